# Optimizing an MI355X kernel written in HIP

```python
import jax, jax.numpy as jnp
from jax import lax
import numpy as np

D_MODEL = 1024
BATCH = 16
SEQ = 256
DEPTH = 2
DEC_BATCH = 4
DEC_SEQ = 2048
PAST_LEN = 256

GRID_W = 64
N_HEADS_A = 8
HEAD_DIM = 64
W_A = N_HEADS_A * HEAD_DIM
W_B = 512
CONV_K = 31
CONV_PAD = CONV_K // 2
WIN_R_MAX = 8
WIN_C = 16
EPS = 1e-6
PROJ_SPLITS = (W_A, 2 * W_A, 3 * W_A, 4 * W_A, 4 * W_A + 2 * W_B, 4 * W_A + 3 * W_B)
D_IN = 4 * W_A + 3 * W_B + 2 * D_MODEL

kernel_name = "gated_natten_conformer_prefix_diffusion"


def rmsnorm(x, g):
    xf = x.astype(jnp.float32)
    y = xf * lax.rsqrt(jnp.mean(xf * xf, axis=-1, keepdims=True) + EPS)
    return (y * g.astype(jnp.float32)).astype(x.dtype)


def layernorm(x, g, b):
    xf = x.astype(jnp.float32)
    mu = jnp.mean(xf, axis=-1, keepdims=True)
    var = jnp.mean(jnp.square(xf - mu), axis=-1, keepdims=True)
    y = (xf - mu) * lax.rsqrt(var + EPS)
    return (y * g.astype(jnp.float32) + b.astype(jnp.float32)).astype(x.dtype)


def context_attention(q, k, v):
    s = jnp.einsum('bqhd,bkhd->bhqk', q, k).astype(jnp.float32) * (HEAD_DIM ** -0.5)
    p = jax.nn.softmax(s, axis=-1).astype(v.dtype)
    o = jnp.einsum('bhqk,bkhd->bqhd', p, v)
    return o.reshape(q.shape[0], q.shape[1], W_A)


def neighbourhood_attention(q, k, v, ck, cv, table):
    B, L, H, Dh = q.shape
    rows = L // GRID_W
    wr = min(WIN_R_MAX, rows)
    r = jnp.arange(rows)
    r0 = jnp.clip(r - wr // 2, 0, rows - wr)
    band = r0[:, None] + jnp.arange(wr)[None, :]
    cq = jnp.arange(GRID_W)
    c0 = jnp.clip(cq - WIN_C // 2, 0, GRID_W - WIN_C)
    col_ok = (cq[None, :] >= c0[:, None]) & (cq[None, :] < c0[:, None] + WIN_C)
    dr = band - r[:, None] + (WIN_R_MAX - 1)
    dc = jnp.clip(cq[None, :] - cq[:, None] + (WIN_C - 1), 0, 2 * WIN_C - 2)
    bias = table[:, dr[:, None, :, None], dc[None, :, None, :]]
    qg = q.reshape(B, rows, GRID_W, H, Dh)
    kb = k.reshape(B, rows, GRID_W, H, Dh)[:, band]
    vb = v.reshape(B, rows, GRID_W, H, Dh)[:, band]
    scale = Dh ** -0.5
    s_win = jnp.einsum('brchd,brkwhd->bhrckw', qg, kb).astype(jnp.float32) * scale
    s_win = s_win + bias.astype(jnp.float32)[None]
    s_win = jnp.where(col_ok[:, None, :], s_win, -jnp.inf)
    s_win = s_win.reshape(B, H, rows, GRID_W, wr * GRID_W)
    s_ctx = jnp.einsum('brchd,bshd->bhrcs', qg, ck).astype(jnp.float32) * scale
    p = jax.nn.softmax(jnp.concatenate([s_win, s_ctx], axis=-1), axis=-1).astype(v.dtype)
    p_win = p[..., :wr * GRID_W].reshape(B, H, rows, GRID_W, wr, GRID_W)
    p_ctx = p[..., wr * GRID_W:]
    o = jnp.einsum('bhrckw,brkwhd->brchd', p_win, vb) + jnp.einsum('bhrcs,bshd->brchd', p_ctx, cv)
    return o.reshape(B, L, H * Dh)


def conv_branch(glu, dw_w, dw_b, ln_g, ln_b):
    a, b = jnp.split(glu, 2, axis=-1)
    u = a * jax.nn.sigmoid(b)
    u = lax.conv_general_dilated(u, dw_w[:, None, :], window_strides=(1,),
                                 padding=[(CONV_PAD, CONV_PAD)],
                                 dimension_numbers=('NWC', 'WIO', 'NWC'),
                                 feature_group_count=W_B) + dw_b
    return jax.nn.silu(layernorm(u, ln_g, ln_b))


def mixer_layer(x, mod, rms_g, w_in, b_in, dw_w, dw_b, ln_g, ln_b, w_proj_a, w_proj_b, w_out, attend):
    shift, scale, gate = jnp.split(mod, 3, axis=-1)
    h = rmsnorm(x, rms_g) * (1 + scale) + shift
    q, k, v, z_a, glu, z_b, gates = jnp.split(h @ w_in + b_in, PROJ_SPLITS, axis=-1)
    B, L, _ = x.shape
    q = q.reshape(B, L, N_HEADS_A, HEAD_DIM)
    k = k.reshape(B, L, N_HEADS_A, HEAD_DIM)
    v = v.reshape(B, L, N_HEADS_A, HEAD_DIM)
    y_a = attend(q, k, v) * jax.nn.silu(z_a)
    y_b = conv_branch(glu, dw_w, dw_b, ln_g, ln_b) * jax.nn.silu(z_b)
    g_a, g_b = jnp.split(jax.nn.sigmoid(gates), 2, axis=-1)
    m = g_a * (y_a @ w_proj_a) + g_b * (y_b @ w_proj_b)
    return x + gate * (m @ w_out), k, v


def setup_inputs(seed: int = 0) -> dict:
    key = jax.random.key(seed)
    ks = jax.random.split(key, 20)
    n = jax.random.normal
    f32 = jnp.float32
    return {
        "x_prompt": n(ks[0], (BATCH, SEQ, D_MODEL), f32),
        "x_sample": n(ks[1], (DEC_BATCH, DEC_SEQ, D_MODEL), f32),
        "cache_k": n(ks[2], (DEC_BATCH, DEPTH, PAST_LEN, N_HEADS_A, HEAD_DIM), f32),
        "cache_v": n(ks[3], (DEC_BATCH, DEPTH, PAST_LEN, N_HEADS_A, HEAD_DIM), f32),
        "c": n(ks[4], (DEC_BATCH, D_MODEL), f32),
        "c_ctx": n(ks[5], (D_MODEL,), f32),
        "rms_g": 1.0 + 0.1 * n(ks[6], (DEPTH, D_MODEL), f32),
        "w_ada": 0.5 * D_MODEL ** -0.5 * n(ks[7], (DEPTH, D_MODEL, 3 * D_MODEL), f32),
        "b_ada": 0.01 * n(ks[8], (DEPTH, 3 * D_MODEL), f32),
        "w_in": D_MODEL ** -0.5 * n(ks[9], (DEPTH, D_MODEL, D_IN), f32),
        "b_in": 0.01 * n(ks[10], (DEPTH, D_IN), f32),
        "rel_bias": 0.1 * n(ks[11], (DEPTH, N_HEADS_A, 2 * WIN_R_MAX - 1, 2 * WIN_C - 1), f32),
        "dw_w": CONV_K ** -0.5 * n(ks[12], (DEPTH, CONV_K, W_B), f32),
        "dw_b": 0.01 * n(ks[13], (DEPTH, W_B), f32),
        "ln_g": 1.0 + 0.1 * n(ks[14], (DEPTH, W_B), f32),
        "ln_b": 0.01 * n(ks[15], (DEPTH, W_B), f32),
        "w_proj_a": W_A ** -0.5 * n(ks[16], (DEPTH, W_A, D_MODEL), f32),
        "w_proj_b": W_B ** -0.5 * n(ks[17], (DEPTH, W_B, D_MODEL), f32),
        "w_out": D_MODEL ** -0.5 * n(ks[18], (DEPTH, D_MODEL, D_MODEL), f32),
        "final_g": 1.0 + 0.1 * n(ks[19], (D_MODEL,), f32),
    }


def reference(x_prompt, x_sample, cache_k, cache_v, c, c_ctx, rms_g, w_ada, b_ada, w_in, b_in,
              rel_bias, dw_w, dw_b, ln_g, ln_b, w_proj_a, w_proj_b, w_out, final_g):
    x = x_prompt
    ks, vs = [], []
    for l in range(DEPTH):
        mod_ctx = jax.nn.silu(c_ctx) @ w_ada[l] + b_ada[l]
        x, k, v = mixer_layer(x, mod_ctx, rms_g[l], w_in[l], b_in[l], dw_w[l], dw_b[l], ln_g[l], ln_b[l],
                              w_proj_a[l], w_proj_b[l], w_out[l], context_attention)
        ks.append(k)
        vs.append(v)
    y_prompt = rmsnorm(x, final_g)
    state_k = jnp.stack(ks, axis=1)
    state_v = jnp.stack(vs, axis=1)

    z = x_sample
    for l in range(DEPTH):
        mod_lat = (jax.nn.silu(c) @ w_ada[l] + b_ada[l])[:, None, :]
        attend = lambda q, k, v, l=l: neighbourhood_attention(q, k, v, cache_k[:, l], cache_v[:, l], rel_bias[l])
        z, _, _ = mixer_layer(z, mod_lat, rms_g[l], w_in[l], b_in[l], dw_w[l], dw_b[l], ln_g[l], ln_b[l],
                              w_proj_a[l], w_proj_b[l], w_out[l], attend)
    y_sample = rmsnorm(z, final_g)
    return (y_prompt, y_sample, state_k, state_v)
```

```cpp
#include <hip/hip_runtime.h>
#include <cstdio>
#include <cstdint>

#ifndef MK_N_LAUNCHES
#define MK_N_LAUNCHES 1
#endif

#define GAS __attribute__((address_space(1)))
#define LAS __attribute__((address_space(3)))
typedef unsigned short bf16_t;
typedef short bf16x8 __attribute__((ext_vector_type(8)));
typedef float f32x4 __attribute__((ext_vector_type(4)));
typedef float f32x2 __attribute__((ext_vector_type(2)));
typedef unsigned u32x4 __attribute__((ext_vector_type(4)));
typedef unsigned u32x2 __attribute__((ext_vector_type(2)));
typedef GAS unsigned gu32;
#define RLX_AGENT __ATOMIC_RELAXED, __HIP_MEMORY_SCOPE_AGENT
#define LDS_WAIT() asm volatile("s_waitcnt lgkmcnt(0)" ::: "memory")
#define VM_WAIT() asm volatile("s_waitcnt vmcnt(0)" ::: "memory")

constexpr int D = 1024, NCTX = 4096, NLAT = 8192, M = NCTX + NLAT, DIN = 5632, DEPTH = 2, NH = 8, HD = 64;
constexpr int NPHASE = 12;
constexpr float EPS = 1e-6f;

constexpr size_t MiB = 1u << 20;
constexpr size_t WS_CTL = 0, CTL_ZERO_BYTES = 192 * 1024;
constexpr size_t WS_RSS2 = 128 * 1024;
constexpr size_t WS_RSS = 64 * 1024;
constexpr size_t WS_GM = 1 * MiB + 192 * 1024;
constexpr size_t WS_CVEC = 1 * MiB + 256 * 1024;
constexpr size_t WS_MOD = 1 * MiB;
constexpr size_t WS_BIASP = 1 * MiB + 128 * 1024;
constexpr size_t WS_WTIN = 2 * MiB;
constexpr size_t WS_WTPROJ = 24 * MiB;
constexpr size_t WS_WTOUT = 28 * MiB;
constexpr size_t WS_CK = 32 * MiB, WS_CV = 34 * MiB;
constexpr size_t WS_H = 36 * MiB;
constexpr size_t WS_Q = 60 * MiB, WS_K = 72 * MiB, WS_V = 84 * MiB, WS_SZA = 96 * MiB, WS_U = 108 * MiB, WS_SZB = 120 * MiB;
constexpr size_t WS_GR = 132 * MiB, WS_GB = 156 * MiB;
constexpr size_t WS_YAB = 180 * MiB;
constexpr size_t WS_X1 = 204 * MiB;
constexpr size_t WS_END = 228 * MiB;
constexpr int CW_BAR = 4096;

constexpr int RING_BYTES = 131072;
constexpr int LDSCTL_OFF = RING_BYTES, MISC_OFF = LDSCTL_OFF + 320;
constexpr int LDS_BYTES = 147456;

__device__ __forceinline__ unsigned f2bf(float f) { unsigned u = __builtin_bit_cast(unsigned, f); return (u + 0x7fffu + ((u >> 16) & 1u)) >> 16; }
__device__ __forceinline__ unsigned pk2(float lo, float hi) { return f2bf(lo) | (f2bf(hi) << 16); }
typedef __bf16 bf16x2_cv __attribute__((ext_vector_type(2)));
__device__ __forceinline__ unsigned cvt_pk_bf16(float lo, float hi) { f32x2 v = {lo, hi}; bf16x2_cv b = __builtin_convertvector(v, bf16x2_cv); return __builtin_bit_cast(unsigned, b); }
__device__ __forceinline__ float bflo(unsigned w) { return __builtin_bit_cast(float, w << 16); }
__device__ __forceinline__ float bfhi(unsigned w) { return __builtin_bit_cast(float, w & 0xffff0000u); }
__device__ __forceinline__ float sigmoid_f(float x) { return __builtin_amdgcn_rcpf(1.0f + __expf(-x)); }
__device__ __forceinline__ float silu_f(float x) { return x * sigmoid_f(x); }
__device__ __forceinline__ float dpp_f(float v, float o) { return v + o; }
__device__ __forceinline__ float wave_sum(float v) {
#define DPP_ADD(ctrl, rm, bc) v += __builtin_bit_cast(float, __builtin_amdgcn_update_dpp(0, __builtin_bit_cast(int, v), ctrl, rm, 0xf, bc))
    DPP_ADD(0x111, 0xf, true); DPP_ADD(0x112, 0xf, true); DPP_ADD(0x114, 0xf, true); DPP_ADD(0x118, 0xf, true);
    DPP_ADD(0x142, 0xa, false); DPP_ADD(0x143, 0xc, false);
#undef DPP_ADD
    return __builtin_bit_cast(float, __builtin_amdgcn_readlane(__builtin_bit_cast(int, v), 63));
}

__device__ __forceinline__ int fresh_tid() { int t = threadIdx.x; asm volatile("" : "+v"(t)); return t; }

namespace pg8 {
constexpr int BM = 256, BK = 64, HALF = 128, HTB = HALF * BK * 2, STAGE_BYTES = 8 * HTB, NXCD = 8, WGM = 8;
__host__ __device__ __forceinline__ int lds_byte(int r, int c) { const int st = (r >> 4) * 2 + (c >> 5), rr = r & 15, cc = c & 31, ob = rr * 64 + cc * 2; return st * 1024 + (ob ^ (((ob >> 9) & 1) << 5)); }
__host__ __device__ __forceinline__ void stage_rc(int b, int& R, int& C) { const int st = b / 1024, sb = b % 1024, swz = sb ^ (((sb >> 9) & 1) << 5); R = (st >> 1) * 16 + swz / 64; C = (st & 1) * 32 + (swz % 64) / 2; }
__host__ __device__ __forceinline__ int perm32(int rho) { const int n = rho >> 4, i = rho & 15; return 8 * (i >> 2) + 4 * n + (i & 3); }

struct Unit { int pm, pn, kh; };
struct Gemm { const bf16_t* A; const bf16_t* Bt; int M, N, K, ld; };

struct StaticOrder {
    int nM, nN, nwg, G, c;
    __host__ __device__ void init(int M_, int N_, int G_, int c_, int split_ = 0, int bm_ = BM) { nM = M_ / bm_; nN = N_ / BM; nwg = nM * nN; G = G_; c = c_; split = split_; }
    int split;
    __host__ __device__ bool next(int i0, Unit& u) const {
        const int i = split ? (i0 >> 1) : i0; u.kh = split ? (i0 & 1) : 0;
        const long L = (long)i * G + c; if (L >= nwg) return false;
        int wgid = (int)L; { const int q = nwg / NXCD, r = nwg % NXCD, xcd = wgid % NXCD, off = wgid / NXCD; wgid = (xcd < r ? xcd * (q + 1) : r * (q + 1) + (xcd - r) * q) + off; }
        const int nig = WGM * nN, gid = wgid / nig, fm = gid * WGM, gsz = (nM - fm) < WGM ? (nM - fm) : WGM;
        u.pm = fm + ((wgid % nig) % gsz); u.pn = (wgid % nig) / gsz; return true;
    }
};

template <class Epi, bool ALIGN_EPI = true, bool SP2 = true>
__device__ __forceinline__ void gemm_phase(LAS unsigned char* lds, const Gemm g, const StaticOrder& S, const Epi& E) {
    const int tid = fresh_tid(), wid = __builtin_amdgcn_readfirstlane(tid >> 6), lane = tid & 63, wr = wid >> 2, wc = wid & 3, fr = lane & 15, fq = lane >> 4;
    static_assert(SP2 || Epi::MB == 4, "tiles lower than 256 rows use the SP2 loop");
    constexpr int MB = Epi::MB, HROWS = 32 * MB;
    const int K = g.ld, nt = g.K / BK;
    const size_t khstep = (size_t)g.K * 2;
    unsigned voffA[2], voffB[2];
#pragma unroll
    for (int i = 0; i < 2; ++i) { int R, C; stage_rc(tid * 16 + i * 8192, R, C); const int Rb = Epi::PERM ? ((R & ~31) + perm32(R & 31)) : R;
        voffA[i] = (unsigned)(R * K + C) * 2u; voffB[i] = (unsigned)(Rb * K + C) * 2u; }
    const size_t kstep = (size_t)(BK * 2);
    const size_t hstep = (size_t)HROWS * K * 2;
    const size_t hstepB = (size_t)HALF * K * 2;
    const size_t tstep = 2 * hstep, tstepB = 2 * hstepB;
    const unsigned ldsw = (unsigned)wid * 1024u;
    const int aoff = lds_byte(wr * (16 * MB) + fr, fq * 8), boff = lds_byte(wc * 32 + fr, fq * 8);
#define PG8_SA(b, h) (((b) * 2 + (h)) * HTB)
#define PG8_SB(b, h) ((4 + (b) * 2 + (h)) * HTB)
#define PG8_STAGE(bufoff, gbase, voff) do { _Pragma("unroll") for (int _i = 0; _i < 2; ++_i) \
        __builtin_amdgcn_global_load_lds((const unsigned*)((const char*)(gbase) + (voff)[_i]), (LAS unsigned*)(lds + (bufoff) + ldsw + _i * 8192), 16, 0, 0); } while (0)
#define PG8_LDA(dst, b, h) do { _Pragma("unroll") for (int m = 0; m < MB; ++m) _Pragma("unroll") for (int k = 0; k < 2; ++k) dst[m][k] = *(const LAS bf16x8*)(lds + PG8_SA(b, h) + aoff + m * 2048 + k * 1024); } while (0)
#define PG8_LDB(dst, b, h) do { _Pragma("unroll") for (int n = 0; n < 2; ++n) _Pragma("unroll") for (int k = 0; k < 2; ++k) dst[n][k] = *(const LAS bf16x8*)(lds + PG8_SB(b, h) + boff + n * 2048 + k * 1024); } while (0)
#define PG8_MMA(ai, bj, At, Bt) do { __builtin_amdgcn_s_setprio(1); _Pragma("unroll") for (int m = 0; m < MB; ++m) _Pragma("unroll") for (int n = 0; n < 2; ++n) _Pragma("unroll") for (int k = 0; k < 2; ++k) \
        acc[ai][bj][m][n] = __builtin_amdgcn_mfma_f32_16x16x32_bf16(Bt[n][k], At[m][k], acc[ai][bj][m][n], 0, 0, 0); __builtin_amdgcn_s_setprio(0); } while (0)
#define PG8_WAIT_V(n) asm volatile("s_waitcnt vmcnt(" #n ")" ::: "memory")
    const int aIss = (MB == 4) ? 2 : (MB == 3) ? (wid < 4 ? 2 : 1) : (MB == 2) ? 1 : (wid < 4 ? 1 : 0);
#define PG8_STAGE_A(bufoff, gbase, voff) do { _Pragma("unroll") for (int _i = 0; _i < 2; ++_i) if (MB == 4 || _i < aIss) \
        __builtin_amdgcn_global_load_lds((const unsigned*)((const char*)(gbase) + (voff)[_i]), (LAS unsigned*)(lds + (bufoff) + ldsw + _i * 8192), 16, 0, 0); } while (0)
#define PG8_WAIT_VN(n) do { switch (n) { case 0: PG8_WAIT_V(0); break; case 1: PG8_WAIT_V(1); break; case 2: PG8_WAIT_V(2); break; case 4: PG8_WAIT_V(4); break; case 5: PG8_WAIT_V(5); break; \
        case 6: PG8_WAIT_V(6); break; default: PG8_WAIT_V(8); break; } } while (0)
#define PG8_WAIT_LOOP() do { if constexpr (MB == 4) PG8_WAIT_V(8); else PG8_WAIT_VN(4 + 2 * aIss); } while (0)
#define PG8_WAIT_P1() do { if constexpr (MB == 4) PG8_WAIT_V(2); else PG8_WAIT_VN(aIss); } while (0)
#define PG8_WAIT_P2() do { if constexpr (MB == 4) PG8_WAIT_V(6); else PG8_WAIT_VN(4 + aIss); } while (0)
#define PG8_WAIT_L(n) asm volatile("s_waitcnt lgkmcnt(" #n ")" ::: "memory")
#define PG8_BAR __builtin_amdgcn_s_barrier()
#define PG8_SCHED __builtin_amdgcn_sched_barrier(0)
    Unit cur, nxt; int ui = 0;
    if (!S.next(0, cur)) return;
    f32x4 acc[2][2][MB][2];
#pragma unroll
    for (int a = 0; a < 2; ++a)
#pragma unroll
        for (int b = 0; b < 2; ++b)
#pragma unroll
            for (int m = 0; m < MB; ++m)
#pragma unroll
                for (int n = 0; n < 2; ++n) acc[a][b][m][n] = (f32x4){0.f, 0.f, 0.f, 0.f};
    bf16x8 At[MB][2], B0[2][2], B1[2][2];
    const char* cA = (const char*)g.A + (size_t)cur.pm * tstep + cur.kh * khstep; const char* cB = (const char*)g.Bt + (size_t)cur.pn * tstepB + cur.kh * khstep;
    if constexpr (SP2) {
        PG8_STAGE(PG8_SB(0, 0), cB, voffB); PG8_STAGE(PG8_SB(0, 1), cB + hstepB, voffB); PG8_STAGE_A(PG8_SA(0, 0), cA, voffA); PG8_STAGE_A(PG8_SA(0, 1), cA + hstep, voffA);
        if (wr == 1) PG8_BAR;
        PG8_WAIT_P1(); PG8_BAR;
        PG8_STAGE(PG8_SB(1, 0), cB + kstep, voffB); PG8_STAGE_A(PG8_SA(1, 0), cA + kstep, voffA); PG8_STAGE(PG8_SB(1, 1), cB + hstepB + kstep, voffB);
        PG8_WAIT_P2(); PG8_BAR;
    } else {
        PG8_STAGE(PG8_SB(0, 0), cB, voffB); PG8_STAGE(PG8_SA(0, 0), cA, voffA); PG8_STAGE(PG8_SB(0, 1), cB + hstepB, voffB); PG8_STAGE(PG8_SA(0, 1), cA + hstep, voffA);
        if (wr == 1) PG8_BAR;
        PG8_WAIT_V(4); PG8_BAR;
        PG8_STAGE(PG8_SB(1, 0), cB + kstep, voffB); PG8_STAGE(PG8_SA(1, 0), cA + kstep, voffA); PG8_STAGE(PG8_SB(1, 1), cB + hstepB + kstep, voffB);
        PG8_WAIT_V(6); PG8_BAR;
    }
    for (;;) {
        const bool has_next = S.next(ui + 1, nxt);
        const char* nA = has_next ? (const char*)g.A + (size_t)nxt.pm * tstep + nxt.kh * khstep : cA; const char* nB = has_next ? (const char*)g.Bt + (size_t)nxt.pn * tstepB + nxt.kh * khstep : cB;
        for (int t = 0; t < nt; t += 2) {
            const bool last = (t == nt - 2);
            const char* a1 = cA + (size_t)(t + 1) * kstep;
            const char* a2 = last ? nA : cA + (size_t)(t + 2) * kstep; const char* b2 = last ? nB : cB + (size_t)(t + 2) * kstep;
            const char* a3 = a2 + kstep; const char* b3 = b2 + kstep;
            if constexpr (SP2) {
            PG8_LDB(B0, 0, 0); PG8_LDB(B1, 0, 1); PG8_SCHED; PG8_LDA(At, 0, 0); PG8_STAGE_A(PG8_SA(1, 1), a1 + hstep, voffA);
            PG8_WAIT_LOOP(); PG8_WAIT_L(0); PG8_BAR; PG8_MMA(0, 0, At, B0); PG8_MMA(0, 1, At, B1); PG8_BAR; PG8_SCHED;
            PG8_LDA(At, 0, 1); PG8_STAGE(PG8_SB(0, 0), b2, voffB); PG8_STAGE(PG8_SB(0, 1), b2 + hstepB, voffB); PG8_STAGE_A(PG8_SA(0, 0), a2, voffA);
            PG8_WAIT_LOOP(); PG8_WAIT_L(0); PG8_BAR; PG8_MMA(1, 0, At, B0); PG8_MMA(1, 1, At, B1); PG8_BAR; PG8_SCHED;
            PG8_LDB(B0, 1, 0); PG8_LDB(B1, 1, 1); PG8_SCHED; PG8_LDA(At, 1, 0); PG8_STAGE_A(PG8_SA(0, 1), a2 + hstep, voffA);
            PG8_WAIT_LOOP(); PG8_WAIT_L(0); PG8_BAR; PG8_MMA(0, 0, At, B0); PG8_MMA(0, 1, At, B1); PG8_BAR; PG8_SCHED;
            PG8_LDA(At, 1, 1); PG8_STAGE(PG8_SB(1, 0), b3, voffB); PG8_STAGE(PG8_SB(1, 1), b3 + hstepB, voffB); PG8_STAGE_A(PG8_SA(1, 0), a3, voffA);
            PG8_WAIT_LOOP(); PG8_WAIT_L(0); PG8_BAR; PG8_MMA(1, 0, At, B0); PG8_MMA(1, 1, At, B1); PG8_BAR; PG8_SCHED;
            } else {
            PG8_LDB(B0, 0, 0); PG8_SCHED; PG8_LDA(At, 0, 0); PG8_STAGE(PG8_SA(1, 1), a1 + hstep, voffA);
            PG8_WAIT_L(8); PG8_BAR; PG8_WAIT_L(0); PG8_MMA(0, 0, At, B0); PG8_BAR; PG8_SCHED;
            PG8_LDB(B1, 0, 1); PG8_STAGE(PG8_SB(0, 0), b2, voffB);
            PG8_BAR; PG8_WAIT_L(0); PG8_MMA(0, 1, At, B1); PG8_BAR;
            PG8_LDA(At, 0, 1); PG8_STAGE(PG8_SA(0, 0), a2, voffA);
            PG8_BAR; PG8_WAIT_L(0); PG8_MMA(1, 0, At, B0); PG8_BAR; PG8_SCHED;
            PG8_STAGE(PG8_SB(0, 1), b2 + hstepB, voffB);
            PG8_WAIT_V(6); PG8_BAR; PG8_MMA(1, 1, At, B1); PG8_BAR;
            PG8_LDB(B0, 1, 0); PG8_SCHED; PG8_LDA(At, 1, 0); PG8_STAGE(PG8_SA(0, 1), a2 + hstep, voffA);
            PG8_WAIT_L(8); PG8_BAR; PG8_WAIT_L(0); PG8_MMA(0, 0, At, B0); PG8_BAR; PG8_SCHED;
            PG8_LDB(B1, 1, 1); PG8_STAGE(PG8_SB(1, 0), b3, voffB);
            PG8_BAR; PG8_WAIT_L(0); PG8_MMA(0, 1, At, B1); PG8_BAR;
            PG8_LDA(At, 1, 1); PG8_STAGE(PG8_SA(1, 0), a3, voffA);
            PG8_BAR; PG8_WAIT_L(0); PG8_MMA(1, 0, At, B0); PG8_BAR; PG8_SCHED;
            PG8_STAGE(PG8_SB(1, 1), b3 + hstepB, voffB);
            PG8_WAIT_V(6); PG8_BAR; PG8_MMA(1, 1, At, B1); PG8_BAR;
            }
            if constexpr (Epi::MIDHOOK) { if (t + 2 == nt / 2) { E.mid(acc, cur, wr, wc, fr, fq); PG8_SCHED; } }
        }
        if constexpr (ALIGN_EPI) { if (wr == 0) PG8_BAR; }
        E(acc, cur, wr, wc, fr, fq);
        if (!has_next) break;
        {
#pragma unroll
        for (int a = 0; a < 2; ++a)
#pragma unroll
            for (int b = 0; b < 2; ++b)
#pragma unroll
                for (int m = 0; m < MB; ++m)
#pragma unroll
                    for (int n = 0; n < 2; ++n) acc[a][b][m][n] = (f32x4){0.f, 0.f, 0.f, 0.f};
        }
        cur = nxt; cA = nA; cB = nB; ++ui;
        if constexpr (ALIGN_EPI) { if (wr == 1) PG8_BAR; }
    }
    PG8_WAIT_V(0);
    if constexpr (!ALIGN_EPI) { if (wr == 0) PG8_BAR; }
    PG8_BAR;
#undef PG8_SA
#undef PG8_SB
#undef PG8_STAGE
#undef PG8_STAGE_A
#undef PG8_WAIT_VN
#undef PG8_WAIT_LOOP
#undef PG8_WAIT_P1
#undef PG8_WAIT_P2
#undef PG8_LDA
#undef PG8_LDB
#undef PG8_MMA
#undef PG8_WAIT_V
#undef PG8_WAIT_L
#undef PG8_BAR
#undef PG8_SCHED
}
}

#define AS4 __attribute__((address_space(4)))
__device__ __forceinline__ const float* kin(int k) { const AS4 char* p = (const AS4 char*)__builtin_amdgcn_kernarg_segment_ptr(); asm volatile("" : "+s"(p)); return *(const float* const AS4*)(p + 8 * k); }
__device__ __forceinline__ float* kout() { const AS4 char* p = (const AS4 char*)__builtin_amdgcn_kernarg_segment_ptr(); asm volatile("" : "+s"(p)); return *(float* const AS4*)(p + 160); }
__device__ __forceinline__ int kint(int off) { const AS4 char* p = (const AS4 char*)__builtin_amdgcn_kernarg_segment_ptr(); asm volatile("" : "+s"(p)); return *(const int AS4*)(p + off); }
__device__ __forceinline__ unsigned char* kws() { const AS4 char* p = (const AS4 char*)__builtin_amdgcn_kernarg_segment_ptr(); asm volatile("" : "+s"(p)); return *(unsigned char* const AS4*)(p + 168); }
#define I_X_PROMPT 0
#define I_X_SAMPLE 1
#define I_CACHE_K 2
#define I_CACHE_V 3
#define I_C 4
#define I_C_CTX 5
#define I_RMS_G 6
#define I_W_ADA 7
#define I_B_ADA 8
#define I_W_IN 9
#define I_B_IN 10
#define I_REL_BIAS 11
#define I_DW_W 12
#define I_DW_B 13
#define I_LN_G 14
#define I_LN_B 15
#define I_W_PROJ_A 16
#define I_W_PROJ_B 17
#define I_W_OUT 18
#define I_FINAL_G 19
#define WSP(T, off) ((T*)(kws() + (off)))

constexpr float QSCALE = 0.125f * 1.4426950408889634f;
typedef f32x4 acc_t[2][2][4][2];
typedef f32x4 acc3_t[2][2][3][2];

template <int MB_, bool FU = false> struct EpiInT {
    static constexpr bool PERM = true, SPLIT2 = false, MIDHOOK = false; static constexpr int MB = MB_;
    typedef f32x4 accm_t[2][2][MB_][2];
    int layer, rowbase;
    template <bool ACT, bool ST, bool QS = false> __device__ __forceinline__ void plain(accm_t& acc, const f32x4 (&bv)[2][2], bf16_t* dst, float* st, int row0, int colbase) const {
#pragma unroll
        for (int ai = 0; ai < 2; ++ai)
#pragma unroll
            for (int m = 0; m < MB_; ++m) { const int row = row0 + ai * (32 * MB_) + m * 16;
#pragma unroll
                for (int bj = 0; bj < 2; ++bj) { f32x4 v0 = acc[ai][bj][m][0] + bv[bj][0], v1 = acc[ai][bj][m][1] + bv[bj][1];
                    if (QS) { v0 = v0 * QSCALE; v1 = v1 * QSCALE; }
                    if (ST) { float* sp = st + ((size_t)((row >> 8) * 512 + layer * 256 + (row & 255))) * 512 + colbase + bj * 128; *(f32x4*)sp = v0; *(f32x4*)(sp + 4) = v1; }
                    if (ACT) {
#pragma unroll
                        for (int j = 0; j < 4; ++j) { v0[j] = silu_f(v0[j]); v1[j] = silu_f(v1[j]); } }
                    u32x4 w; w.x = cvt_pk_bf16(v0[0], v0[1]); w.y = cvt_pk_bf16(v0[2], v0[3]); w.z = cvt_pk_bf16(v1[0], v1[1]); w.w = cvt_pk_bf16(v1[2], v1[3]);
                    *(u32x4*)(dst + (size_t)row * 512 + colbase + bj * 128) = w; } }
    }
    __device__ __forceinline__ void operator()(accm_t& acc, const pg8::Unit& u, int wr, int wc, int fr, int fq) const {
        asm volatile("" : "+v"(fr), "+v"(fq));
        const int row0 = rowbase + u.pm * (64 * MB_) + wr * (16 * MB_) + fr, c8 = wc * 32 + 8 * fq, pn = u.pn;
        const bool ctxrows = rowbase + u.pm * (64 * MB_) < NCTX;
        unsigned char* wsb = kws();
        bf16_t* Q = (bf16_t*)(wsb + WS_Q); bf16_t* K = (bf16_t*)(wsb + WS_K); bf16_t* V = (bf16_t*)(wsb + WS_V); bf16_t* SZA = (bf16_t*)(wsb + WS_SZA); bf16_t* U = (bf16_t*)(wsb + WS_U);
        bf16_t* SZB = (bf16_t*)(wsb + WS_SZB); bf16_t* GR = (bf16_t*)(wsb + WS_GR); bf16_t* GB = (bf16_t*)(wsb + WS_GB);
        const int tr0 = rowbase + u.pm * (64 * MB_), tg = tr0 < NCTX ? 0 : 1 + ((tr0 - NCTX) >> 11);
        const float* bp = FU ? (const float*)(wsb + WS_CVEC) + tg * DIN + pn * 256 + c8 : (const float*)(wsb + WS_BIASP) + layer * DIN + pn * 256 + c8;
        if (FU) { const float* rss = (const float*)(wsb + WS_RSS); float rq[2][MB_];
#pragma unroll
            for (int ai = 0; ai < 2; ++ai)
#pragma unroll
                for (int m = 0; m < MB_; ++m) rq[ai][m] = rss[row0 + ai * (32 * MB_) + m * 16];
#pragma unroll
            for (int ai = 0; ai < 2; ++ai)
#pragma unroll
                for (int m = 0; m < MB_; ++m) { const float rs = rsqrtf(rq[ai][m] * (1.0f / D) + EPS);
#pragma unroll
                    for (int bj = 0; bj < 2; ++bj) { acc[ai][bj][m][0] = acc[ai][bj][m][0] * rs; acc[ai][bj][m][1] = acc[ai][bj][m][1] * rs; } } }
        float* stk = kout() + (size_t)M * D; float* stv = stk + (size_t)16 * 2 * 256 * 512;
        f32x4 bv[2][2];
#pragma unroll
        for (int bj = 0; bj < 2; ++bj)
#pragma unroll
            for (int n = 0; n < 2; ++n) bv[bj][n] = *(const f32x4*)(bp + bj * 128 + 4 * n);
        const int colbase = (pn & 1) * 256 + c8;
        if (pn < 2) plain<false, false, true>(acc, bv, Q, nullptr, row0, colbase);
        else if (pn < 4) { if (ctxrows) plain<false, true>(acc, bv, K, stk, row0, colbase); else plain<false, false>(acc, bv, K, nullptr, row0, colbase); }
        else if (pn < 6) { if (ctxrows) plain<false, true>(acc, bv, V, stv, row0, colbase); else plain<false, false>(acc, bv, V, nullptr, row0, colbase); }
        else if (pn < 8) plain<true, false>(acc, bv, SZA, nullptr, row0, colbase);
        else if (pn == 12 || pn == 13) plain<true, false>(acc, bv, SZB, nullptr, row0, colbase);
        else if (pn < 12) {
            const int cb = (pn - 8) * 128 + c8;
#pragma unroll
            for (int ai = 0; ai < 2; ++ai)
#pragma unroll
                for (int m = 0; m < MB_; ++m) { const int row = row0 + ai * (32 * MB_) + m * 16;
                    f32x4 a0 = acc[ai][0][m][0] + bv[0][0], a1 = acc[ai][0][m][1] + bv[0][1], b0 = acc[ai][1][m][0] + bv[1][0], b1 = acc[ai][1][m][1] + bv[1][1];
#pragma unroll
                    for (int j = 0; j < 4; ++j) { a0[j] *= sigmoid_f(b0[j]); a1[j] *= sigmoid_f(b1[j]); }
                    u32x4 w; w.x = cvt_pk_bf16(a0[0], a0[1]); w.y = cvt_pk_bf16(a0[2], a0[3]); w.z = cvt_pk_bf16(a1[0], a1[1]); w.w = cvt_pk_bf16(a1[2], a1[3]);
                    *(u32x4*)(U + (size_t)row * 512 + cb) = w; }
        } else {
            const int cb = (pn - 14) * 128 + c8;
#pragma unroll
            for (int ai = 0; ai < 2; ++ai)
#pragma unroll
                for (int m = 0; m < MB_; ++m) { const int row = row0 + ai * (32 * MB_) + m * 16;
                    f32x4 a0 = acc[ai][0][m][0] + bv[0][0], a1 = acc[ai][0][m][1] + bv[0][1], b0 = acc[ai][1][m][0] + bv[1][0], b1 = acc[ai][1][m][1] + bv[1][1];
                    f32x4 r0, r1, g0, g1;
#pragma unroll
                    for (int j = 0; j < 4; ++j) {
                        const float ea0 = __expf(-a0[j]), ea1 = __expf(-a1[j]), eb0 = fminf(__expf(-b0[j]), 1e30f), eb1 = fminf(__expf(-b1[j]), 1e30f);
                        g0[j] = __builtin_amdgcn_rcpf(1.0f + eb0); g1[j] = __builtin_amdgcn_rcpf(1.0f + eb1);
                        r0[j] = (1.0f + eb0) * __builtin_amdgcn_rcpf(1.0f + ea0); r1[j] = (1.0f + eb1) * __builtin_amdgcn_rcpf(1.0f + ea1); }
                    u32x4 w; w.x = cvt_pk_bf16(r0[0], r0[1]); w.y = cvt_pk_bf16(r0[2], r0[3]); w.z = cvt_pk_bf16(r1[0], r1[1]); w.w = cvt_pk_bf16(r1[2], r1[3]);
                    *(u32x4*)(GR + (size_t)row * 1024 + cb) = w;
                    w.x = cvt_pk_bf16(g0[0], g0[1]); w.y = cvt_pk_bf16(g0[2], g0[3]); w.z = cvt_pk_bf16(g1[0], g1[1]); w.w = cvt_pk_bf16(g1[2], g1[3]);
                    *(u32x4*)(GB + (size_t)row * 1024 + cb) = w; }
        }
    }
};

struct EpiProj {
    static constexpr bool PERM = true, SPLIT2 = false, MIDHOOK = true; static constexpr int MB = 3;
    __device__ __forceinline__ void mid(acc3_t& acc, const pg8::Unit& u, int wr, int wc, int fr, int fq) const {
        asm volatile("" : "+v"(fr), "+v"(fq));
        const int row0 = u.pm * 192 + wr * 48 + fr, col0 = u.pn * 256 + wc * 32 + 8 * fq;
        const bf16_t* G = WSP(bf16_t, WS_GR);
#pragma unroll
        for (int ai = 0; ai < 2; ++ai)
#pragma unroll
            for (int m = 0; m < 3; ++m) { const size_t off = (size_t)(row0 + ai * 96 + m * 16) * 1024 + col0;
#pragma unroll
                for (int bj = 0; bj < 2; ++bj) { const u32x4 w = *(const u32x4*)(G + off + bj * 128);
                    acc[ai][bj][m][0] = acc[ai][bj][m][0] * (f32x4){bflo(w.x), bfhi(w.x), bflo(w.y), bfhi(w.y)}; acc[ai][bj][m][1] = acc[ai][bj][m][1] * (f32x4){bflo(w.z), bfhi(w.z), bflo(w.w), bfhi(w.w)}; } }
    }
    __device__ __forceinline__ void operator()(acc3_t& acc, const pg8::Unit& u, int wr, int wc, int fr, int fq) const {
        asm volatile("" : "+v"(fr), "+v"(fq));
        const int row0 = u.pm * 192 + wr * 48 + fr, col0 = u.pn * 256 + wc * 32 + 8 * fq;
        unsigned char* wsb = kws();
        const bf16_t* G = (const bf16_t*)(wsb + WS_GB); bf16_t* Mo = (bf16_t*)(wsb + WS_H);
#pragma unroll
        for (int ai = 0; ai < 2; ++ai)
#pragma unroll
            for (int m = 0; m < 3; ++m) { const size_t off = (size_t)(row0 + ai * 96 + m * 16) * 1024 + col0;
#pragma unroll
                for (int bj = 0; bj < 2; ++bj) { const u32x4 w = *(const u32x4*)(G + off + bj * 128);
                    const f32x4 v0 = acc[ai][bj][m][0] * (f32x4){bflo(w.x), bfhi(w.x), bflo(w.y), bfhi(w.y)}, v1 = acc[ai][bj][m][1] * (f32x4){bflo(w.z), bfhi(w.z), bflo(w.w), bfhi(w.w)};
                    u32x4 o; o.x = cvt_pk_bf16(v0[0], v0[1]); o.y = cvt_pk_bf16(v0[2], v0[3]); o.z = cvt_pk_bf16(v1[0], v1[1]); o.w = cvt_pk_bf16(v1[2], v1[3]);
                    *(u32x4*)(Mo + off + bj * 128) = o; }
                asm volatile("" ::: "memory"); }
    }
};

template <bool LAST> struct EpiOutT {
    static constexpr bool PERM = true, SPLIT2 = false, MIDHOOK = false; static constexpr int MB = 3;
    int layer;
    __device__ __forceinline__ void operator()(acc3_t& acc, const pg8::Unit& u, int wr, int wc, int fr, int fq) const {
        asm volatile("" : "+v"(fr), "+v"(fq));
        const int row0 = u.pm * 192 + wr * 48 + fr, col0 = u.pn * 256 + wc * 32 + 8 * fq;
        const float* modl = WSP(float, WS_MOD) + layer * 5 * 3072 + 2048 + col0;
        const float* xp = kin(I_X_PROMPT); const float* xs = kin(I_X_SAMPLE) - (size_t)NCTX * D;
        bf16_t* X1 = WSP(bf16_t, WS_X1); bf16_t* XG = WSP(bf16_t, WS_YAB);
        float* rss = WSP(float, LAST ? WS_RSS2 : WS_RSS);
        const float* gfin = kin(I_FINAL_G) + col0;
#pragma unroll
        for (int ai = 0; ai < 2; ++ai)
#pragma unroll
            for (int m = 0; m < 3; ++m) { const int row = row0 + ai * 96 + m * 16; const size_t off = (size_t)row * D + col0;
                const int g = row < NCTX ? 0 : 1 + ((row - NCTX) >> 11);
                const float* gate = modl + g * 3072; const float* xin = row < NCTX ? xp : xs;
                float ssq = 0.f;
#pragma unroll
                for (int bj = 0; bj < 2; ++bj) { const size_t o_ = off + bj * 128;
                    const f32x4 gv0 = *(const f32x4*)(gate + bj * 128), gv1 = *(const f32x4*)(gate + bj * 128 + 4);
                    f32x4 xi0, xi1;
                    if (LAST) { const u32x4 xw = *(const u32x4*)(X1 + o_); xi0 = (f32x4){bflo(xw.x), bfhi(xw.x), bflo(xw.y), bfhi(xw.y)}; xi1 = (f32x4){bflo(xw.z), bfhi(xw.z), bflo(xw.w), bfhi(xw.w)}; }
                    else { xi0 = *(const f32x4*)(xin + o_); xi1 = *(const f32x4*)(xin + o_ + 4); }
                    const f32x4 xn0 = xi0 + gv0 * acc[ai][bj][m][0], xn1 = xi1 + gv1 * acc[ai][bj][m][1];
                    ssq += ((xn0[0] * xn0[0] + xn0[1] * xn0[1]) + (xn0[2] * xn0[2] + xn0[3] * xn0[3])) + ((xn1[0] * xn1[0] + xn1[1] * xn1[1]) + (xn1[2] * xn1[2] + xn1[3] * xn1[3]));
                    const float* gmp = LAST ? gfin + bj * 128 : WSP(float, WS_GM) + g * 1024 + col0 + bj * 128;
                    const f32x4 y0 = xn0 * *(const f32x4*)gmp, y1 = xn1 * *(const f32x4*)(gmp + 4);
                    u32x4 w; w.x = cvt_pk_bf16(y0[0], y0[1]); w.y = cvt_pk_bf16(y0[2], y0[3]); w.z = cvt_pk_bf16(y1[0], y1[1]); w.w = cvt_pk_bf16(y1[2], y1[3]);
                    *(u32x4*)(XG + o_) = w;
                    if (!LAST) { u32x4 xw; xw.x = cvt_pk_bf16(xn0[0], xn0[1]); xw.y = cvt_pk_bf16(xn0[2], xn0[3]); xw.z = cvt_pk_bf16(xn1[0], xn1[1]); xw.w = cvt_pk_bf16(xn1[2], xn1[3]);
                        *(u32x4*)(X1 + o_) = xw; } }
                ssq += __shfl_xor(ssq, 16); ssq += __shfl_xor(ssq, 32);
                if (fq == 0) (void)__hip_atomic_fetch_add(rss + row, ssq, __ATOMIC_RELAXED, __HIP_MEMORY_SCOPE_AGENT);
                asm volatile("" ::: "memory"); }
    }
};

#define XB_TMO      128
#define XB_XCNT(j)  (256  + 64 * (j))
#define XB_XSUB(j)  (1280 + 64 * (j))
#define XB_XGEN(j)  (2304 + 64 * (j))
#define XB_TOP      3328
#define XB_TOPGEN   3392
#define XCD_BAR_WORDS 3456
#define XB_SPIN_CAP (1u << 18)
__device__ __forceinline__ unsigned xb_ld(unsigned* p)              { return __hip_atomic_load(p, __ATOMIC_RELAXED, __HIP_MEMORY_SCOPE_AGENT); }
__device__ __forceinline__ unsigned xb_add(unsigned* p, unsigned v) { return __hip_atomic_fetch_add(p, v, __ATOMIC_RELAXED, __HIP_MEMORY_SCOPE_AGENT); }
__device__ __forceinline__ unsigned xb_xcc_id() { return (unsigned)__builtin_amdgcn_s_getreg((3 << 11) | 20) & 0xFu; }
#define XB_SPIN(cond, bar) do { unsigned _sp = 0; while (cond) { __builtin_amdgcn_s_sleep(1); \
    if ((++_sp & 255u) == 0u) { if (xb_ld(&(bar)[XB_TMO])) break; if (_sp > XB_SPIN_CAP) { atomicAdd(&(bar)[XB_TMO], 1u); break; } } } } while (0)
struct XcdBarrier { unsigned* bar; unsigned x; volatile LAS unsigned* st; };
__device__ __forceinline__ XcdBarrier xcd_barrier_post(unsigned* bar, volatile LAS unsigned* st) {
    XcdBarrier b; b.bar = bar; b.x = xb_xcc_id(); b.st = st;
    if (threadIdx.x == 0) (void)xb_add(&bar[XB_XCNT(b.x)], 1u);
    return b;
}
__device__ __forceinline__ void xcd_barrier_complete(unsigned* bar, unsigned x, unsigned& nloc, unsigned& nx) {
    const unsigned G = gridDim.x * gridDim.y * gridDim.z;
    unsigned sum, cnt, mine, sp = 0u;
    for (;;) {
        sum = 0u; cnt = 0u; mine = 0u;
#pragma unroll
        for (unsigned j = 0; j < 16; ++j) { const unsigned c = xb_ld(&bar[XB_XCNT(j)]); sum += c; cnt += (c > 0u) ? 1u : 0u; mine = (j == x) ? c : mine; }
        if (sum == G) break;
        __builtin_amdgcn_s_sleep(1);
        if ((++sp & 255u) == 0u) { if (xb_ld(&bar[XB_TMO])) break; if (sp > XB_SPIN_CAP) { atomicAdd(&bar[XB_TMO], 1u); break; } }
    }
    nloc = mine > 0u ? mine : 1u; nx = cnt > 0u ? cnt : 1u;
}
__device__ __forceinline__ void xcd_barrier(const XcdBarrier& b) {
    asm volatile("s_waitcnt vmcnt(0)" ::: "memory");
    __syncthreads();
    if (fresh_tid() == 0) {
        unsigned* bar = b.bar;
        __builtin_amdgcn_s_waitcnt(0);
        unsigned nloc = b.st[0], nx = b.st[1];
        if (nloc == 0u) { xcd_barrier_complete(bar, b.x, nloc, nx); b.st[0] = nloc; b.st[1] = nx; }
        const unsigned old = xb_add(&bar[XB_XSUB(b.x)], 1u);
        const unsigned gen = old / nloc;
        if (old + 1u == (gen + 1u) * nloc) {
            __builtin_amdgcn_fence(__ATOMIC_RELEASE, "agent");
            asm volatile("s_waitcnt vmcnt(0)" ::: "memory");
            const unsigned og = xb_add(&bar[XB_TOP], 1u);
            const unsigned tg = og / nx;
            if (og + 1u == (tg + 1u) * nx) xb_add(&bar[XB_TOPGEN], 1u);
            else XB_SPIN(xb_ld(&bar[XB_TOPGEN]) == tg, bar);
            __builtin_amdgcn_fence(__ATOMIC_ACQUIRE, "agent");
            xb_add(&bar[XB_XGEN(b.x)], 1u);
            asm volatile("s_waitcnt vmcnt(0)" ::: "memory");
        } else {
            XB_SPIN(xb_ld(&bar[XB_XGEN(b.x)]) == gen, bar);
            __builtin_amdgcn_fence(__ATOMIC_ACQUIRE, "agent");
            asm volatile("s_waitcnt vmcnt(0)" ::: "memory");
        }
    }
    __syncthreads();
}

struct Frame {
    LAS unsigned char* lds;
    int tid, lane, wave, G, bx;
};


__device__ __forceinline__ int in_srccol(int n) {
    const int tile = n >> 8, r = n & 255;
    if (tile < 8 || tile == 12 || tile == 13) return n;
    if (tile < 12) { const int i = tile - 8; return (r < 128 ? 2048 : 2560) + 128 * i + (r & 127); }
    const int i = tile - 14; return (r < 128 ? 3584 : 4608) + 128 * i + (r & 127);
}

__device__ __forceinline__ void transpose_item(const float* W, int ldw, int srccol0, int k0, bf16_t* WT, int dstrow0, int dstk0, LAS float* scr, int lane) {
    float tv[32];
#pragma unroll
    for (int i = 0; i < 32; ++i) { const int kk = 2 * i + (lane >> 5); tv[i] = W[(size_t)(k0 + kk) * ldw + srccol0 + (lane & 31)]; }
#pragma unroll
    for (int i = 0; i < 32; ++i) { const int kk = 2 * i + (lane >> 5); scr[kk * 33 + (lane & 31)] = tv[i]; }
    LDS_WAIT(); asm volatile("" ::: "memory");
    const int c = lane & 7;
#pragma unroll
    for (int j = 0; j < 4; ++j) { const int n = (lane >> 3) + 8 * j; const LAS float* s = scr + (8 * c) * 33 + n;
        u32x4 o; o.x = pk2(s[0 * 33], s[1 * 33]); o.y = pk2(s[2 * 33], s[3 * 33]); o.z = pk2(s[4 * 33], s[5 * 33]); o.w = pk2(s[6 * 33], s[7 * 33]);
        *(GAS u32x4*)(WT + (size_t)(dstrow0 + n) * 1024 + dstk0 + 8 * c) = o; }
    LDS_WAIT(); asm volatile("" ::: "memory");
}

__device__ __forceinline__ void mod_task(Frame& F, int t) {
    const int l = t / 48, j0 = (t % 48) * 64;
    const float* c_ctx = kin(I_C_CTX); const float* cvec = kin(I_C); const float* w_ada = kin(I_W_ADA); const float* b_ada = kin(I_B_ADA); float* MOD = WSP(float, WS_MOD);
    LAS float* sv = (LAS float*)F.lds;
    LAS float* part = (LAS float*)(F.lds + 20480);
    for (int i = F.tid; i < 5 * 1024; i += 512) { const int g = i >> 10, k = i & 1023; const float c = (g == 0) ? c_ctx[k] : cvec[(g - 1) * 1024 + k]; sv[i] = silu_f(c); }
    __syncthreads();
    const float* W = w_ada + (size_t)l * 1024 * 3072 + (size_t)(128 * F.wave) * 3072 + j0 + F.lane;
    float a0 = 0.f, a1 = 0.f, a2 = 0.f, a3 = 0.f, a4 = 0.f;
#pragma unroll 32
    for (int kk = 0; kk < 128; ++kk) { const float wv = W[(size_t)kk * 3072]; const int k = 128 * F.wave + kk;
        a0 += sv[k] * wv; a1 += sv[1024 + k] * wv; a2 += sv[2048 + k] * wv; a3 += sv[3072 + k] * wv; a4 += sv[4096 + k] * wv; }
    part[(F.wave * 5 + 0) * 64 + F.lane] = a0; part[(F.wave * 5 + 1) * 64 + F.lane] = a1; part[(F.wave * 5 + 2) * 64 + F.lane] = a2;
    part[(F.wave * 5 + 3) * 64 + F.lane] = a3; part[(F.wave * 5 + 4) * 64 + F.lane] = a4;
    __syncthreads();
    if (F.tid < 320) { const int g = F.tid >> 6, ln = F.tid & 63; float s = 0.f;
#pragma unroll
        for (int w = 0; w < 8; ++w) s += part[(w * 5 + g) * 64 + ln];
        MOD[(l * 5 + g) * 3072 + j0 + ln] = s + b_ada[l * 3072 + j0 + ln]; }
    __syncthreads();
}

__device__ __forceinline__ void wt_items(Frame& F, int l, int w0, int nw);
__device__ __forceinline__ void p0_prologue(Frame& F) {
    if (F.bx < 96) mod_task(F, F.bx);
    const int gw = F.bx * 8 + F.wave, NGW = F.G * 8;
    const int gt = F.bx * 512 + F.tid, NGT = F.G * 512;
    { float* BIASP = WSP(float, WS_BIASP); const float* b_in = kin(I_B_IN);
      for (int i = gt; i < DEPTH * DIN; i += NGT) { const int l = i / DIN, n = i % DIN; BIASP[i] = b_in[l * DIN + in_srccol(n)]; } }
    const float* cache_k = kin(I_CACHE_K); const float* cache_v = kin(I_CACHE_V); bf16_t* CK = WSP(bf16_t, WS_CK); bf16_t* CV = WSP(bf16_t, WS_CV);
    for (int i0 = gt; i0 < 2 * 131072; i0 += 2 * NGT) { f32x4 a[2], b[2];
#pragma unroll
        for (int k = 0; k < 2; ++k) { const int i = i0 + k * NGT; if (i < 2 * 131072) { const int which = i >> 17, e = (i & 131071) * 8; const float* src = (which ? cache_v : cache_k) + e; a[k] = *(const f32x4*)src; b[k] = *(const f32x4*)(src + 4); } }
#pragma unroll
        for (int k = 0; k < 2; ++k) { const int i = i0 + k * NGT; if (i < 2 * 131072) { const int which = i >> 17, e = (i & 131071) * 8; bf16_t* dst = (which ? CV : CK) + e;
            u32x4 w; w.x = pk2(a[k][0], a[k][1]); w.y = pk2(a[k][2], a[k][3]); w.z = pk2(b[k][0], b[k][1]); w.w = pk2(b[k][2], b[k][3]); *(u32x4*)dst = w; } } }
    wt_items(F, 0, gw, NGW);
    { const int nidle = F.G - (M - 46 * 256) / 128 * (DIN / 256); if (nidle <= 0) wt_items(F, 1, gw, NGW); }
}

__device__ __forceinline__ void wt_items(Frame& F, int l, int w0, int nw) {
    LAS float* scr = (LAS float*)(F.lds + F.wave * 16384);
    const float* w_in = kin(I_W_IN); const float* w_proj_a = kin(I_W_PROJ_A); const float* w_proj_b = kin(I_W_PROJ_B); const float* w_out = kin(I_W_OUT);
    bf16_t* WTIN = WSP(bf16_t, WS_WTIN); bf16_t* WTPROJ = WSP(bf16_t, WS_WTPROJ); bf16_t* WTOUT = WSP(bf16_t, WS_WTOUT);
    constexpr int I_IN = 16 * 176, I_P = 8 * 32, I_O = 16 * 32, I_L = I_IN + 2 * I_P + I_O;
    for (int it = w0; it < I_L; it += nw) {
        int r = it;
        if (r < I_IN) { const int kb = r / 176, nb = r % 176; transpose_item(w_in + (size_t)l * D * DIN, DIN, in_srccol(32 * nb), 64 * kb, WTIN + (size_t)l * DIN * D, 32 * nb, 64 * kb, scr, F.lane); continue; } r -= I_IN;
        if (r < I_P) { const int kb = r / 32, nb = r % 32; transpose_item(w_proj_a + (size_t)l * 512 * D, D, 32 * nb, 64 * kb, WTPROJ + (size_t)l * D * D, 32 * nb, 64 * kb, scr, F.lane); continue; } r -= I_P;
        if (r < I_P) { const int kb = r / 32, nb = r % 32; transpose_item(w_proj_b + (size_t)l * 512 * D, D, 32 * nb, 64 * kb, WTPROJ + (size_t)l * D * D, 32 * nb, 512 + 64 * kb, scr, F.lane); continue; } r -= I_P;
        { const int kb = r / 32, nb = r % 32; transpose_item(w_out + (size_t)l * D * D, D, 32 * nb, 64 * kb, WTOUT + (size_t)l * D * D, 32 * nb, 64 * kb, scr, F.lane); }
    }
}

__device__ __forceinline__ void norm_phase(Frame& F, int layer) {
    const int gw = F.bx * 8 + F.wave, NGW = F.G * 8;
    const float* xa = layer == 0 ? kin(I_X_PROMPT) : kout(); const float* xb = layer == 0 ? kin(I_X_SAMPLE) : kout() + (size_t)NCTX * D;
    const float* MOD = WSP(float, WS_MOD); const float* rms_g = kin(I_RMS_G) + layer * D; bf16_t* H = WSP(bf16_t, WS_H);
    for (int rb = gw; rb < M; rb += 3 * NGW) {
        f32x4 v[3][4];
#pragma unroll
        for (int k = 0; k < 3; ++k) { const int r = rb + k * NGW; if (r < M) {
            const float* xrow = r < NCTX ? xa + (size_t)r * D : xb + (size_t)(r - NCTX) * D; const f32x4* xr = (const f32x4*)xrow + F.lane;
#pragma unroll
            for (int j = 0; j < 4; ++j) v[k][j] = xr[64 * j]; } }
#pragma unroll
        for (int k = 0; k < 3; ++k) { const int r = rb + k * NGW; if (r < M) {
            const int g = r < NCTX ? 0 : 1 + ((r - NCTX) >> 11);
            const float* mod = MOD + (layer * 5 + g) * 3072;
            float s = 0.f;
#pragma unroll
            for (int j = 0; j < 4; ++j) s += (v[k][j][0] * v[k][j][0] + v[k][j][1] * v[k][j][1]) + (v[k][j][2] * v[k][j][2] + v[k][j][3] * v[k][j][3]);
            const float rstd = rsqrtf(wave_sum(s) * (1.f / D) + EPS);
            unsigned long long* o8 = (unsigned long long*)(H + (size_t)r * D) + F.lane;
#pragma unroll
            for (int j = 0; j < 4; ++j) { const int c = 4 * F.lane + 256 * j;
                const f32x4 gg = *(const f32x4*)(rms_g + c), sh = *(const f32x4*)(mod + c), sc = *(const f32x4*)(mod + 1024 + c);
                const f32x4 y = v[k][j] * rstd * gg * (sc + 1.0f) + sh;
                o8[64 * j] = (unsigned long long)cvt_pk_bf16(y[0], y[1]) | ((unsigned long long)cvt_pk_bf16(y[2], y[3]) << 32); } } }
    }
}

__device__ __forceinline__ void final_norm_phase(Frame& F) {
    const int gw = F.bx * 8 + F.wave, NGW = F.G * 8;
    float* out = kout(); const bf16_t* XF = WSP(bf16_t, WS_YAB); const float* rss = WSP(float, WS_RSS2);
    for (int rb = gw; rb < M; rb += 3 * NGW) {
        u32x2 v[3][4]; float sq[3];
#pragma unroll
        for (int k = 0; k < 3; ++k) { const int r = rb + k * NGW; if (r < M) { const u32x2* xr = (const u32x2*)(XF + (size_t)r * D) + F.lane; sq[k] = rss[r];
#pragma unroll
            for (int j = 0; j < 4; ++j) v[k][j] = xr[64 * j]; } }
#pragma unroll
        for (int k = 0; k < 3; ++k) { const int r = rb + k * NGW; if (r < M) { f32x4* yr = (f32x4*)(out + (size_t)r * D) + F.lane;
            const float rstd = rsqrtf(sq[k] * (1.f / D) + EPS);
#pragma unroll
            for (int j = 0; j < 4; ++j) yr[64 * j] = (f32x4){bflo(v[k][j].x), bfhi(v[k][j].x), bflo(v[k][j].y), bfhi(v[k][j].y)} * rstd; } }
    }
}

struct AttnPre { u32x4 qrow[4], pa0, pc0, pa1, kreg, vreg; float bvv[8]; };
__device__ __forceinline__ void attn_prefetch(Frame& F, int layer, int task, const bool ctx, AttnPre& P);
__device__ __forceinline__ void conv_task(Frame& F, int layer, int tile, AttnPre& pre, int pre_task) {
    const int t0 = tile * 32;
    int s0, s1; if (t0 < NCTX) { s0 = t0 & ~255; s1 = s0 + 256; } else { s0 = NCTX + ((t0 - NCTX) & ~2047); s1 = s0 + 2048; }
    const bf16_t* Ub = WSP(bf16_t, WS_U); const bf16_t* SZB = WSP(bf16_t, WS_SZB); bf16_t* YAB = WSP(bf16_t, WS_YAB);
    const float* dw_w = kin(I_DW_W); const float* dw_b = kin(I_DW_B); const float* ln_g = kin(I_LN_G) + layer * 512; const float* ln_b = kin(I_LN_B) + layer * 512;
    LAS unsigned* Ul = (LAS unsigned*)F.lds;
    LAS float* Cl = (LAS float*)(F.lds + 62 * 1024);
    u32x4 xs[8];
#pragma unroll
    for (int k = 0; k < 8; ++k) { const int i = F.tid + 512 * k; const int lr = i >> 6, ch = i & 63; const int t = t0 - 15 + lr; xs[k] = (u32x4){0u, 0u, 0u, 0u};
        if (i < 62 * 64 && t >= s0 && t < s1) xs[k] = *(const u32x4*)(Ub + (size_t)t * 512 + ch * 8); }
    const int cp = F.tid & 255, th = F.tid >> 8;
    float w0[31], w1[31];
#pragma unroll
    for (int j = 0; j < 31; ++j) { const f32x2 w = *(const f32x2*)(dw_w + (size_t)(layer * 31 + j) * 512 + 2 * cp); w0[j] = w[0]; w1[j] = w[1]; }
    const f32x2 bb = *(const f32x2*)(dw_b + layer * 512 + 2 * cp);
    u32x2 zq[4][2];
#pragma unroll
    for (int k = 0; k < 4; ++k) { const int t = t0 + F.wave * 4 + k; zq[k][0] = *(const u32x2*)(SZB + (size_t)t * 512 + 4 * F.lane); zq[k][1] = *(const u32x2*)(SZB + (size_t)t * 512 + 256 + 4 * F.lane); }
#pragma unroll
    for (int k = 0; k < 8; ++k) { const int i = F.tid + 512 * k; if (i < 62 * 64) *(LAS u32x4*)(Ul + (i >> 6) * 256 + (i & 63) * 4) = xs[k]; }
    __syncthreads();
    {
        for (int blk = 0; blk < 4; ++blk) { const int tt0 = th * 16 + blk * 4;
            float a0[4], a1[4];
#pragma unroll
            for (int o = 0; o < 4; ++o) { a0[o] = bb[0]; a1[o] = bb[1]; }
#pragma unroll
            for (int i = 0; i < 34; ++i) { const unsigned x = Ul[(tt0 + i) * 256 + cp]; const float x0 = bflo(x), x1 = bfhi(x);
#pragma unroll
                for (int o = 0; o < 4; ++o) { const int j = i - o; if (j >= 0 && j < 31) { a0[o] += w0[j] * x0; a1[o] += w1[j] * x1; } } }
#pragma unroll
            for (int o = 0; o < 4; ++o) *(LAS f32x2*)(Cl + (tt0 + o) * 512 + 2 * cp) = (f32x2){a0[o], a1[o]};
        }
    }
    __syncthreads();
    const f32x4 g0 = *(const f32x4*)(ln_g + 4 * F.lane), g1 = *(const f32x4*)(ln_g + 256 + 4 * F.lane);
    const f32x4 b0 = *(const f32x4*)(ln_b + 4 * F.lane), b1 = *(const f32x4*)(ln_b + 256 + 4 * F.lane);
    asm volatile("" ::: "memory");
    if (pre_task >= 0) attn_prefetch(F, layer, pre_task, false, pre);
    asm volatile("" ::: "memory");
#pragma unroll
    for (int k = 0; k < 4; ++k) { const int tt = F.wave * 4 + k, t = t0 + tt;
        f32x4 v0 = *(LAS f32x4*)(Cl + tt * 512 + 4 * F.lane), v1 = *(LAS f32x4*)(Cl + tt * 512 + 256 + 4 * F.lane);
        const float mean = wave_sum((v0[0] + v0[1]) + (v0[2] + v0[3]) + (v1[0] + v1[1]) + (v1[2] + v1[3])) * (1.f / 512.f);
        v0 = v0 - mean; v1 = v1 - mean;
        const float var = wave_sum((v0[0] * v0[0] + v0[1] * v0[1]) + (v0[2] * v0[2] + v0[3] * v0[3]) + (v1[0] * v1[0] + v1[1] * v1[1]) + (v1[2] * v1[2] + v1[3] * v1[3])) * (1.f / 512.f);
        const float rstd = rsqrtf(var + EPS);
        f32x4 y0 = v0 * rstd * g0 + b0, y1 = v1 * rstd * g1 + b1;
        const u32x2 z0 = zq[k][0], z1 = zq[k][1];
        const f32x4 zz0 = (f32x4){bflo(z0.x), bfhi(z0.x), bflo(z0.y), bfhi(z0.y)}, zz1 = (f32x4){bflo(z1.x), bfhi(z1.x), bflo(z1.y), bfhi(z1.y)};
#pragma unroll
        for (int j = 0; j < 4; ++j) { y0[j] = silu_f(y0[j]) * zz0[j]; y1[j] = silu_f(y1[j]) * zz1[j]; }
        u32x2 o0, o1; o0.x = cvt_pk_bf16(y0[0], y0[1]); o0.y = cvt_pk_bf16(y0[2], y0[3]); o1.x = cvt_pk_bf16(y1[0], y1[1]); o1.y = cvt_pk_bf16(y1[2], y1[3]);
        *(u32x2*)(YAB + (size_t)t * 1024 + 512 + 4 * F.lane) = o0; *(u32x2*)(YAB + (size_t)t * 1024 + 768 + 4 * F.lane) = o1;
    }
    __syncthreads();
}

typedef float f32x16 __attribute__((ext_vector_type(16)));
typedef short s16x4 __attribute__((ext_vector_type(4)));
typedef __bf16 bf16x2_t __attribute__((ext_vector_type(2)));
__device__ __forceinline__ unsigned cvtpk_s(float lo, float hi) { f32x2 v = {lo, hi}; bf16x2_t b = __builtin_convertvector(v, bf16x2_t); return __builtin_bit_cast(unsigned, b); }
__device__ __forceinline__ s16x4 vtr(const LAS char* p) { return __builtin_bit_cast(s16x4, __builtin_amdgcn_ds_read_tr16_b64_v4i16((LAS s16x4*)p)); }
#define MFMA32(a, b, c) __builtin_amdgcn_mfma_f32_32x32x16_bf16((a), (b), (c), 0, 0, 0)
constexpr float LOG2E = 1.4426950408889634f;
constexpr float ATT_QSCALE = 0.125f * LOG2E;
constexpr int AT_SLOTB = 8192, AT_K = 0, AT_V = 3 * AT_SLOTB, AT_TBL = 6 * AT_SLOTB;
constexpr int AT_VSTRIDE = 68, AT_ROWF = 16 * AT_VSTRIDE + 52, AT_INF = AT_TBL + 15 * AT_ROWF * 4, AT_ZERO = AT_INF + 512, AT_END = AT_ZERO + 512;
static_assert(AT_END <= RING_BYTES, "attention LDS");
constexpr float ATT_THR = 8.0f;

#define ATT_DECODE() \
    int b, h, R0, r = 0, n_win = 0, lo = 0, qc = 0, r0 = 0; \
    if (!ctx) { const int R = 4 * (task & 7); h = (task >> 3) & 7; b = task >> 6; r = R + (wid >> 1); const int HALF = wid & 1; \
        R0 = NCTX + b * 2048 + r * 64 + HALF * 32; qc = HALF * 32 + r32; r0 = min(max(r - 4, 0), 24); \
        lo = min(max(R - 4, 0), 24); n_win = min(max(R - 1, 0), 24) + 8 - lo; \
    } else { h = task & 7; b = task >> 3; R0 = b * 256 + wid * 32; } \
    const int NT = n_win + 4; (void)qc; (void)r0; (void)r; (void)NT; \
    const unsigned ksoff = (unsigned)(lane * 512 + wid * 8), vsoff = (unsigned)((16 * (wid & 3) + (lane >> 2)) * 512 + (wid >> 2) * 32 + (lane & 3) * 8);
#define ATT_SRC(t, KP, VP) do { if ((t) < n_win) { const size_t o_ = (size_t)(NCTX + b * 2048 + (lo + (t)) * 64) * 512 + h * 64; KP = (const bf16_t*)(wsb + WS_K) + o_; VP = (const bf16_t*)(wsb + WS_V) + o_; } \
        else if (ctx) { const size_t o_ = (size_t)(b * 256 + ((t) - n_win) * 64) * 512 + h * 64; KP = (const bf16_t*)(wsb + WS_K) + o_; VP = (const bf16_t*)(wsb + WS_V) + o_; } \
        else { const size_t o_ = ((size_t)((b * 2 + layer) * 256 + ((t) - n_win) * 64)) * 512 + h * 64; KP = (const bf16_t*)(wsb + WS_CK) + o_; VP = (const bf16_t*)(wsb + WS_CV) + o_; } } while (0)
__device__ __forceinline__ void attn_prefetch(Frame& F, int layer, int task, const bool ctx, AttnPre& P) {
    const int tid = fresh_tid(), lane = tid & 63, r32 = lane & 31, wid = __builtin_amdgcn_readfirstlane(tid >> 6);
    unsigned char* wsb = kws();
    ATT_DECODE()
    { const bf16_t* qp = (const bf16_t*)(wsb + WS_Q) + (size_t)(R0 + (lane >> 3)) * 512 + h * 64 + (lane & 7) * 8;
#pragma unroll
      for (int i = 0; i < 4; ++i) P.qrow[i] = *(const u32x4*)(qp + (size_t)i * 8 * 512); }
    { const bf16_t *k0, *v0, *k1, *v1, *k2, *v2; ATT_SRC(0, k0, v0); ATT_SRC(1, k1, v1); ATT_SRC(2, k2, v2); (void)v2;
      P.pa0 = *(const u32x4*)(k0 + ksoff); P.pc0 = *(const u32x4*)(v0 + vsoff); P.pa1 = *(const u32x4*)(k1 + ksoff);
      P.kreg = *(const u32x4*)(k2 + ksoff); P.vreg = *(const u32x4*)(v1 + vsoff); }
    if (!ctx) { const float* rb = kin(I_REL_BIAS) + (size_t)(layer * 8 + h) * 465;
#pragma unroll
        for (int k = 0; k < 8; ++k) { const int i = tid + 512 * k, dr = i >> 8, v = (i >> 4) & 15, j = i & 15; P.bvv[k] = (i < 3840) ? rb[dr * 31 + v + j] : 0.f; } }
}

__device__ __forceinline__ void attn_wg(Frame& F, int layer, int task, const bool ctx, AttnPre& P, int next_ctx) {
    const int tid = fresh_tid(), lane = tid & 63, r32 = lane & 31, hi = lane >> 5, wid = __builtin_amdgcn_readfirstlane(tid >> 6);
    LAS char* L = (LAS char*)F.lds;
    unsigned char* wsb = kws();
    ATT_DECODE()
    const int kdst = AT_K + wid * 1024 + lane * 16, vdst = AT_V + wid * 1024 + lane * 16;
    u32x4 kreg = P.kreg, vreg = P.vreg;
    bf16x8 qr[4];
    { LAS char* stg = L + AT_TBL + wid * 4608; LAS char* srow = stg + (lane >> 3) * 144 + (lane & 7) * 16;
#pragma unroll
      for (int i = 0; i < 4; ++i) *(LAS u32x4*)(srow + i * 8 * 144) = P.qrow[i];
      asm volatile("s_waitcnt lgkmcnt(0)" ::: "memory");
#pragma unroll
      for (int s_ = 0; s_ < 4; ++s_) qr[s_] = *(const LAS bf16x8*)(stg + r32 * 144 + hi * 16 + s_ * 32);
      asm volatile("s_waitcnt lgkmcnt(0)" ::: "memory"); }
    { unsigned zz = 0u; asm volatile("" : "+v"(zz));
      if (tid < 32) *(LAS u32x4*)(L + AT_ZERO + 16 * tid) = (u32x4){zz, zz, zz, zz}; }
    if (!ctx) { unsigned ninf = 0xff800000u; asm volatile("" : "+v"(ninf));
        for (int i = lane; i < 4608 / 16; i += 64) *(LAS u32x4*)(L + AT_TBL + wid * 4608 + 16 * i) = (u32x4){ninf, ninf, ninf, ninf};
        for (int i = 8 * 4608 / 16 + tid; i < (AT_ZERO - AT_TBL) / 16; i += 512) *(LAS u32x4*)(L + AT_TBL + 16 * i) = (u32x4){ninf, ninf, ninf, ninf}; }
    *(LAS u32x4*)(L + kdst) = P.pa0; *(LAS u32x4*)(L + vdst) = P.pc0; *(LAS u32x4*)(L + AT_SLOTB + kdst) = P.pa1;
    if (!ctx) {
        asm volatile("s_waitcnt lgkmcnt(0)\n\ts_barrier" ::: "memory");
#pragma unroll
        for (int k = 0; k < 8; ++k) { const int i = tid + 512 * k, dr = i >> 8, v = (i >> 4) & 15, j = i & 15; if (i < 3840) *(LAS float*)(L + AT_TBL + (dr * AT_ROWF + v * AT_VSTRIDE + 48 + j) * 4) = P.bvv[k] * LOG2E; }
    }
    const int HALFW = ctx ? 0 : (wid & 1);
    const LAS char* kpA = L + AT_K + hi * 1024 + (32 * HALFW + r32) * 16;
    const LAS char* kpB = L + AT_K + hi * 1024 + (32 * (1 - HALFW) + ((r32 + 24 * HALFW) & 31)) * 16;
    const LAS char* vp0 = L + AT_V + ((lane >> 4) & 1) * 32 + (lane & 3) * 8 + (4 * hi + ((lane & 15) >> 2)) * 64;
    const int H2 = HALFW * 2048, O2 = (1 - HALFW) * 2048, rot = 3 * HALFW;
    const int vol0 = H2, voh0 = H2 + 512, vol1 = H2 + 1024, voh1 = H2 + 1536;
    const int vol2 = O2 + ((0 + rot) & 3) * 512, voh2 = O2 + ((1 + rot) & 3) * 512, vol3 = O2 + ((2 + rot) & 3) * 512, voh3 = O2 + ((3 + rot) & 3) * 512;
    const int vsh = (qc < 8 ? 8 - qc : (qc > 56 ? 56 - qc : 0)) + 7;
    const int tlane = AT_TBL + (67 * vsh + 4 * hi - qc + 63) * 4;
    const int offA = 128 * HALFW, offB = HALFW ? 96 : 128;
    const int NWP = n_win + ((n_win > 0 && ((n_win - 1) & 1)) ? 1 : 0), NTV = NWP + 4;
#define VT(t) ((t) < n_win ? (t) : ((t) < NWP ? n_win - 1 : (t) - (NWP - n_win)))
    float mhat = -INFINITY, l_reg = 0.f, fres = 1.f; bool resc = false;
    f32x16 o0, o1;
#pragma unroll
    for (int i = 0; i < 16; ++i) { o0[i] = 0.f; o1[i] = 0.f; }
    f32x16 pA0, pA1, pB0, pB1; bf16x8 kf[8]; s16x4 vlo[8], vhi[8]; u32x4 pw0, pw1, pw2, pw3;
#pragma unroll
    for (int i = 0; i < 16; ++i) { pA1[i] = 0.f; pB1[i] = 0.f; }
    int sl_prev = 0, sl_cur = 0, sl_next = AT_SLOTB;
#define SBAR() __builtin_amdgcn_sched_barrier(0)
#define PIN(x) asm volatile("" : "+v"(x))
#define WBAR() asm volatile("s_waitcnt lgkmcnt(0)\n\ts_barrier" ::: "memory")
#define ROT() do { sl_prev = sl_cur; sl_cur = sl_next; sl_next = (sl_next == 2 * AT_SLOTB) ? 0 : sl_next + AT_SLOTB; } while (0)
#define MX3(a, b, c) __builtin_fmaxf(__builtin_fmaxf((a), (b)), (c))
#define KLD2(so, j) do { kf[2 * (j)] = *(const LAS bf16x8*)(kpA + (so) + (j) * 2048); kf[2 * (j) + 1] = *(const LAS bf16x8*)(kpB + (so) + (j) * 2048); } while (0)
#define CADDR(tt) (((tt) < n_win && (unsigned)(lo + (tt) - r0) < 8u) ? tlane + (lo + (tt) - r + 7) * (AT_ROWF * 4) : AT_INF)
#define CLDA(X0, q) do { const int ro_ = (((2 * (q)) & 3) + 8 * ((2 * (q)) >> 2)) * 4; X0[2 * (q)] = *(const LAS float*)(L + cad + offA + ro_); X0[2 * (q) + 1] = *(const LAS float*)(L + cad + offA + ro_ + 4); } while (0)
#define CLDB(X1, q) do { X1[2 * (q)] = *(const LAS float*)(L + cad + offB + 8 * (q)); X1[2 * (q) + 1] = *(const LAS float*)(L + cad + offB + 8 * (q) + 4); } while (0)
#define DEC_TAIL() do { { auto rr_ = __builtin_amdgcn_permlane32_swap(__float_as_uint(rm_), __float_as_uint(rm_), false, false); rm_ = __builtin_fmaxf(__uint_as_float(rr_[0]), __uint_as_float(rr_[1])); } \
        resc = false; \
        if (__builtin_amdgcn_ballot_w64(rm_ > mhat + ATT_THR) != 0ull) { const float mn_ = __builtin_fmaxf(mhat, rm_); fres = __builtin_amdgcn_exp2f(mhat - mn_); l_reg *= fres; mhat = mn_; resc = true; } \
        nmh = (mhat == -INFINITY) ? 0.f : -mhat; } while (0)
#define DECIDE_D(C0, C1) do { float a_ = MX3(C0[0], C0[1], C1[0]), b_ = MX3(C0[2], C0[3], C1[1]); a_ = MX3(a_, C1[2], C1[3]); \
        _Pragma("unroll") for (int r_ = 4; r_ < 16; r_ += 4) { a_ = MX3(a_, C0[r_], C0[r_ + 1]); b_ = MX3(b_, C0[r_ + 2], C0[r_ + 3]); a_ = MX3(a_, C1[r_], C1[r_ + 1]); b_ = MX3(b_, C1[r_ + 2], C1[r_ + 3]); } \
        float rm_ = __builtin_fmaxf(a_, b_); DEC_TAIL(); } while (0)
#define DECIDE_W(C0, C1) do { float a_ = MX3(C0[0], C0[1], C1[0]), b_ = MX3(C0[2], C0[3], C1[1]); a_ = MX3(a_, C1[2], C1[3]); \
        _Pragma("unroll") for (int r_ = 4; r_ < 16; r_ += 4) { a_ = MX3(a_, C0[r_], C0[r_ + 1]); b_ = MX3(b_, C0[r_ + 2], C0[r_ + 3]); } \
        float rm_ = __builtin_fmaxf(a_, b_); DEC_TAIL(); } while (0)
#define RESC() do { if (resc) { _Pragma("unroll") for (int r_ = 0; r_ < 16; ++r_) { o0[r_] *= fres; o1[r_] *= fres; } } } while (0)
#define EX(v) __builtin_amdgcn_exp2f((v) + nmh)
#define PKW(P, i) cvtpk_s(P[i], P[(i) + 1])
#define PAF(k) __builtin_bit_cast(bf16x8, pw##k)
#define VFR(i) (bf16x8){vlo[i][0], vlo[i][1], vlo[i][2], vlo[i][3], vhi[i][0], vhi[i][1], vhi[i][2], vhi[i][3]}
#define VRD(i, s) do { vlo[i] = vtr(vp_ + (((i) >> 2) * 4096 + vol##s)); vhi[i] = vtr(vp_ + (((i) >> 2) * 4096 + voh##s)); } while (0)
#define GAPA(MF, a0, a1, a2, a3, W0, W1, PW) do { MF; sacc += a0; sacc += a1; sacc += a2; sacc += a3; PIN(sacc); W0; W1; PIN(PW); SBAR(); } while (0)
#define GAPM(MF) do { MF; SBAR(); } while (0)
#define GAPB(MF, X, i) do { MF; X[i] = EX(X[i]); X[(i) + 1] = EX(X[(i) + 1]); X[(i) + 2] = EX(X[(i) + 2]); X[(i) + 3] = EX(X[(i) + 3]); PIN(X); SBAR(); } while (0)
#define EXG(X, i) do { X[i] = EX(X[i]); X[(i) + 1] = EX(X[(i) + 1]); X[(i) + 2] = EX(X[(i) + 2]); X[(i) + 3] = EX(X[(i) + 3]); PIN(X); SBAR(); } while (0)
#define STAGE(t) do { *(LAS u32x4*)(L + sl_prev + kdst) = kreg; *(LAS u32x4*)(L + sl_next + vdst) = vreg; \
        { const int tk_ = VT(min((t) + 3, NTV - 1)), tv_ = VT(min((t) + 2, NTV - 1)); const bf16_t *kp_, *vq_, *kq_, *vv_; ATT_SRC(tk_, kp_, vq_); ATT_SRC(tv_, kq_, vv_); (void)vq_; (void)kq_; \
          kreg = *(const u32x4*)(kp_ + ksoff); vreg = *(const u32x4*)(vv_ + vsoff); } SBAR(); } while (0)
#define QK0(C0, CZ) C0 = (CZ) ? MFMA32(kf[0], qr[0], zero16) : MFMA32(kf[0], qr[0], C0)
#define QK1(C1, CZ) C1 = (CZ) ? MFMA32(kf[1], qr[0], zero16) : MFMA32(kf[1], qr[0], C1)
#define PHASEA_PW(C0, C1, P0, P1, CZ) do { \
    VRD(0, 0); SBAR(); float sacc = P0[0] + P0[1]; \
                       GAPA(QK0(C0, CZ), P0[2], P0[3], P0[4], P0[5],     pw0[0] = PKW(P0, 0),  pw0[1] = PKW(P0, 2),  pw0); \
    VRD(4, 0); SBAR(); GAPA(QK1(C1, CZ), P0[6], P0[7], P0[8], P0[9],     pw0[2] = PKW(P0, 4),  pw0[3] = PKW(P0, 6),  pw0); \
    VRD(1, 1); SBAR(); GAPA(C0 = MFMA32(kf[2], qr[1], C0), P0[10], P0[11], P0[12], P0[13], pw1[0] = PKW(P0, 8),  pw1[1] = PKW(P0, 10), pw1); \
    VRD(5, 1); SBAR(); GAPA(C1 = MFMA32(kf[3], qr[1], C1), P0[14], P0[15], P1[0], P1[1],   pw1[2] = PKW(P0, 12), pw1[3] = PKW(P0, 14), pw1); \
    VRD(2, 2); SBAR(); GAPA(C0 = MFMA32(kf[4], qr[2], C0), P1[2], P1[3], 0.f, 0.f,         pw2[0] = PKW(P1, 0),  pw2[1] = PKW(P1, 2),  pw2); \
    VRD(6, 2); SBAR(); GAPM(C1 = MFMA32(kf[5], qr[2], C1)); pw2[2] = 0u; pw2[3] = 0u; \
                       GAPM(C0 = MFMA32(kf[6], qr[3], C0)); GAPM(C1 = MFMA32(kf[7], qr[3], C1)); \
    l_reg += sacc; } while (0)
#define PHASEA_PD(C0, C1, P0, P1, CZ) do { \
    VRD(0, 0); SBAR(); float sacc = P0[0] + P0[1]; \
                       GAPA(QK0(C0, CZ), P0[2], P0[3], P0[4], P0[5],     pw0[0] = PKW(P0, 0),  pw0[1] = PKW(P0, 2),  pw0); \
    VRD(4, 0); SBAR(); GAPA(QK1(C1, CZ), P0[6], P0[7], P0[8], P0[9],     pw0[2] = PKW(P0, 4),  pw0[3] = PKW(P0, 6),  pw0); \
    VRD(1, 1); SBAR(); GAPA(C0 = MFMA32(kf[2], qr[1], C0), P0[10], P0[11], P0[12], P0[13], pw1[0] = PKW(P0, 8),  pw1[1] = PKW(P0, 10), pw1); \
    VRD(5, 1); SBAR(); GAPA(C1 = MFMA32(kf[3], qr[1], C1), P0[14], P0[15], P1[0], P1[1],   pw1[2] = PKW(P0, 12), pw1[3] = PKW(P0, 14), pw1); \
    VRD(2, 2); SBAR(); GAPA(C0 = MFMA32(kf[4], qr[2], C0), P1[2], P1[3], P1[4], P1[5],     pw2[0] = PKW(P1, 0),  pw2[1] = PKW(P1, 2),  pw2); \
    VRD(6, 2); SBAR(); GAPA(C1 = MFMA32(kf[5], qr[2], C1), P1[6], P1[7], P1[8], P1[9],     pw2[2] = PKW(P1, 4),  pw2[3] = PKW(P1, 6),  pw2); \
    VRD(3, 3); SBAR(); GAPA(C0 = MFMA32(kf[6], qr[3], C0), P1[10], P1[11], P1[12], P1[13], pw3[0] = PKW(P1, 8),  pw3[1] = PKW(P1, 10), pw3); \
    VRD(7, 3); SBAR(); GAPA(C1 = MFMA32(kf[7], qr[3], C1), P1[14], P1[15], 0.f, 0.f,       pw3[2] = PKW(P1, 12), pw3[3] = PKW(P1, 14), pw3); \
    l_reg += sacc; } while (0)
#define STEP_WW(C0, C1, P0, P1, t) do { SBAR(); const LAS char* vp_ = vp0 + sl_prev; const int cad = CADDR((t) + 1); \
    PHASEA_PW(C0, C1, P0, P1, false); STAGE(t); float nmh; DECIDE_W(C0, C1); SBAR(); \
                               GAPB(o0 = MFMA32(VFR(0), PAF(0), o0), C0, 0);  CLDA(P0, 0); CLDA(P0, 1); SBAR(); \
                               GAPB(o1 = MFMA32(VFR(4), PAF(0), o1), C0, 4);  CLDA(P0, 2); CLDA(P0, 3); SBAR(); \
    KLD2(sl_next, 0); SBAR();  GAPB(o0 = MFMA32(VFR(1), PAF(1), o0), C0, 8);  CLDA(P0, 4); CLDA(P0, 5); SBAR(); \
    KLD2(sl_next, 1); SBAR();  GAPB(o1 = MFMA32(VFR(5), PAF(1), o1), C0, 12); CLDA(P0, 6); CLDA(P0, 7); SBAR(); \
    KLD2(sl_next, 2); SBAR();  GAPB(o0 = MFMA32(VFR(2), PAF(2), o0), C1, 0);  CLDB(P1, 0); CLDB(P1, 1); SBAR(); \
    KLD2(sl_next, 3); SBAR();  GAPM(o1 = MFMA32(VFR(6), PAF(2), o1)); } while (0)
#define STEP_DW(C0, C1, P0, P1, t) do { SBAR(); const LAS char* vp_ = vp0 + sl_prev; \
    PHASEA_PW(C0, C1, P0, P1, true); STAGE(t); float nmh; DECIDE_D(C0, C1); SBAR(); \
                               GAPB(o0 = MFMA32(VFR(0), PAF(0), o0), C0, 0); \
                               GAPB(o1 = MFMA32(VFR(4), PAF(0), o1), C0, 4); \
    KLD2(sl_next, 0); SBAR();  GAPB(o0 = MFMA32(VFR(1), PAF(1), o0), C0, 8); \
    KLD2(sl_next, 1); SBAR();  GAPB(o1 = MFMA32(VFR(5), PAF(1), o1), C0, 12); \
    KLD2(sl_next, 2); SBAR();  GAPB(o0 = MFMA32(VFR(2), PAF(2), o0), C1, 0); \
    KLD2(sl_next, 3); SBAR();  GAPB(o1 = MFMA32(VFR(6), PAF(2), o1), C1, 4); \
                               EXG(C1, 8); EXG(C1, 12); } while (0)
#define STEP_DD(C0, C1, P0, P1, t) do { SBAR(); const LAS char* vp_ = vp0 + sl_prev; \
    PHASEA_PD(C0, C1, P0, P1, true); STAGE(t); float nmh; DECIDE_D(C0, C1); SBAR(); \
                               GAPB(o0 = MFMA32(VFR(0), PAF(0), o0), C0, 0); \
                               GAPB(o1 = MFMA32(VFR(4), PAF(0), o1), C0, 4); \
    KLD2(sl_next, 0); SBAR();  GAPB(o0 = MFMA32(VFR(1), PAF(1), o0), C0, 8); \
    KLD2(sl_next, 1); SBAR();  GAPB(o1 = MFMA32(VFR(5), PAF(1), o1), C0, 12); \
    KLD2(sl_next, 2); SBAR();  GAPB(o0 = MFMA32(VFR(2), PAF(2), o0), C1, 0); \
    KLD2(sl_next, 3); SBAR();  GAPB(o1 = MFMA32(VFR(6), PAF(2), o1), C1, 4); \
                               GAPB(o0 = MFMA32(VFR(3), PAF(3), o0), C1, 8); \
                               GAPB(o1 = MFMA32(VFR(7), PAF(3), o1), C1, 12); } while (0)
    f32x16 zero16;
#pragma unroll
    for (int i = 0; i < 16; ++i) zero16[i] = 0.f;
    WBAR();
    sl_prev = 2 * AT_SLOTB; sl_cur = 0; sl_next = AT_SLOTB;
    if (!ctx) {
        { const int cad = CADDR(0);
#pragma unroll
          for (int q = 0; q < 8; ++q) CLDA(pA0, q);
          CLDB(pA1, 0); CLDB(pA1, 1); }
#pragma unroll
        for (int j = 0; j < 4; ++j) KLD2(0, j);
#pragma unroll
        for (int j = 0; j < 4; ++j) { pA0 = MFMA32(kf[2 * j], qr[j], pA0); pA1 = MFMA32(kf[2 * j + 1], qr[j], pA1); }
        STAGE(0);
        { float nmh; DECIDE_W(pA0, pA1);
#pragma unroll
          for (int r_ = 0; r_ < 16; ++r_) pA0[r_] = EX(pA0[r_]);
#pragma unroll
          for (int r_ = 0; r_ < 4; ++r_) pA1[r_] = EX(pA1[r_]); }
        { const int cad = CADDR(1);
#pragma unroll
          for (int q = 0; q < 8; ++q) CLDA(pB0, q);
          CLDB(pB1, 0); CLDB(pB1, 1); }
#pragma unroll
        for (int j = 0; j < 4; ++j) KLD2(AT_SLOTB, j);
        WBAR(); ROT();
#pragma unroll 1
        for (int t = 1; t < NWP; t += 2) {
            STEP_WW(pB0, pB1, pA0, pA1, t);     WBAR(); RESC(); ROT();
            STEP_WW(pA0, pA1, pB0, pB1, t + 1); WBAR(); RESC(); ROT();
        }
        STEP_DW(pB0, pB1, pA0, pA1, NWP); WBAR(); RESC(); ROT();
    } else {
#pragma unroll
        for (int j = 0; j < 4; ++j) KLD2(0, j);
        pB0 = MFMA32(kf[0], qr[0], zero16); pB1 = MFMA32(kf[1], qr[0], zero16);
#pragma unroll
        for (int j = 1; j < 4; ++j) { pB0 = MFMA32(kf[2 * j], qr[j], pB0); pB1 = MFMA32(kf[2 * j + 1], qr[j], pB1); }
        STAGE(0);
        { float nmh; DECIDE_D(pB0, pB1);
#pragma unroll
          for (int r_ = 0; r_ < 16; ++r_) { pB0[r_] = EX(pB0[r_]); pB1[r_] = EX(pB1[r_]); } }
#pragma unroll
        for (int j = 0; j < 4; ++j) KLD2(AT_SLOTB, j);
        WBAR(); ROT();
    }
    { const int td = NWP;
      STEP_DD(pA0, pA1, pB0, pB1, td + 1); WBAR(); RESC(); ROT();
      STEP_DD(pB0, pB1, pA0, pA1, td + 2); WBAR(); RESC(); ROT();
      STEP_DD(pA0, pA1, pB0, pB1, td + 3); WBAR(); RESC(); ROT(); }
#define DRAIN(P0, P1) do { float sacc = P0[0] + P0[1]; \
      _Pragma("unroll") for (int r_ = 2; r_ < 16; ++r_) sacc += P0[r_]; \
      _Pragma("unroll") for (int r_ = 0; r_ < 16; ++r_) sacc += P1[r_]; \
      l_reg += sacc; \
      pw0 = (u32x4){PKW(P0, 0), PKW(P0, 2), PKW(P0, 4), PKW(P0, 6)}; pw1 = (u32x4){PKW(P0, 8), PKW(P0, 10), PKW(P0, 12), PKW(P0, 14)}; \
      pw2 = (u32x4){PKW(P1, 0), PKW(P1, 2), PKW(P1, 4), PKW(P1, 6)}; pw3 = (u32x4){PKW(P1, 8), PKW(P1, 10), PKW(P1, 12), PKW(P1, 14)}; \
      PIN(pw0); PIN(pw1); PIN(pw2); PIN(pw3); SBAR(); \
      _Pragma("unroll") for (int i_ = 0; i_ < 4; ++i_) zr[i_] = *(const u32x4*)(zp + (size_t)i_ * 8 * 512); \
      asm volatile("" ::: "memory"); if (next_ctx >= 0) attn_prefetch(F, layer, next_ctx, true, P); asm volatile("" ::: "memory");     \
      const LAS char* vp_ = vp0 + sl_prev; VRD(0, 0); VRD(4, 0); VRD(1, 1); VRD(5, 1); VRD(2, 2); VRD(6, 2); VRD(3, 3); VRD(7, 3); \
      o0 = MFMA32(VFR(0), PAF(0), o0); o1 = MFMA32(VFR(4), PAF(0), o1); o0 = MFMA32(VFR(1), PAF(1), o0); o1 = MFMA32(VFR(5), PAF(1), o1); \
      o0 = MFMA32(VFR(2), PAF(2), o0); o1 = MFMA32(VFR(6), PAF(2), o1); o0 = MFMA32(VFR(3), PAF(3), o0); o1 = MFMA32(VFR(7), PAF(3), o1); } while (0)
    int le = lane; asm volatile("" : "+v"(le));
    unsigned char* wse = kws();
    const bf16_t* zp = (const bf16_t*)(wse + WS_SZA) + (size_t)(R0 + (le >> 3)) * 512 + h * 64 + (le & 7) * 8;
    u32x4 zr[4];
    DRAIN(pA0, pA1);
#undef DRAIN
#undef STEP_DD
#undef STEP_DW
#undef STEP_WW
#undef PHASEA_PD
#undef PHASEA_PW
#undef QK0
#undef QK1
#undef STAGE
#undef EXG
#undef GAPB
#undef GAPM
#undef GAPA
#undef VRD
#undef VFR
#undef PAF
#undef PKW
#undef EX
#undef RESC
#undef DECIDE_W
#undef DECIDE_D
#undef DEC_TAIL
#undef CLDA
#undef CLDB
#undef CADDR
#undef KLD2
#undef MX3
#undef ROT
#undef VT
    { auto rr = __builtin_amdgcn_permlane32_swap(__float_as_uint(l_reg), __float_as_uint(l_reg), false, false); l_reg = __uint_as_float(rr[0]) + __uint_as_float(rr[1]); }
    const float inv = 1.0f / l_reg;
    { LAS char* stg = L + AT_TBL + wid * 4608; LAS char* srow = stg + (le >> 3) * 144 + (le & 7) * 16; LAS char* sfrag = stg + (le & 31) * 144 + (le >> 5) * 8;
#pragma unroll
      for (int i = 0; i < 4; ++i) *(LAS u32x4*)(srow + i * 8 * 144) = zr[i];
      asm volatile("s_waitcnt lgkmcnt(0)" ::: "memory");
      u32x2 zg0[4], zg1[4];
#pragma unroll
      for (int g = 0; g < 4; ++g) { zg0[g] = *(const LAS u32x2*)(sfrag + 16 * g); zg1[g] = *(const LAS u32x2*)(sfrag + 64 + 16 * g); }
      asm volatile("s_waitcnt lgkmcnt(0)" ::: "memory");
#pragma unroll
      for (int g = 0; g < 4; ++g) {
          const u32x2 z0 = zg0[g], z1 = zg1[g];
          u32x2 w0, w1;
          w0.x = cvtpk_s(o0[4 * g + 0] * inv * bflo(z0.x), o0[4 * g + 1] * inv * bfhi(z0.x)); w0.y = cvtpk_s(o0[4 * g + 2] * inv * bflo(z0.y), o0[4 * g + 3] * inv * bfhi(z0.y));
          w1.x = cvtpk_s(o1[4 * g + 0] * inv * bflo(z1.x), o1[4 * g + 1] * inv * bfhi(z1.x)); w1.y = cvtpk_s(o1[4 * g + 2] * inv * bflo(z1.y), o1[4 * g + 3] * inv * bfhi(z1.y));
          *(LAS u32x2*)(sfrag + 16 * g) = w0; *(LAS u32x2*)(sfrag + 64 + 16 * g) = w1; }
      asm volatile("s_waitcnt lgkmcnt(0)" ::: "memory");
      bf16_t* yp = (bf16_t*)(wse + WS_YAB) + (size_t)(R0 + (le >> 3)) * 1024 + h * 64 + (le & 7) * 8;
#pragma unroll
      for (int i = 0; i < 4; ++i) { const u32x4 v = *(const LAS u32x4*)(srow + i * 8 * 144); *(u32x4*)(yp + (size_t)i * 8 * 1024) = v; } }
    WBAR();
#undef WBAR
#undef PIN
#undef SBAR
}
#undef ATT_SRC
#undef ATT_DECODE

__device__ __forceinline__ void mix_phase(Frame& F, int layer) {
    AttnPre P;
    if (F.G == 256) {
        const int t_ctx = 255 - F.bx;
        for (int t = F.bx; t < M / 32; t += 256) conv_task(F, layer, t, P, t + 256 >= M / 32 ? F.bx : -1);
        attn_wg(F, layer, F.bx, false, P, t_ctx < 128 ? t_ctx : -1);
        if (t_ctx < 128) attn_wg(F, layer, t_ctx, true, P, -1);
    } else {
        for (int t = F.bx; t < M / 32; t += F.G) conv_task(F, layer, t, P, -1);
        for (int t = F.bx; t < 256; t += F.G) { attn_prefetch(F, layer, t, false, P); attn_wg(F, layer, t, false, P, -1); }
        for (int t = F.G - 1 - F.bx; t < 128; t += F.G) { attn_prefetch(F, layer, t, true, P); attn_wg(F, layer, t, true, P, -1); }
    }
}

__device__ __forceinline__ void cvec_phase(Frame& F) {
    const int gw = F.bx * 8 + F.wave, NGW = F.G * 8;
    const float* md = WSP(float, WS_MOD) + 5 * 3072;
    f32x4 sh[5][4];
#pragma unroll
    for (int g = 0; g < 5; ++g)
#pragma unroll
        for (int i = 0; i < 4; ++i) sh[g][i] = *(const f32x4*)(md + g * 3072 + 16 * F.lane + 4 * i);
    const bf16_t* W = WSP(bf16_t, WS_WTIN) + (size_t)DIN * D; const float* bp = WSP(float, WS_BIASP) + DIN; float* cv = WSP(float, WS_CVEC);
    for (int n = gw; n < DIN; n += NGW) {
        const u32x4 wa = *(const u32x4*)(W + (size_t)n * D + 16 * F.lane), wb = *(const u32x4*)(W + (size_t)n * D + 16 * F.lane + 8);
        const f32x4 w0 = {bflo(wa.x), bfhi(wa.x), bflo(wa.y), bfhi(wa.y)}, w1 = {bflo(wa.z), bfhi(wa.z), bflo(wa.w), bfhi(wa.w)};
        const f32x4 w2 = {bflo(wb.x), bfhi(wb.x), bflo(wb.y), bfhi(wb.y)}, w3 = {bflo(wb.z), bfhi(wb.z), bflo(wb.w), bfhi(wb.w)};
        const float bias = bp[n];
#pragma unroll
        for (int g = 0; g < 5; ++g) { const f32x4 p = sh[g][0] * w0 + sh[g][1] * w1 + sh[g][2] * w2 + sh[g][3] * w3;
            const float sm = wave_sum((p[0] + p[1]) + (p[2] + p[3])); if (F.lane == 0) cv[g * DIN + n] = sm + bias; }
    }
}

struct Args { const float* in[20]; float* out; unsigned char* ws; int ph_lo, ph_hi; };

__global__ void __launch_bounds__(512, 2) mk_fwd(Args args) {
    extern __shared__ __attribute__((aligned(16))) unsigned char lds_raw[];
    Frame F;
    F.lds = (LAS unsigned char*)lds_raw;
    F.tid = threadIdx.x; F.lane = F.tid & 63; F.wave = __builtin_amdgcn_readfirstlane(F.tid >> 6); F.G = gridDim.x; F.bx = blockIdx.x;
    for (int u = F.tid; u < (LDS_BYTES - LDSCTL_OFF) / 4; u += 512) ((LAS unsigned*)(F.lds + LDSCTL_OFF))[u] = 0u;
    __syncthreads();
    XcdBarrier bar; bar.bar = WSP(unsigned, WS_CTL) + CW_BAR; bar.x = 0; bar.st = nullptr;
#define lo (kint(176))
#define hi (kint(180))
    if (hi - lo > 1) bar = xcd_barrier_post(WSP(unsigned, WS_CTL) + CW_BAR, (volatile LAS unsigned*)(F.lds + MISC_OFF) + 8);
#ifndef PH_MASK
#define PH_MASK 0x7f
#endif
#define PHK(kind) ((PH_MASK >> (kind)) & 1)
#define IN(k) (lo <= (k) && (k) < hi)
#define SEAM(k) do { if (IN(k) && IN((k) + 1)) { XcdBarrier bb_; bb_.bar = WSP(unsigned, WS_CTL) + CW_BAR; bb_.x = xb_xcc_id(); bb_.st = (volatile LAS unsigned*)((LAS unsigned char*)lds_raw + MISC_OFF) + 8; xcd_barrier(bb_); } } while (0)
#define FRESH() do { F.tid = fresh_tid(); F.lane = F.tid & 63; F.wave = __builtin_amdgcn_readfirstlane(F.tid >> 6); } while (0)

    if (PHK(0) && IN(0)) { FRESH(); p0_prologue(F); SEAM(0); }
    for (int layer = 0; layer < DEPTH; ++layer) {
        const int pb = 1 + 5 * layer;
        if (PHK(1) && IN(pb) && layer == 0) { FRESH();
            if (layer == 0 && F.bx == F.G - 1) { const float* rg = kin(I_RMS_G) + D; const float* md = WSP(float, WS_MOD) + 5 * 3072; float* gm = WSP(float, WS_GM);
                for (int i = F.tid; i < 5 * 1024; i += 512) { const int g = i >> 10, c = i & 1023; gm[i] = rg[c] * (1.0f + md[g * 3072 + 1024 + c]); } }
            norm_phase(F, layer); SEAM(pb); }
        if (PHK(2) && IN(pb + 1)) {
            constexpr int M1 = 46 * 256;
            const bf16_t* Ain = layer == 0 ? WSP(bf16_t, WS_H) : WSP(bf16_t, WS_YAB);
            { pg8::Gemm g{Ain, WSP(bf16_t, WS_WTIN) + (size_t)layer * DIN * D, M1, DIN, D, D}; pg8::StaticOrder S; S.init(M1, DIN, F.G, F.bx);
              if (layer == 0) { EpiInT<4> E{layer, 0}; pg8::gemm_phase<EpiInT<4>>(F.lds, g, S, E); } else { EpiInT<4, true> E{layer, 0}; pg8::gemm_phase<EpiInT<4, true>>(F.lds, g, S, E); } }
            { pg8::Gemm g{Ain + (size_t)M1 * D, WSP(bf16_t, WS_WTIN) + (size_t)layer * DIN * D, M - M1, DIN, D, D}; pg8::StaticOrder S; S.init(M - M1, DIN, F.G, F.G - 1 - F.bx, 0, 128);
              if (layer == 0) { EpiInT<2> E{layer, M1}; pg8::gemm_phase<EpiInT<2>>(F.lds, g, S, E); } else { EpiInT<2, true> E{layer, M1}; pg8::gemm_phase<EpiInT<2, true>>(F.lds, g, S, E); } }
            if (layer == 0) { const int nidle = F.G - (M - M1) / 128 * (DIN / 256);
                if (nidle > 0 && F.bx < nidle) { FRESH(); __syncthreads(); wt_items(F, 1, F.bx * 8 + F.wave, nidle * 8); } }
            SEAM(pb + 1);
        }
        if (PHK(3) && IN(pb + 2)) { FRESH(); mix_phase(F, layer); SEAM(pb + 2); }
        if (PHK(4) && IN(pb + 3)) {
            if (layer == 0) { FRESH(); cvec_phase(F); }
            pg8::Gemm g{WSP(bf16_t, WS_YAB), WSP(bf16_t, WS_WTPROJ) + (size_t)layer * D * D, M, D, D, D}; pg8::StaticOrder S; S.init(M, D, F.G, F.bx, 0, 192);
            EpiProj E{};
            pg8::gemm_phase<EpiProj>(F.lds, g, S, E);
            SEAM(pb + 3);
        }
        if (PHK(5) && IN(pb + 4)) {
            pg8::Gemm g{WSP(bf16_t, WS_H), WSP(bf16_t, WS_WTOUT) + (size_t)layer * D * D, M, D, D, D}; pg8::StaticOrder S; S.init(M, D, F.G, F.bx, 0, 192);
            if (layer + 1 < DEPTH) { EpiOutT<false> E{layer}; pg8::gemm_phase<EpiOutT<false>>(F.lds, g, S, E); }
            else { EpiOutT<true> E{layer}; pg8::gemm_phase<EpiOutT<true>>(F.lds, g, S, E); }
            SEAM(pb + 4);
        }
    }
    if (PHK(6) && IN(11)) { FRESH(); final_norm_phase(F); }
#undef IN
#undef SEAM
#undef lo
#undef hi
}

extern "C" void kernel_launch(void* const* d_in, const int* in_sizes, int n_in, void* d_out, int out_size, void* d_ws, size_t ws_size, hipStream_t stream) {
    static int grid = 0;
    if (grid == 0) {
        if (n_in != 20 || ws_size < WS_END) { fprintf(stderr, "kernel_launch: unexpected inputs (n_in %d, ws %zu)\n", n_in, ws_size); grid = -1; return; }
        int dev = 0, cus = 0, per_cu = 0;
        if (hipGetDevice(&dev) != hipSuccess || hipDeviceGetAttribute(&cus, hipDeviceAttributeMultiprocessorCount, dev) != hipSuccess) { grid = -1; return; }
        if (hipFuncSetAttribute((const void*)mk_fwd, hipFuncAttributeMaxDynamicSharedMemorySize, LDS_BYTES) != hipSuccess) { fprintf(stderr, "kernel_launch: hipFuncSetAttribute failed\n"); grid = -1; return; }
        if (hipOccupancyMaxActiveBlocksPerMultiprocessor(&per_cu, (const void*)mk_fwd, 512, LDS_BYTES) != hipSuccess || per_cu < 1) { fprintf(stderr, "kernel_launch: occupancy query says %d\n", per_cu); per_cu = 1; }
        (void)hipGetLastError();
        grid = cus;
    }
    if (grid < 0) return;
    (void)hipMemsetAsync((char*)d_ws + WS_CTL, 0, CTL_ZERO_BYTES, stream);
    Args a{};
    for (int i = 0; i < 20; ++i) a.in[i] = (const float*)d_in[i];
    a.out = (float*)d_out; a.ws = (unsigned char*)d_ws;
    if (MK_N_LAUNCHES == 1) { a.ph_lo = 0; a.ph_hi = NPHASE; hipLaunchKernelGGL(mk_fwd, dim3(grid), dim3(512), LDS_BYTES, stream, a); }
    else for (int p = 0; p < NPHASE; ++p) { a.ph_lo = p; a.ph_hi = p + 1; hipLaunchKernelGGL(mk_fwd, dim3(grid), dim3(512), LDS_BYTES, stream, a); }
}
```

```cpp
#include <hip/hip_runtime.h>
#include <cstdio>
#include <cstdint>

#ifndef MK_N_LAUNCHES
#define MK_N_LAUNCHES 1
#endif

#define GAS __attribute__((address_space(1)))
#define LAS __attribute__((address_space(3)))
typedef unsigned short bf16_t;
typedef short bf16x8 __attribute__((ext_vector_type(8)));
typedef float f32x4 __attribute__((ext_vector_type(4)));
typedef float f32x2 __attribute__((ext_vector_type(2)));
typedef unsigned u32x4 __attribute__((ext_vector_type(4)));
typedef unsigned u32x2 __attribute__((ext_vector_type(2)));
typedef GAS unsigned gu32;
#define RLX_AGENT __ATOMIC_RELAXED, __HIP_MEMORY_SCOPE_AGENT
#define LDS_WAIT() asm volatile("s_waitcnt lgkmcnt(0)" ::: "memory")
#define VM_WAIT() asm volatile("s_waitcnt vmcnt(0)" ::: "memory")

constexpr int D = 1024, NCTX = 4096, NLAT = 8192, M = NCTX + NLAT, DIN = 5632, DEPTH = 2, NH = 8, HD = 64;
constexpr int NPHASE = 12;
constexpr float EPS = 1e-6f;

constexpr size_t MiB = 1u << 20;
constexpr size_t WS_CTL = 0, CTL_ZERO_BYTES = 192 * 1024;
constexpr size_t WS_RSS2 = 128 * 1024;
constexpr size_t WS_RSS = 64 * 1024;
constexpr size_t WS_GM = 1 * MiB + 192 * 1024;
constexpr size_t WS_CVEC = 1 * MiB + 256 * 1024;
constexpr size_t WS_MOD = 1 * MiB;
constexpr size_t WS_BIASP = 1 * MiB + 128 * 1024;
constexpr size_t WS_WTIN = 2 * MiB;
constexpr size_t WS_WTPROJ = 24 * MiB;
constexpr size_t WS_WTOUT = 28 * MiB;
constexpr size_t WS_CK = 32 * MiB, WS_CV = 34 * MiB;
constexpr size_t WS_H = 36 * MiB;
constexpr size_t WS_Q = 60 * MiB, WS_K = 72 * MiB, WS_V = 84 * MiB, WS_SZA = 96 * MiB, WS_U = 108 * MiB, WS_SZB = 120 * MiB;
constexpr size_t WS_GR = 132 * MiB, WS_GB = 156 * MiB;
constexpr size_t WS_YAB = 180 * MiB;
constexpr size_t WS_X1 = 204 * MiB;
constexpr size_t WS_END = 228 * MiB;
constexpr int CW_BAR = 4096;

constexpr int RING_BYTES = 131072;
constexpr int LDSCTL_OFF = RING_BYTES, MISC_OFF = LDSCTL_OFF + 320;
constexpr int LDS_BYTES = 147456;

__device__ __forceinline__ unsigned f2bf(float f) { unsigned u = __builtin_bit_cast(unsigned, f); return (u + 0x7fffu + ((u >> 16) & 1u)) >> 16; }
__device__ __forceinline__ unsigned pk2(float lo, float hi) { return f2bf(lo) | (f2bf(hi) << 16); }
typedef __bf16 bf16x2_cv __attribute__((ext_vector_type(2)));
__device__ __forceinline__ unsigned cvt_pk_bf16(float lo, float hi) { f32x2 v = {lo, hi}; bf16x2_cv b = __builtin_convertvector(v, bf16x2_cv); return __builtin_bit_cast(unsigned, b); }
__device__ __forceinline__ float bflo(unsigned w) { return __builtin_bit_cast(float, w << 16); }
__device__ __forceinline__ float bfhi(unsigned w) { return __builtin_bit_cast(float, w & 0xffff0000u); }
__device__ __forceinline__ float sigmoid_f(float x) { return __builtin_amdgcn_rcpf(1.0f + __expf(-x)); }
__device__ __forceinline__ float silu_f(float x) { return x * sigmoid_f(x); }
__device__ __forceinline__ float dpp_f(float v, float o) { return v + o; }
__device__ __forceinline__ float wave_sum(float v) {
#define DPP_ADD(ctrl, rm, bc) v += __builtin_bit_cast(float, __builtin_amdgcn_update_dpp(0, __builtin_bit_cast(int, v), ctrl, rm, 0xf, bc))
    DPP_ADD(0x111, 0xf, true); DPP_ADD(0x112, 0xf, true); DPP_ADD(0x114, 0xf, true); DPP_ADD(0x118, 0xf, true);
    DPP_ADD(0x142, 0xa, false); DPP_ADD(0x143, 0xc, false);
#undef DPP_ADD
    return __builtin_bit_cast(float, __builtin_amdgcn_readlane(__builtin_bit_cast(int, v), 63));
}

__device__ __forceinline__ int fresh_tid() { int t = threadIdx.x; asm volatile("" : "+v"(t)); return t; }

namespace pg8 {
constexpr int BM = 256, BK = 64, HALF = 128, HTB = HALF * BK * 2, STAGE_BYTES = 8 * HTB, NXCD = 8, WGM = 8;
__host__ __device__ __forceinline__ int lds_byte(int r, int c) { const int st = (r >> 4) * 2 + (c >> 5), rr = r & 15, cc = c & 31, ob = rr * 64 + cc * 2; return st * 1024 + (ob ^ (((ob >> 9) & 1) << 5)); }
__host__ __device__ __forceinline__ void stage_rc(int b, int& R, int& C) { const int st = b / 1024, sb = b % 1024, swz = sb ^ (((sb >> 9) & 1) << 5); R = (st >> 1) * 16 + swz / 64; C = (st & 1) * 32 + (swz % 64) / 2; }
__host__ __device__ __forceinline__ int perm32(int rho) { const int n = rho >> 4, i = rho & 15; return 8 * (i >> 2) + 4 * n + (i & 3); }

struct Unit { int pm, pn, kh; };
struct Gemm { const bf16_t* A; const bf16_t* Bt; int M, N, K, ld; };

struct StaticOrder {
    int nM, nN, nwg, G, c;
    __host__ __device__ void init(int M_, int N_, int G_, int c_, int split_ = 0, int bm_ = BM) { nM = M_ / bm_; nN = N_ / BM; nwg = nM * nN; G = G_; c = c_; split = split_; }
    int split;
    __host__ __device__ bool next(int i0, Unit& u) const {
        const int i = split ? (i0 >> 1) : i0; u.kh = split ? (i0 & 1) : 0;
        const long L = (long)i * G + c; if (L >= nwg) return false;
        int wgid = (int)L; { const int q = nwg / NXCD, r = nwg % NXCD, xcd = wgid % NXCD, off = wgid / NXCD; wgid = (xcd < r ? xcd * (q + 1) : r * (q + 1) + (xcd - r) * q) + off; }
        const int nig = WGM * nN, gid = wgid / nig, fm = gid * WGM, gsz = (nM - fm) < WGM ? (nM - fm) : WGM;
        u.pm = fm + ((wgid % nig) % gsz); u.pn = (wgid % nig) / gsz; return true;
    }
};

template <class Epi, bool ALIGN_EPI = true, bool SP2 = true>
__device__ __forceinline__ void gemm_phase(LAS unsigned char* lds, const Gemm g, const StaticOrder& S, const Epi& E) {
    const int tid = fresh_tid(), wid = __builtin_amdgcn_readfirstlane(tid >> 6), lane = tid & 63, wr = wid >> 2, wc = wid & 3, fr = lane & 15, fq = lane >> 4;
    static_assert(SP2 || Epi::MB == 4, "tiles lower than 256 rows use the SP2 loop");
    constexpr int MB = Epi::MB, HROWS = 32 * MB;
    const int K = g.ld, nt = g.K / BK;
    const size_t khstep = (size_t)g.K * 2;
    unsigned voffA[2], voffB[2];
#pragma unroll
    for (int i = 0; i < 2; ++i) { int R, C; stage_rc(tid * 16 + i * 8192, R, C); const int Rb = Epi::PERM ? ((R & ~31) + perm32(R & 31)) : R;
        voffA[i] = (unsigned)(R * K + C) * 2u; voffB[i] = (unsigned)(Rb * K + C) * 2u; }
    const size_t kstep = (size_t)(BK * 2);
    const size_t hstep = (size_t)HROWS * K * 2;
    const size_t hstepB = (size_t)HALF * K * 2;
    const size_t tstep = 2 * hstep, tstepB = 2 * hstepB;
    const unsigned ldsw = (unsigned)wid * 1024u;
    const int aoff = lds_byte(wr * (16 * MB) + fr, fq * 8), boff = lds_byte(wc * 32 + fr, fq * 8);
#define PG8_SA(b, h) (((b) * 2 + (h)) * HTB)
#define PG8_SB(b, h) ((4 + (b) * 2 + (h)) * HTB)
#define PG8_STAGE(bufoff, gbase, voff) do { _Pragma("unroll") for (int _i = 0; _i < 2; ++_i) \
        __builtin_amdgcn_global_load_lds((const unsigned*)((const char*)(gbase) + (voff)[_i]), (LAS unsigned*)(lds + (bufoff) + ldsw + _i * 8192), 16, 0, 0); } while (0)
#define PG8_LDA(dst, b, h) do { _Pragma("unroll") for (int m = 0; m < MB; ++m) _Pragma("unroll") for (int k = 0; k < 2; ++k) dst[m][k] = *(const LAS bf16x8*)(lds + PG8_SA(b, h) + aoff + m * 2048 + k * 1024); } while (0)
#define PG8_LDB(dst, b, h) do { _Pragma("unroll") for (int n = 0; n < 2; ++n) _Pragma("unroll") for (int k = 0; k < 2; ++k) dst[n][k] = *(const LAS bf16x8*)(lds + PG8_SB(b, h) + boff + n * 2048 + k * 1024); } while (0)
#define PG8_MMA(ai, bj, At, Bt) do { __builtin_amdgcn_s_setprio(1); _Pragma("unroll") for (int m = 0; m < MB; ++m) _Pragma("unroll") for (int n = 0; n < 2; ++n) _Pragma("unroll") for (int k = 0; k < 2; ++k) \
        acc[ai][bj][m][n] = __builtin_amdgcn_mfma_f32_16x16x32_bf16(Bt[n][k], At[m][k], acc[ai][bj][m][n], 0, 0, 0); __builtin_amdgcn_s_setprio(0); } while (0)
#define PG8_WAIT_V(n) asm volatile("s_waitcnt vmcnt(" #n ")" ::: "memory")
    const int aIss = (MB == 4) ? 2 : (MB == 3) ? (wid < 4 ? 2 : 1) : (MB == 2) ? 1 : (wid < 4 ? 1 : 0);
#define PG8_STAGE_A(bufoff, gbase, voff) do { _Pragma("unroll") for (int _i = 0; _i < 2; ++_i) if (MB == 4 || _i < aIss) \
        __builtin_amdgcn_global_load_lds((const unsigned*)((const char*)(gbase) + (voff)[_i]), (LAS unsigned*)(lds + (bufoff) + ldsw + _i * 8192), 16, 0, 0); } while (0)
#define PG8_WAIT_VN(n) do { switch (n) { case 0: PG8_WAIT_V(0); break; case 1: PG8_WAIT_V(1); break; case 2: PG8_WAIT_V(2); break; case 4: PG8_WAIT_V(4); break; case 5: PG8_WAIT_V(5); break; \
        case 6: PG8_WAIT_V(6); break; default: PG8_WAIT_V(8); break; } } while (0)
#define PG8_WAIT_LOOP() do { if constexpr (MB == 4) PG8_WAIT_V(8); else PG8_WAIT_VN(4 + 2 * aIss); } while (0)
#define PG8_WAIT_P1() do { if constexpr (MB == 4) PG8_WAIT_V(2); else PG8_WAIT_VN(aIss); } while (0)
#define PG8_WAIT_P2() do { if constexpr (MB == 4) PG8_WAIT_V(6); else PG8_WAIT_VN(4 + aIss); } while (0)
#define PG8_WAIT_L(n) asm volatile("s_waitcnt lgkmcnt(" #n ")" ::: "memory")
#define PG8_BAR __builtin_amdgcn_s_barrier()
#define PG8_SCHED __builtin_amdgcn_sched_barrier(0)
    Unit cur, nxt; int ui = 0;
    if (!S.next(0, cur)) return;
    f32x4 acc[2][2][MB][2];
#pragma unroll
    for (int a = 0; a < 2; ++a)
#pragma unroll
        for (int b = 0; b < 2; ++b)
#pragma unroll
            for (int m = 0; m < MB; ++m)
#pragma unroll
                for (int n = 0; n < 2; ++n) acc[a][b][m][n] = (f32x4){0.f, 0.f, 0.f, 0.f};
    bf16x8 At[MB][2], B0[2][2], B1[2][2];
    const char* cA = (const char*)g.A + (size_t)cur.pm * tstep + cur.kh * khstep; const char* cB = (const char*)g.Bt + (size_t)cur.pn * tstepB + cur.kh * khstep;
    if constexpr (SP2) {
        PG8_STAGE(PG8_SB(0, 0), cB, voffB); PG8_STAGE(PG8_SB(0, 1), cB + hstepB, voffB); PG8_STAGE_A(PG8_SA(0, 0), cA, voffA); PG8_STAGE_A(PG8_SA(0, 1), cA + hstep, voffA);
        if (wr == 1) PG8_BAR;
        PG8_WAIT_P1(); PG8_BAR;
        PG8_STAGE(PG8_SB(1, 0), cB + kstep, voffB); PG8_STAGE_A(PG8_SA(1, 0), cA + kstep, voffA); PG8_STAGE(PG8_SB(1, 1), cB + hstepB + kstep, voffB);
        PG8_WAIT_P2(); PG8_BAR;
    } else {
        PG8_STAGE(PG8_SB(0, 0), cB, voffB); PG8_STAGE(PG8_SA(0, 0), cA, voffA); PG8_STAGE(PG8_SB(0, 1), cB + hstepB, voffB); PG8_STAGE(PG8_SA(0, 1), cA + hstep, voffA);
        if (wr == 1) PG8_BAR;
        PG8_WAIT_V(4); PG8_BAR;
        PG8_STAGE(PG8_SB(1, 0), cB + kstep, voffB); PG8_STAGE(PG8_SA(1, 0), cA + kstep, voffA); PG8_STAGE(PG8_SB(1, 1), cB + hstepB + kstep, voffB);
        PG8_WAIT_V(6); PG8_BAR;
    }
    for (;;) {
        const bool has_next = S.next(ui + 1, nxt);
        const char* nA = has_next ? (const char*)g.A + (size_t)nxt.pm * tstep + nxt.kh * khstep : cA; const char* nB = has_next ? (const char*)g.Bt + (size_t)nxt.pn * tstepB + nxt.kh * khstep : cB;
        for (int t = 0; t < nt; t += 2) {
            const bool last = (t == nt - 2);
            const char* a1 = cA + (size_t)(t + 1) * kstep;
            const char* a2 = last ? nA : cA + (size_t)(t + 2) * kstep; const char* b2 = last ? nB : cB + (size_t)(t + 2) * kstep;
            const char* a3 = a2 + kstep; const char* b3 = b2 + kstep;
            if constexpr (SP2) {
            PG8_LDB(B0, 0, 0); PG8_LDB(B1, 0, 1); PG8_SCHED; PG8_LDA(At, 0, 0); PG8_STAGE_A(PG8_SA(1, 1), a1 + hstep, voffA);
            PG8_WAIT_LOOP(); PG8_WAIT_L(0); PG8_BAR; PG8_MMA(0, 0, At, B0); PG8_MMA(0, 1, At, B1); PG8_BAR; PG8_SCHED;
            PG8_LDA(At, 0, 1); PG8_STAGE(PG8_SB(0, 0), b2, voffB); PG8_STAGE(PG8_SB(0, 1), b2 + hstepB, voffB); PG8_STAGE_A(PG8_SA(0, 0), a2, voffA);
            PG8_WAIT_LOOP(); PG8_WAIT_L(0); PG8_BAR; PG8_MMA(1, 0, At, B0); PG8_MMA(1, 1, At, B1); PG8_BAR; PG8_SCHED;
            PG8_LDB(B0, 1, 0); PG8_LDB(B1, 1, 1); PG8_SCHED; PG8_LDA(At, 1, 0); PG8_STAGE_A(PG8_SA(0, 1), a2 + hstep, voffA);
            PG8_WAIT_LOOP(); PG8_WAIT_L(0); PG8_BAR; PG8_MMA(0, 0, At, B0); PG8_MMA(0, 1, At, B1); PG8_BAR; PG8_SCHED;
            PG8_LDA(At, 1, 1); PG8_STAGE(PG8_SB(1, 0), b3, voffB); PG8_STAGE(PG8_SB(1, 1), b3 + hstepB, voffB); PG8_STAGE_A(PG8_SA(1, 0), a3, voffA);
            PG8_WAIT_LOOP(); PG8_WAIT_L(0); PG8_BAR; PG8_MMA(1, 0, At, B0); PG8_MMA(1, 1, At, B1); PG8_BAR; PG8_SCHED;
            } else {
            PG8_LDB(B0, 0, 0); PG8_SCHED; PG8_LDA(At, 0, 0); PG8_STAGE(PG8_SA(1, 1), a1 + hstep, voffA);
            PG8_WAIT_L(8); PG8_BAR; PG8_WAIT_L(0); PG8_MMA(0, 0, At, B0); PG8_BAR; PG8_SCHED;
            PG8_LDB(B1, 0, 1); PG8_STAGE(PG8_SB(0, 0), b2, voffB);
            PG8_BAR; PG8_WAIT_L(0); PG8_MMA(0, 1, At, B1); PG8_BAR;
            PG8_LDA(At, 0, 1); PG8_STAGE(PG8_SA(0, 0), a2, voffA);
            PG8_BAR; PG8_WAIT_L(0); PG8_MMA(1, 0, At, B0); PG8_BAR; PG8_SCHED;
            PG8_STAGE(PG8_SB(0, 1), b2 + hstepB, voffB);
            PG8_WAIT_V(6); PG8_BAR; PG8_MMA(1, 1, At, B1); PG8_BAR;
            PG8_LDB(B0, 1, 0); PG8_SCHED; PG8_LDA(At, 1, 0); PG8_STAGE(PG8_SA(0, 1), a2 + hstep, voffA);
            PG8_WAIT_L(8); PG8_BAR; PG8_WAIT_L(0); PG8_MMA(0, 0, At, B0); PG8_BAR; PG8_SCHED;
            PG8_LDB(B1, 1, 1); PG8_STAGE(PG8_SB(1, 0), b3, voffB);
            PG8_BAR; PG8_WAIT_L(0); PG8_MMA(0, 1, At, B1); PG8_BAR;
            PG8_LDA(At, 1, 1); PG8_STAGE(PG8_SA(1, 0), a3, voffA);
            PG8_BAR; PG8_WAIT_L(0); PG8_MMA(1, 0, At, B0); PG8_BAR; PG8_SCHED;
            PG8_STAGE(PG8_SB(1, 1), b3 + hstepB, voffB);
            PG8_WAIT_V(6); PG8_BAR; PG8_MMA(1, 1, At, B1); PG8_BAR;
            }
            if constexpr (Epi::MIDHOOK) { if (t + 2 == nt / 2) { E.mid(acc, cur, wr, wc, fr, fq); PG8_SCHED; } }
        }
        if constexpr (ALIGN_EPI) { if (wr == 0) PG8_BAR; }
        E(acc, cur, wr, wc, fr, fq);
        if (!has_next) break;
        {
#pragma unroll
        for (int a = 0; a < 2; ++a)
#pragma unroll
            for (int b = 0; b < 2; ++b)
#pragma unroll
                for (int m = 0; m < MB; ++m)
#pragma unroll
                    for (int n = 0; n < 2; ++n) acc[a][b][m][n] = (f32x4){0.f, 0.f, 0.f, 0.f};
        }
        cur = nxt; cA = nA; cB = nB; ++ui;
        if constexpr (ALIGN_EPI) { if (wr == 1) PG8_BAR; }
    }
    PG8_WAIT_V(0);
    if constexpr (!ALIGN_EPI) { if (wr == 0) PG8_BAR; }
    PG8_BAR;
#undef PG8_SA
#undef PG8_SB
#undef PG8_STAGE
#undef PG8_STAGE_A
#undef PG8_WAIT_VN
#undef PG8_WAIT_LOOP
#undef PG8_WAIT_P1
#undef PG8_WAIT_P2
#undef PG8_LDA
#undef PG8_LDB
#undef PG8_MMA
#undef PG8_WAIT_V
#undef PG8_WAIT_L
#undef PG8_BAR
#undef PG8_SCHED
}
}

#define AS4 __attribute__((address_space(4)))
__device__ __forceinline__ const float* kin(int k) { const AS4 char* p = (const AS4 char*)__builtin_amdgcn_kernarg_segment_ptr(); asm volatile("" : "+s"(p)); return *(const float* const AS4*)(p + 8 * k); }
__device__ __forceinline__ float* kout() { const AS4 char* p = (const AS4 char*)__builtin_amdgcn_kernarg_segment_ptr(); asm volatile("" : "+s"(p)); return *(float* const AS4*)(p + 160); }
__device__ __forceinline__ int kint(int off) { const AS4 char* p = (const AS4 char*)__builtin_amdgcn_kernarg_segment_ptr(); asm volatile("" : "+s"(p)); return *(const int AS4*)(p + off); }
__device__ __forceinline__ unsigned char* kws() { const AS4 char* p = (const AS4 char*)__builtin_amdgcn_kernarg_segment_ptr(); asm volatile("" : "+s"(p)); return *(unsigned char* const AS4*)(p + 168); }
#define I_X_PROMPT 0
#define I_X_SAMPLE 1
#define I_CACHE_K 2
#define I_CACHE_V 3
#define I_C 4
#define I_C_CTX 5
#define I_RMS_G 6
#define I_W_ADA 7
#define I_B_ADA 8
#define I_W_IN 9
#define I_B_IN 10
#define I_REL_BIAS 11
#define I_DW_W 12
#define I_DW_B 13
#define I_LN_G 14
#define I_LN_B 15
#define I_W_PROJ_A 16
#define I_W_PROJ_B 17
#define I_W_OUT 18
#define I_FINAL_G 19
#define WSP(T, off) ((T*)(kws() + (off)))

constexpr float QSCALE = 0.125f * 1.4426950408889634f;
typedef f32x4 acc_t[2][2][4][2];
typedef f32x4 acc3_t[2][2][3][2];

template <int MB_, bool FU = false> struct EpiInT {
    static constexpr bool PERM = true, SPLIT2 = false, MIDHOOK = false; static constexpr int MB = MB_;
    typedef f32x4 accm_t[2][2][MB_][2];
    int layer, rowbase;
    template <bool ACT, bool ST, bool QS = false> __device__ __forceinline__ void plain(accm_t& acc, const f32x4 (&bv)[2][2], bf16_t* dst, float* st, int row0, int colbase) const {
#pragma unroll
        for (int ai = 0; ai < 2; ++ai)
#pragma unroll
            for (int m = 0; m < MB_; ++m) { const int row = row0 + ai * (32 * MB_) + m * 16;
#pragma unroll
                for (int bj = 0; bj < 2; ++bj) { f32x4 v0 = acc[ai][bj][m][0] + bv[bj][0], v1 = acc[ai][bj][m][1] + bv[bj][1];
                    if (QS) { v0 = v0 * QSCALE; v1 = v1 * QSCALE; }
                    if (ST) { float* sp = st + ((size_t)((row >> 8) * 512 + layer * 256 + (row & 255))) * 512 + colbase + bj * 128; *(f32x4*)sp = v0; *(f32x4*)(sp + 4) = v1; }
                    if (ACT) {
#pragma unroll
                        for (int j = 0; j < 4; ++j) { v0[j] = silu_f(v0[j]); v1[j] = silu_f(v1[j]); } }
                    u32x4 w; w.x = cvt_pk_bf16(v0[0], v0[1]); w.y = cvt_pk_bf16(v0[2], v0[3]); w.z = cvt_pk_bf16(v1[0], v1[1]); w.w = cvt_pk_bf16(v1[2], v1[3]);
                    *(u32x4*)(dst + (size_t)row * 512 + colbase + bj * 128) = w; } }
    }
    __device__ __forceinline__ void operator()(accm_t& acc, const pg8::Unit& u, int wr, int wc, int fr, int fq) const {
        asm volatile("" : "+v"(fr), "+v"(fq));
        const int row0 = rowbase + u.pm * (64 * MB_) + wr * (16 * MB_) + fr, c8 = wc * 32 + 8 * fq, pn = u.pn;
        const bool ctxrows = rowbase + u.pm * (64 * MB_) < NCTX;
        unsigned char* wsb = kws();
        bf16_t* Q = (bf16_t*)(wsb + WS_Q); bf16_t* K = (bf16_t*)(wsb + WS_K); bf16_t* V = (bf16_t*)(wsb + WS_V); bf16_t* SZA = (bf16_t*)(wsb + WS_SZA); bf16_t* U = (bf16_t*)(wsb + WS_U);
        bf16_t* SZB = (bf16_t*)(wsb + WS_SZB); bf16_t* GR = (bf16_t*)(wsb + WS_GR); bf16_t* GB = (bf16_t*)(wsb + WS_GB);
        const int tr0 = rowbase + u.pm * (64 * MB_), tg = tr0 < NCTX ? 0 : 1 + ((tr0 - NCTX) >> 11);
        const float* bp = FU ? (const float*)(wsb + WS_CVEC) + tg * DIN + pn * 256 + c8 : (const float*)(wsb + WS_BIASP) + layer * DIN + pn * 256 + c8;
        if (FU) { const float* rss = (const float*)(wsb + WS_RSS); float rq[2][MB_];
#pragma unroll
            for (int ai = 0; ai < 2; ++ai)
#pragma unroll
                for (int m = 0; m < MB_; ++m) rq[ai][m] = rss[row0 + ai * (32 * MB_) + m * 16];
#pragma unroll
            for (int ai = 0; ai < 2; ++ai)
#pragma unroll
                for (int m = 0; m < MB_; ++m) { const float rs = rsqrtf(rq[ai][m] * (1.0f / D) + EPS);
#pragma unroll
                    for (int bj = 0; bj < 2; ++bj) { acc[ai][bj][m][0] = acc[ai][bj][m][0] * rs; acc[ai][bj][m][1] = acc[ai][bj][m][1] * rs; } } }
        float* stk = kout() + (size_t)M * D; float* stv = stk + (size_t)16 * 2 * 256 * 512;
        f32x4 bv[2][2];
#pragma unroll
        for (int bj = 0; bj < 2; ++bj)
#pragma unroll
            for (int n = 0; n < 2; ++n) bv[bj][n] = *(const f32x4*)(bp + bj * 128 + 4 * n);
        const int colbase = (pn & 1) * 256 + c8;
        if (pn < 2) plain<false, false, true>(acc, bv, Q, nullptr, row0, colbase);
        else if (pn < 4) { if (ctxrows) plain<false, true>(acc, bv, K, stk, row0, colbase); else plain<false, false>(acc, bv, K, nullptr, row0, colbase); }
        else if (pn < 6) { if (ctxrows) plain<false, true>(acc, bv, V, stv, row0, colbase); else plain<false, false>(acc, bv, V, nullptr, row0, colbase); }
        else if (pn < 8) plain<true, false>(acc, bv, SZA, nullptr, row0, colbase);
        else if (pn == 12 || pn == 13) plain<true, false>(acc, bv, SZB, nullptr, row0, colbase);
        else if (pn < 12) {
            const int cb = (pn - 8) * 128 + c8;
#pragma unroll
            for (int ai = 0; ai < 2; ++ai)
#pragma unroll
                for (int m = 0; m < MB_; ++m) { const int row = row0 + ai * (32 * MB_) + m * 16;
                    f32x4 a0 = acc[ai][0][m][0] + bv[0][0], a1 = acc[ai][0][m][1] + bv[0][1], b0 = acc[ai][1][m][0] + bv[1][0], b1 = acc[ai][1][m][1] + bv[1][1];
#pragma unroll
                    for (int j = 0; j < 4; ++j) { a0[j] *= sigmoid_f(b0[j]); a1[j] *= sigmoid_f(b1[j]); }
                    u32x4 w; w.x = cvt_pk_bf16(a0[0], a0[1]); w.y = cvt_pk_bf16(a0[2], a0[3]); w.z = cvt_pk_bf16(a1[0], a1[1]); w.w = cvt_pk_bf16(a1[2], a1[3]);
                    *(u32x4*)(U + (size_t)row * 512 + cb) = w; }
        } else {
            const int cb = (pn - 14) * 128 + c8;
#pragma unroll
            for (int ai = 0; ai < 2; ++ai)
#pragma unroll
                for (int m = 0; m < MB_; ++m) { const int row = row0 + ai * (32 * MB_) + m * 16;
                    f32x4 a0 = acc[ai][0][m][0] + bv[0][0], a1 = acc[ai][0][m][1] + bv[0][1], b0 = acc[ai][1][m][0] + bv[1][0], b1 = acc[ai][1][m][1] + bv[1][1];
                    f32x4 r0, r1, g0, g1;
#pragma unroll
                    for (int j = 0; j < 4; ++j) {
                        const float ea0 = __expf(-a0[j]), ea1 = __expf(-a1[j]), eb0 = fminf(__expf(-b0[j]), 1e30f), eb1 = fminf(__expf(-b1[j]), 1e30f);
                        g0[j] = __builtin_amdgcn_rcpf(1.0f + eb0); g1[j] = __builtin_amdgcn_rcpf(1.0f + eb1);
                        r0[j] = (1.0f + eb0) * __builtin_amdgcn_rcpf(1.0f + ea0); r1[j] = (1.0f + eb1) * __builtin_amdgcn_rcpf(1.0f + ea1); }
                    u32x4 w; w.x = cvt_pk_bf16(r0[0], r0[1]); w.y = cvt_pk_bf16(r0[2], r0[3]); w.z = cvt_pk_bf16(r1[0], r1[1]); w.w = cvt_pk_bf16(r1[2], r1[3]);
                    *(u32x4*)(GR + (size_t)row * 1024 + cb) = w;
                    w.x = cvt_pk_bf16(g0[0], g0[1]); w.y = cvt_pk_bf16(g0[2], g0[3]); w.z = cvt_pk_bf16(g1[0], g1[1]); w.w = cvt_pk_bf16(g1[2], g1[3]);
                    *(u32x4*)(GB + (size_t)row * 1024 + cb) = w; }
        }
    }
};

struct EpiProj {
    static constexpr bool PERM = true, SPLIT2 = false, MIDHOOK = true; static constexpr int MB = 3;
    __device__ __forceinline__ void mid(acc3_t& acc, const pg8::Unit& u, int wr, int wc, int fr, int fq) const {
        asm volatile("" : "+v"(fr), "+v"(fq));
        const int row0 = u.pm * 192 + wr * 48 + fr, col0 = u.pn * 256 + wc * 32 + 8 * fq;
        const bf16_t* G = WSP(bf16_t, WS_GR);
#pragma unroll
        for (int ai = 0; ai < 2; ++ai)
#pragma unroll
            for (int m = 0; m < 3; ++m) { const size_t off = (size_t)(row0 + ai * 96 + m * 16) * 1024 + col0;
#pragma unroll
                for (int bj = 0; bj < 2; ++bj) { const u32x4 w = *(const u32x4*)(G + off + bj * 128);
                    acc[ai][bj][m][0] = acc[ai][bj][m][0] * (f32x4){bflo(w.x), bfhi(w.x), bflo(w.y), bfhi(w.y)}; acc[ai][bj][m][1] = acc[ai][bj][m][1] * (f32x4){bflo(w.z), bfhi(w.z), bflo(w.w), bfhi(w.w)}; } }
    }
    __device__ __forceinline__ void operator()(acc3_t& acc, const pg8::Unit& u, int wr, int wc, int fr, int fq) const {
        asm volatile("" : "+v"(fr), "+v"(fq));
        const int row0 = u.pm * 192 + wr * 48 + fr, col0 = u.pn * 256 + wc * 32 + 8 * fq;
        unsigned char* wsb = kws();
        const bf16_t* G = (const bf16_t*)(wsb + WS_GB); bf16_t* Mo = (bf16_t*)(wsb + WS_H);
#pragma unroll
        for (int ai = 0; ai < 2; ++ai)
#pragma unroll
            for (int m = 0; m < 3; ++m) { const size_t off = (size_t)(row0 + ai * 96 + m * 16) * 1024 + col0;
#pragma unroll
                for (int bj = 0; bj < 2; ++bj) { const u32x4 w = *(const u32x4*)(G + off + bj * 128);
                    const f32x4 v0 = acc[ai][bj][m][0] * (f32x4){bflo(w.x), bfhi(w.x), bflo(w.y), bfhi(w.y)}, v1 = acc[ai][bj][m][1] * (f32x4){bflo(w.z), bfhi(w.z), bflo(w.w), bfhi(w.w)};
                    u32x4 o; o.x = cvt_pk_bf16(v0[0], v0[1]); o.y = cvt_pk_bf16(v0[2], v0[3]); o.z = cvt_pk_bf16(v1[0], v1[1]); o.w = cvt_pk_bf16(v1[2], v1[3]);
                    *(u32x4*)(Mo + off + bj * 128) = o; }
                asm volatile("" ::: "memory"); }
    }
};

template <bool LAST> struct EpiOutT {
    static constexpr bool PERM = true, SPLIT2 = false, MIDHOOK = false; static constexpr int MB = 3;
    int layer;
    __device__ __forceinline__ void operator()(acc3_t& acc, const pg8::Unit& u, int wr, int wc, int fr, int fq) const {
        asm volatile("" : "+v"(fr), "+v"(fq));
        const int row0 = u.pm * 192 + wr * 48 + fr, col0 = u.pn * 256 + wc * 32 + 8 * fq;
        const float* modl = WSP(float, WS_MOD) + layer * 5 * 3072 + 2048 + col0;
        const float* xp = kin(I_X_PROMPT); const float* xs = kin(I_X_SAMPLE) - (size_t)NCTX * D;
        bf16_t* X1 = WSP(bf16_t, WS_X1); bf16_t* XG = WSP(bf16_t, WS_YAB);
        float* rss = WSP(float, LAST ? WS_RSS2 : WS_RSS);
        const float* gfin = kin(I_FINAL_G) + col0;
#pragma unroll
        for (int ai = 0; ai < 2; ++ai)
#pragma unroll
            for (int m = 0; m < 3; ++m) { const int row = row0 + ai * 96 + m * 16; const size_t off = (size_t)row * D + col0;
                const int g = row < NCTX ? 0 : 1 + ((row - NCTX) >> 11);
                const float* gate = modl + g * 3072; const float* xin = row < NCTX ? xp : xs;
                float ssq = 0.f;
#pragma unroll
                for (int bj = 0; bj < 2; ++bj) { const size_t o_ = off + bj * 128;
                    const f32x4 gv0 = *(const f32x4*)(gate + bj * 128), gv1 = *(const f32x4*)(gate + bj * 128 + 4);
                    f32x4 xi0, xi1;
                    if (LAST) { const u32x4 xw = *(const u32x4*)(X1 + o_); xi0 = (f32x4){bflo(xw.x), bfhi(xw.x), bflo(xw.y), bfhi(xw.y)}; xi1 = (f32x4){bflo(xw.z), bfhi(xw.z), bflo(xw.w), bfhi(xw.w)}; }
                    else { xi0 = *(const f32x4*)(xin + o_); xi1 = *(const f32x4*)(xin + o_ + 4); }
                    const f32x4 xn0 = xi0 + gv0 * acc[ai][bj][m][0], xn1 = xi1 + gv1 * acc[ai][bj][m][1];
                    ssq += ((xn0[0] * xn0[0] + xn0[1] * xn0[1]) + (xn0[2] * xn0[2] + xn0[3] * xn0[3])) + ((xn1[0] * xn1[0] + xn1[1] * xn1[1]) + (xn1[2] * xn1[2] + xn1[3] * xn1[3]));
                    const float* gmp = LAST ? gfin + bj * 128 : WSP(float, WS_GM) + g * 1024 + col0 + bj * 128;
                    const f32x4 y0 = xn0 * *(const f32x4*)gmp, y1 = xn1 * *(const f32x4*)(gmp + 4);
                    u32x4 w; w.x = cvt_pk_bf16(y0[0], y0[1]); w.y = cvt_pk_bf16(y0[2], y0[3]); w.z = cvt_pk_bf16(y1[0], y1[1]); w.w = cvt_pk_bf16(y1[2], y1[3]);
                    *(u32x4*)(XG + o_) = w;
                    if (!LAST) { u32x4 xw; xw.x = cvt_pk_bf16(xn0[0], xn0[1]); xw.y = cvt_pk_bf16(xn0[2], xn0[3]); xw.z = cvt_pk_bf16(xn1[0], xn1[1]); xw.w = cvt_pk_bf16(xn1[2], xn1[3]);
                        *(u32x4*)(X1 + o_) = xw; } }
                ssq += __shfl_xor(ssq, 16); ssq += __shfl_xor(ssq, 32);
                if (fq == 0) (void)__hip_atomic_fetch_add(rss + row, ssq, __ATOMIC_RELAXED, __HIP_MEMORY_SCOPE_AGENT);
                asm volatile("" ::: "memory"); }
    }
};

#define XB_TMO      128
#define XB_XCNT(j)  (256  + 64 * (j))
#define XB_XSUB(j)  (1280 + 64 * (j))
#define XB_XGEN(j)  (2304 + 64 * (j))
#define XB_TOP      3328
#define XB_TOPGEN   3392
#define XCD_BAR_WORDS 3456
#define XB_SPIN_CAP (1u << 18)
__device__ __forceinline__ unsigned xb_ld(unsigned* p)              { return __hip_atomic_load(p, __ATOMIC_RELAXED, __HIP_MEMORY_SCOPE_AGENT); }
__device__ __forceinline__ unsigned xb_add(unsigned* p, unsigned v) { return __hip_atomic_fetch_add(p, v, __ATOMIC_RELAXED, __HIP_MEMORY_SCOPE_AGENT); }
__device__ __forceinline__ unsigned xb_xcc_id() { return (unsigned)__builtin_amdgcn_s_getreg((3 << 11) | 20) & 0xFu; }
#define XB_SPIN(cond, bar) do { unsigned _sp = 0; while (cond) { __builtin_amdgcn_s_sleep(1); \
    if ((++_sp & 255u) == 0u) { if (xb_ld(&(bar)[XB_TMO])) break; if (_sp > XB_SPIN_CAP) { atomicAdd(&(bar)[XB_TMO], 1u); break; } } } } while (0)
struct XcdBarrier { unsigned* bar; unsigned x; volatile LAS unsigned* st; };
__device__ __forceinline__ XcdBarrier xcd_barrier_post(unsigned* bar, volatile LAS unsigned* st) {
    XcdBarrier b; b.bar = bar; b.x = xb_xcc_id(); b.st = st;
    if (threadIdx.x == 0) (void)xb_add(&bar[XB_XCNT(b.x)], 1u);
    return b;
}
__device__ __forceinline__ void xcd_barrier_complete(unsigned* bar, unsigned x, unsigned& nloc, unsigned& nx) {
    const unsigned G = gridDim.x * gridDim.y * gridDim.z;
    unsigned sum, cnt, mine, sp = 0u;
    for (;;) {
        sum = 0u; cnt = 0u; mine = 0u;
#pragma unroll
        for (unsigned j = 0; j < 16; ++j) { const unsigned c = xb_ld(&bar[XB_XCNT(j)]); sum += c; cnt += (c > 0u) ? 1u : 0u; mine = (j == x) ? c : mine; }
        if (sum == G) break;
        __builtin_amdgcn_s_sleep(1);
        if ((++sp & 255u) == 0u) { if (xb_ld(&bar[XB_TMO])) break; if (sp > XB_SPIN_CAP) { atomicAdd(&bar[XB_TMO], 1u); break; } }
    }
    nloc = mine > 0u ? mine : 1u; nx = cnt > 0u ? cnt : 1u;
}
__device__ __forceinline__ void xcd_barrier(const XcdBarrier& b) {
    asm volatile("s_waitcnt vmcnt(0)" ::: "memory");
    __syncthreads();
    if (fresh_tid() == 0) {
        unsigned* bar = b.bar;
        __builtin_amdgcn_s_waitcnt(0);
        unsigned nloc = b.st[0], nx = b.st[1];
        if (nloc == 0u) { xcd_barrier_complete(bar, b.x, nloc, nx); b.st[0] = nloc; b.st[1] = nx; }
        const unsigned old = xb_add(&bar[XB_XSUB(b.x)], 1u);
        const unsigned gen = old / nloc;
        if (old + 1u == (gen + 1u) * nloc) {
            __builtin_amdgcn_fence(__ATOMIC_RELEASE, "agent");
            asm volatile("s_waitcnt vmcnt(0)" ::: "memory");
            const unsigned og = xb_add(&bar[XB_TOP], 1u);
            const unsigned tg = og / nx;
            if (og + 1u == (tg + 1u) * nx) xb_add(&bar[XB_TOPGEN], 1u);
            else XB_SPIN(xb_ld(&bar[XB_TOPGEN]) == tg, bar);
            __builtin_amdgcn_fence(__ATOMIC_ACQUIRE, "agent");
            xb_add(&bar[XB_XGEN(b.x)], 1u);
            asm volatile("s_waitcnt vmcnt(0)" ::: "memory");
        } else {
            XB_SPIN(xb_ld(&bar[XB_XGEN(b.x)]) == gen, bar);
            __builtin_amdgcn_fence(__ATOMIC_ACQUIRE, "agent");
            asm volatile("s_waitcnt vmcnt(0)" ::: "memory");
        }
    }
    __syncthreads();
}

struct Frame {
    LAS unsigned char* lds;
    int tid, lane, wave, G, bx;
};


__device__ __forceinline__ int in_srccol(int n) {
    const int tile = n >> 8, r = n & 255;
    if (tile < 8 || tile == 12 || tile == 13) return n;
    if (tile < 12) { const int i = tile - 8; return (r < 128 ? 2048 : 2560) + 128 * i + (r & 127); }
    const int i = tile - 14; return (r < 128 ? 3584 : 4608) + 128 * i + (r & 127);
}

__device__ __forceinline__ void transpose_item(const float* W, int ldw, int srccol0, int k0, bf16_t* WT, int dstrow0, int dstk0, LAS float* scr, int lane) {
    float tv[32];
#pragma unroll
    for (int i = 0; i < 32; ++i) { const int kk = 2 * i + (lane >> 5); tv[i] = W[(size_t)(k0 + kk) * ldw + srccol0 + (lane & 31)]; }
#pragma unroll
    for (int i = 0; i < 32; ++i) { const int kk = 2 * i + (lane >> 5); scr[kk * 33 + (lane & 31)] = tv[i]; }
    LDS_WAIT(); asm volatile("" ::: "memory");
    const int c = lane & 7;
#pragma unroll
    for (int j = 0; j < 4; ++j) { const int n = (lane >> 3) + 8 * j; const LAS float* s = scr + (8 * c) * 33 + n;
        u32x4 o; o.x = pk2(s[0 * 33], s[1 * 33]); o.y = pk2(s[2 * 33], s[3 * 33]); o.z = pk2(s[4 * 33], s[5 * 33]); o.w = pk2(s[6 * 33], s[7 * 33]);
        *(GAS u32x4*)(WT + (size_t)(dstrow0 + n) * 1024 + dstk0 + 8 * c) = o; }
    LDS_WAIT(); asm volatile("" ::: "memory");
}

__device__ __forceinline__ void mod_task(Frame& F, int t) {
    const int l = t / 48, j0 = (t % 48) * 64;
    const float* c_ctx = kin(I_C_CTX); const float* cvec = kin(I_C); const float* w_ada = kin(I_W_ADA); const float* b_ada = kin(I_B_ADA); float* MOD = WSP(float, WS_MOD);
    LAS float* sv = (LAS float*)F.lds;
    LAS float* part = (LAS float*)(F.lds + 20480);
    for (int i = F.tid; i < 5 * 1024; i += 512) { const int g = i >> 10, k = i & 1023; const float c = (g == 0) ? c_ctx[k] : cvec[(g - 1) * 1024 + k]; sv[i] = silu_f(c); }
    __syncthreads();
    const float* W = w_ada + (size_t)l * 1024 * 3072 + (size_t)(128 * F.wave) * 3072 + j0 + F.lane;
    float a0 = 0.f, a1 = 0.f, a2 = 0.f, a3 = 0.f, a4 = 0.f;
#pragma unroll 32
    for (int kk = 0; kk < 128; ++kk) { const float wv = W[(size_t)kk * 3072]; const int k = 128 * F.wave + kk;
        a0 += sv[k] * wv; a1 += sv[1024 + k] * wv; a2 += sv[2048 + k] * wv; a3 += sv[3072 + k] * wv; a4 += sv[4096 + k] * wv; }
    part[(F.wave * 5 + 0) * 64 + F.lane] = a0; part[(F.wave * 5 + 1) * 64 + F.lane] = a1; part[(F.wave * 5 + 2) * 64 + F.lane] = a2;
    part[(F.wave * 5 + 3) * 64 + F.lane] = a3; part[(F.wave * 5 + 4) * 64 + F.lane] = a4;
    __syncthreads();
    if (F.tid < 320) { const int g = F.tid >> 6, ln = F.tid & 63; float s = 0.f;
#pragma unroll
        for (int w = 0; w < 8; ++w) s += part[(w * 5 + g) * 64 + ln];
        MOD[(l * 5 + g) * 3072 + j0 + ln] = s + b_ada[l * 3072 + j0 + ln]; }
    __syncthreads();
}

__device__ __forceinline__ void wt_items(Frame& F, int l, int w0, int nw);
__device__ __forceinline__ void p0_prologue(Frame& F) {
    if (F.bx < 96) mod_task(F, F.bx);
    const int gw = F.bx * 8 + F.wave, NGW = F.G * 8;
    const int gt = F.bx * 512 + F.tid, NGT = F.G * 512;
    { float* BIASP = WSP(float, WS_BIASP); const float* b_in = kin(I_B_IN);
      for (int i = gt; i < DEPTH * DIN; i += NGT) { const int l = i / DIN, n = i % DIN; BIASP[i] = b_in[l * DIN + in_srccol(n)]; } }
    const float* cache_k = kin(I_CACHE_K); const float* cache_v = kin(I_CACHE_V); bf16_t* CK = WSP(bf16_t, WS_CK); bf16_t* CV = WSP(bf16_t, WS_CV);
    for (int i0 = gt; i0 < 2 * 131072; i0 += 2 * NGT) { f32x4 a[2], b[2];
#pragma unroll
        for (int k = 0; k < 2; ++k) { const int i = i0 + k * NGT; if (i < 2 * 131072) { const int which = i >> 17, e = (i & 131071) * 8; const float* src = (which ? cache_v : cache_k) + e; a[k] = *(const f32x4*)src; b[k] = *(const f32x4*)(src + 4); } }
#pragma unroll
        for (int k = 0; k < 2; ++k) { const int i = i0 + k * NGT; if (i < 2 * 131072) { const int which = i >> 17, e = (i & 131071) * 8; bf16_t* dst = (which ? CV : CK) + e;
            u32x4 w; w.x = pk2(a[k][0], a[k][1]); w.y = pk2(a[k][2], a[k][3]); w.z = pk2(b[k][0], b[k][1]); w.w = pk2(b[k][2], b[k][3]); *(u32x4*)dst = w; } } }
    wt_items(F, 0, gw, NGW);
    { const int nidle = F.G - (M - 46 * 256) / 128 * (DIN / 256); if (nidle <= 0) wt_items(F, 1, gw, NGW); }
}

__device__ __forceinline__ void wt_items(Frame& F, int l, int w0, int nw) {
    LAS float* scr = (LAS float*)(F.lds + F.wave * 16384);
    const float* w_in = kin(I_W_IN); const float* w_proj_a = kin(I_W_PROJ_A); const float* w_proj_b = kin(I_W_PROJ_B); const float* w_out = kin(I_W_OUT);
    bf16_t* WTIN = WSP(bf16_t, WS_WTIN); bf16_t* WTPROJ = WSP(bf16_t, WS_WTPROJ); bf16_t* WTOUT = WSP(bf16_t, WS_WTOUT);
    constexpr int I_IN = 16 * 176, I_P = 8 * 32, I_O = 16 * 32, I_L = I_IN + 2 * I_P + I_O;
    for (int it = w0; it < I_L; it += nw) {
        int r = it;
        if (r < I_IN) { const int kb = r / 176, nb = r % 176; transpose_item(w_in + (size_t)l * D * DIN, DIN, in_srccol(32 * nb), 64 * kb, WTIN + (size_t)l * DIN * D, 32 * nb, 64 * kb, scr, F.lane); continue; } r -= I_IN;
        if (r < I_P) { const int kb = r / 32, nb = r % 32; transpose_item(w_proj_a + (size_t)l * 512 * D, D, 32 * nb, 64 * kb, WTPROJ + (size_t)l * D * D, 32 * nb, 64 * kb, scr, F.lane); continue; } r -= I_P;
        if (r < I_P) { const int kb = r / 32, nb = r % 32; transpose_item(w_proj_b + (size_t)l * 512 * D, D, 32 * nb, 64 * kb, WTPROJ + (size_t)l * D * D, 32 * nb, 512 + 64 * kb, scr, F.lane); continue; } r -= I_P;
        { const int kb = r / 32, nb = r % 32; transpose_item(w_out + (size_t)l * D * D, D, 32 * nb, 64 * kb, WTOUT + (size_t)l * D * D, 32 * nb, 64 * kb, scr, F.lane); }
    }
}

__device__ __forceinline__ void norm_phase(Frame& F, int layer) {
    const int gw = F.bx * 8 + F.wave, NGW = F.G * 8;
    const float* xa = layer == 0 ? kin(I_X_PROMPT) : kout(); const float* xb = layer == 0 ? kin(I_X_SAMPLE) : kout() + (size_t)NCTX * D;
    const float* MOD = WSP(float, WS_MOD); const float* rms_g = kin(I_RMS_G) + layer * D; bf16_t* H = WSP(bf16_t, WS_H);
    for (int rb = gw; rb < M; rb += 3 * NGW) {
        f32x4 v[3][4];
#pragma unroll
        for (int k = 0; k < 3; ++k) { const int r = rb + k * NGW; if (r < M) {
            const float* xrow = r < NCTX ? xa + (size_t)r * D : xb + (size_t)(r - NCTX) * D; const f32x4* xr = (const f32x4*)xrow + F.lane;
#pragma unroll
            for (int j = 0; j < 4; ++j) v[k][j] = xr[64 * j]; } }
#pragma unroll
        for (int k = 0; k < 3; ++k) { const int r = rb + k * NGW; if (r < M) {
            const int g = r < NCTX ? 0 : 1 + ((r - NCTX) >> 11);
            const float* mod = MOD + (layer * 5 + g) * 3072;
            float s = 0.f;
#pragma unroll
            for (int j = 0; j < 4; ++j) s += (v[k][j][0] * v[k][j][0] + v[k][j][1] * v[k][j][1]) + (v[k][j][2] * v[k][j][2] + v[k][j][3] * v[k][j][3]);
            const float rstd = rsqrtf(wave_sum(s) * (1.f / D) + EPS);
            unsigned long long* o8 = (unsigned long long*)(H + (size_t)r * D) + F.lane;
#pragma unroll
            for (int j = 0; j < 4; ++j) { const int c = 4 * F.lane + 256 * j;
                const f32x4 gg = *(const f32x4*)(rms_g + c), sh = *(const f32x4*)(mod + c), sc = *(const f32x4*)(mod + 1024 + c);
                const f32x4 y = v[k][j] * rstd * gg * (sc + 1.0f) + sh;
                o8[64 * j] = (unsigned long long)cvt_pk_bf16(y[0], y[1]) | ((unsigned long long)cvt_pk_bf16(y[2], y[3]) << 32); } } }
    }
}

__device__ __forceinline__ void final_norm_phase(Frame& F) {
    const int gw = F.bx * 8 + F.wave, NGW = F.G * 8;
    float* out = kout(); const bf16_t* XF = WSP(bf16_t, WS_YAB); const float* rss = WSP(float, WS_RSS2);
    for (int rb = gw; rb < M; rb += 3 * NGW) {
        u32x2 v[3][4]; float sq[3];
#pragma unroll
        for (int k = 0; k < 3; ++k) { const int r = rb + k * NGW; if (r < M) { const u32x2* xr = (const u32x2*)(XF + (size_t)r * D) + F.lane; sq[k] = rss[r];
#pragma unroll
            for (int j = 0; j < 4; ++j) v[k][j] = xr[64 * j]; } }
#pragma unroll
        for (int k = 0; k < 3; ++k) { const int r = rb + k * NGW; if (r < M) { f32x4* yr = (f32x4*)(out + (size_t)r * D) + F.lane;
            const float rstd = rsqrtf(sq[k] * (1.f / D) + EPS);
#pragma unroll
            for (int j = 0; j < 4; ++j) yr[64 * j] = (f32x4){bflo(v[k][j].x), bfhi(v[k][j].x), bflo(v[k][j].y), bfhi(v[k][j].y)} * rstd; } }
    }
}

struct AttnPre { u32x4 qrow[4], pa0, pc0, pa1, kreg, vreg, kreg2, vreg2; float bvv[8]; };
__device__ __forceinline__ void attn_prefetch(Frame& F, int layer, int task, const bool ctx, AttnPre& P);
__device__ __forceinline__ void conv_task(Frame& F, int layer, int tile, AttnPre& pre, int pre_task) {
    const int t0 = tile * 32;
    int s0, s1; if (t0 < NCTX) { s0 = t0 & ~255; s1 = s0 + 256; } else { s0 = NCTX + ((t0 - NCTX) & ~2047); s1 = s0 + 2048; }
    const bf16_t* Ub = WSP(bf16_t, WS_U); const bf16_t* SZB = WSP(bf16_t, WS_SZB); bf16_t* YAB = WSP(bf16_t, WS_YAB);
    const float* dw_w = kin(I_DW_W); const float* dw_b = kin(I_DW_B); const float* ln_g = kin(I_LN_G) + layer * 512; const float* ln_b = kin(I_LN_B) + layer * 512;
    LAS unsigned* Ul = (LAS unsigned*)F.lds;
    LAS float* Cl = (LAS float*)(F.lds + 62 * 1024);
    u32x4 xs[8];
#pragma unroll
    for (int k = 0; k < 8; ++k) { const int i = F.tid + 512 * k; const int lr = i >> 6, ch = i & 63; const int t = t0 - 15 + lr; xs[k] = (u32x4){0u, 0u, 0u, 0u};
        if (i < 62 * 64 && t >= s0 && t < s1) xs[k] = *(const u32x4*)(Ub + (size_t)t * 512 + ch * 8); }
    const int cp = F.tid & 255, th = F.tid >> 8;
    float w0[31], w1[31];
#pragma unroll
    for (int j = 0; j < 31; ++j) { const f32x2 w = *(const f32x2*)(dw_w + (size_t)(layer * 31 + j) * 512 + 2 * cp); w0[j] = w[0]; w1[j] = w[1]; }
    const f32x2 bb = *(const f32x2*)(dw_b + layer * 512 + 2 * cp);
    u32x2 zq[4][2];
#pragma unroll
    for (int k = 0; k < 4; ++k) { const int t = t0 + F.wave * 4 + k; zq[k][0] = *(const u32x2*)(SZB + (size_t)t * 512 + 4 * F.lane); zq[k][1] = *(const u32x2*)(SZB + (size_t)t * 512 + 256 + 4 * F.lane); }
#pragma unroll
    for (int k = 0; k < 8; ++k) { const int i = F.tid + 512 * k; if (i < 62 * 64) *(LAS u32x4*)(Ul + (i >> 6) * 256 + (i & 63) * 4) = xs[k]; }
    __syncthreads();
    {
        for (int blk = 0; blk < 4; ++blk) { const int tt0 = th * 16 + blk * 4;
            float a0[4], a1[4];
#pragma unroll
            for (int o = 0; o < 4; ++o) { a0[o] = bb[0]; a1[o] = bb[1]; }
#pragma unroll
            for (int i = 0; i < 34; ++i) { const unsigned x = Ul[(tt0 + i) * 256 + cp]; const float x0 = bflo(x), x1 = bfhi(x);
#pragma unroll
                for (int o = 0; o < 4; ++o) { const int j = i - o; if (j >= 0 && j < 31) { a0[o] += w0[j] * x0; a1[o] += w1[j] * x1; } } }
#pragma unroll
            for (int o = 0; o < 4; ++o) *(LAS f32x2*)(Cl + (tt0 + o) * 512 + 2 * cp) = (f32x2){a0[o], a1[o]};
        }
    }
    __syncthreads();
    const f32x4 g0 = *(const f32x4*)(ln_g + 4 * F.lane), g1 = *(const f32x4*)(ln_g + 256 + 4 * F.lane);
    const f32x4 b0 = *(const f32x4*)(ln_b + 4 * F.lane), b1 = *(const f32x4*)(ln_b + 256 + 4 * F.lane);
    asm volatile("" ::: "memory");
    if (pre_task >= 0) attn_prefetch(F, layer, pre_task, false, pre);
    asm volatile("" ::: "memory");
#pragma unroll
    for (int k = 0; k < 4; ++k) { const int tt = F.wave * 4 + k, t = t0 + tt;
        f32x4 v0 = *(LAS f32x4*)(Cl + tt * 512 + 4 * F.lane), v1 = *(LAS f32x4*)(Cl + tt * 512 + 256 + 4 * F.lane);
        const float mean = wave_sum((v0[0] + v0[1]) + (v0[2] + v0[3]) + (v1[0] + v1[1]) + (v1[2] + v1[3])) * (1.f / 512.f);
        v0 = v0 - mean; v1 = v1 - mean;
        const float var = wave_sum((v0[0] * v0[0] + v0[1] * v0[1]) + (v0[2] * v0[2] + v0[3] * v0[3]) + (v1[0] * v1[0] + v1[1] * v1[1]) + (v1[2] * v1[2] + v1[3] * v1[3])) * (1.f / 512.f);
        const float rstd = rsqrtf(var + EPS);
        f32x4 y0 = v0 * rstd * g0 + b0, y1 = v1 * rstd * g1 + b1;
        const u32x2 z0 = zq[k][0], z1 = zq[k][1];
        const f32x4 zz0 = (f32x4){bflo(z0.x), bfhi(z0.x), bflo(z0.y), bfhi(z0.y)}, zz1 = (f32x4){bflo(z1.x), bfhi(z1.x), bflo(z1.y), bfhi(z1.y)};
#pragma unroll
        for (int j = 0; j < 4; ++j) { y0[j] = silu_f(y0[j]) * zz0[j]; y1[j] = silu_f(y1[j]) * zz1[j]; }
        u32x2 o0, o1; o0.x = cvt_pk_bf16(y0[0], y0[1]); o0.y = cvt_pk_bf16(y0[2], y0[3]); o1.x = cvt_pk_bf16(y1[0], y1[1]); o1.y = cvt_pk_bf16(y1[2], y1[3]);
        *(u32x2*)(YAB + (size_t)t * 1024 + 512 + 4 * F.lane) = o0; *(u32x2*)(YAB + (size_t)t * 1024 + 768 + 4 * F.lane) = o1;
    }
    __syncthreads();
}

typedef float f32x16 __attribute__((ext_vector_type(16)));
typedef short s16x4 __attribute__((ext_vector_type(4)));
typedef __bf16 bf16x2_t __attribute__((ext_vector_type(2)));
__device__ __forceinline__ unsigned cvtpk_s(float lo, float hi) { f32x2 v = {lo, hi}; bf16x2_t b = __builtin_convertvector(v, bf16x2_t); return __builtin_bit_cast(unsigned, b); }
__device__ __forceinline__ s16x4 vtr(const LAS char* p) { return __builtin_bit_cast(s16x4, __builtin_amdgcn_ds_read_tr16_b64_v4i16((LAS s16x4*)p)); }
#define MFMA32(a, b, c) __builtin_amdgcn_mfma_f32_32x32x16_bf16((a), (b), (c), 0, 0, 0)
constexpr float LOG2E = 1.4426950408889634f;
constexpr float ATT_QSCALE = 0.125f * LOG2E;
constexpr int AT_SLOTB = 8192, AT_K = 0, AT_V = 3 * AT_SLOTB, AT_TBL = 6 * AT_SLOTB;
constexpr int AT_VSTRIDE = 68, AT_ROWF = 16 * AT_VSTRIDE + 52, AT_INF = AT_TBL + 15 * AT_ROWF * 4, AT_ZERO = AT_INF + 512, AT_END = AT_ZERO + 512;
static_assert(AT_END <= RING_BYTES, "attention LDS");
constexpr float ATT_THR = 8.0f;

#define ATT_DECODE() \
    int b, h, R0, r = 0, n_win = 0, lo = 0, qc = 0, r0 = 0; \
    if (!ctx) { const int R = 4 * (task & 7); h = (task >> 3) & 7; b = task >> 6; r = R + (wid >> 1); const int HALF = wid & 1; \
        R0 = NCTX + b * 2048 + r * 64 + HALF * 32; qc = HALF * 32 + r32; r0 = min(max(r - 4, 0), 24); \
        lo = min(max(R - 4, 0), 24); n_win = min(max(R - 1, 0), 24) + 8 - lo; \
    } else { h = task & 7; b = task >> 3; R0 = b * 256 + wid * 32; } \
    const int NT = n_win + 4; (void)qc; (void)r0; (void)r; (void)NT; \
    const unsigned ksoff = (unsigned)(lane * 512 + wid * 8), vsoff = (unsigned)((16 * (wid & 3) + (lane >> 2)) * 512 + (wid >> 2) * 32 + (lane & 3) * 8);
#define ATT_SRC(t, KP, VP) do { if ((t) < n_win) { const size_t o_ = (size_t)(NCTX + b * 2048 + (lo + (t)) * 64) * 512 + h * 64; KP = (const bf16_t*)(wsb + WS_K) + o_; VP = (const bf16_t*)(wsb + WS_V) + o_; } \
        else if (ctx) { const size_t o_ = (size_t)(b * 256 + ((t) - n_win) * 64) * 512 + h * 64; KP = (const bf16_t*)(wsb + WS_K) + o_; VP = (const bf16_t*)(wsb + WS_V) + o_; } \
        else { const size_t o_ = ((size_t)((b * 2 + layer) * 256 + ((t) - n_win) * 64)) * 512 + h * 64; KP = (const bf16_t*)(wsb + WS_CK) + o_; VP = (const bf16_t*)(wsb + WS_CV) + o_; } } while (0)
__device__ __forceinline__ void attn_prefetch(Frame& F, int layer, int task, const bool ctx, AttnPre& P) {
    const int tid = fresh_tid(), lane = tid & 63, r32 = lane & 31, wid = __builtin_amdgcn_readfirstlane(tid >> 6);
    unsigned char* wsb = kws();
    ATT_DECODE()
    { const bf16_t* qp = (const bf16_t*)(wsb + WS_Q) + (size_t)(R0 + (lane >> 3)) * 512 + h * 64 + (lane & 7) * 8;
#pragma unroll
      for (int i = 0; i < 4; ++i) P.qrow[i] = *(const u32x4*)(qp + (size_t)i * 8 * 512); }
    { const bf16_t *k0, *v0, *k1, *v1, *k2, *v2, *k3, *v3; ATT_SRC(0, k0, v0); ATT_SRC(1, k1, v1); ATT_SRC(2, k2, v2); ATT_SRC(3, k3, v3); (void)v3;
      P.pa0 = *(const u32x4*)(k0 + ksoff); P.pc0 = *(const u32x4*)(v0 + vsoff); P.pa1 = *(const u32x4*)(k1 + ksoff);
      P.kreg = *(const u32x4*)(k2 + ksoff); P.vreg = *(const u32x4*)(v1 + vsoff); P.kreg2 = *(const u32x4*)(k3 + ksoff); P.vreg2 = *(const u32x4*)(v2 + vsoff); }
    if (!ctx) { const float* rb = kin(I_REL_BIAS) + (size_t)(layer * 8 + h) * 465;
#pragma unroll
        for (int k = 0; k < 8; ++k) { const int i = tid + 512 * k, dr = i >> 8, v = (i >> 4) & 15, j = i & 15; P.bvv[k] = (i < 3840) ? rb[dr * 31 + v + j] : 0.f; } }
}

__device__ __forceinline__ void attn_wg(Frame& F, int layer, int task, const bool ctx, AttnPre& P, int next_ctx) {
    const int tid = fresh_tid(), lane = tid & 63, r32 = lane & 31, hi = lane >> 5, wid = __builtin_amdgcn_readfirstlane(tid >> 6);
    LAS char* L = (LAS char*)F.lds;
    unsigned char* wsb = kws();
    ATT_DECODE()
    const int kdst = AT_K + wid * 1024 + lane * 16, vdst = AT_V + wid * 1024 + lane * 16;
    u32x4 kreg = P.kreg, vreg = P.vreg, kreg2 = P.kreg2, vreg2 = P.vreg2;
    bf16x8 qr[4];
    { LAS char* stg = L + AT_TBL + wid * 4608; LAS char* srow = stg + (lane >> 3) * 144 + (lane & 7) * 16;
#pragma unroll
      for (int i = 0; i < 4; ++i) *(LAS u32x4*)(srow + i * 8 * 144) = P.qrow[i];
      asm volatile("s_waitcnt lgkmcnt(0)" ::: "memory");
#pragma unroll
      for (int s_ = 0; s_ < 4; ++s_) qr[s_] = *(const LAS bf16x8*)(stg + r32 * 144 + hi * 16 + s_ * 32);
      asm volatile("s_waitcnt lgkmcnt(0)" ::: "memory"); }
    { unsigned zz = 0u; asm volatile("" : "+v"(zz));
      if (tid < 32) *(LAS u32x4*)(L + AT_ZERO + 16 * tid) = (u32x4){zz, zz, zz, zz}; }
    if (!ctx) { unsigned ninf = 0xff800000u; asm volatile("" : "+v"(ninf));
        for (int i = lane; i < 4608 / 16; i += 64) *(LAS u32x4*)(L + AT_TBL + wid * 4608 + 16 * i) = (u32x4){ninf, ninf, ninf, ninf};
        for (int i = 8 * 4608 / 16 + tid; i < (AT_ZERO - AT_TBL) / 16; i += 512) *(LAS u32x4*)(L + AT_TBL + 16 * i) = (u32x4){ninf, ninf, ninf, ninf}; }
    *(LAS u32x4*)(L + kdst) = P.pa0; *(LAS u32x4*)(L + vdst) = P.pc0; *(LAS u32x4*)(L + AT_SLOTB + kdst) = P.pa1;
    if (!ctx) {
        asm volatile("s_waitcnt lgkmcnt(0)\n\ts_barrier" ::: "memory");
#pragma unroll
        for (int k = 0; k < 8; ++k) { const int i = tid + 512 * k, dr = i >> 8, v = (i >> 4) & 15, j = i & 15; if (i < 3840) *(LAS float*)(L + AT_TBL + (dr * AT_ROWF + v * AT_VSTRIDE + 48 + j) * 4) = P.bvv[k] * LOG2E; }
    }
    const int HALFW = ctx ? 0 : (wid & 1);
    const LAS char* kpA = L + AT_K + hi * 1024 + (32 * HALFW + r32) * 16;
    const LAS char* kpB = L + AT_K + hi * 1024 + (32 * (1 - HALFW) + ((r32 + 24 * HALFW) & 31)) * 16;
    const LAS char* vp0 = L + AT_V + ((lane >> 4) & 1) * 32 + (lane & 3) * 8 + (4 * hi + ((lane & 15) >> 2)) * 64;
    const int H2 = HALFW * 2048, O2 = (1 - HALFW) * 2048, rot = 3 * HALFW;
    const int vol0 = H2, voh0 = H2 + 512, vol1 = H2 + 1024, voh1 = H2 + 1536;
    const int vol2 = O2 + ((0 + rot) & 3) * 512, voh2 = O2 + ((1 + rot) & 3) * 512, vol3 = O2 + ((2 + rot) & 3) * 512, voh3 = O2 + ((3 + rot) & 3) * 512;
    const int vsh = (qc < 8 ? 8 - qc : (qc > 56 ? 56 - qc : 0)) + 7;
    const int tlane = AT_TBL + (67 * vsh + 4 * hi - qc + 63) * 4;
    const int offA = 128 * HALFW, offB = HALFW ? 96 : 128;
    const int NWP = n_win + ((n_win > 0 && ((n_win - 1) & 1)) ? 1 : 0), NTV = NWP + 4;
#define VT(t) ((t) < n_win ? (t) : ((t) < NWP ? n_win - 1 : (t) - (NWP - n_win)))
    float mhat = -INFINITY, l_reg = 0.f, fres = 1.f; bool resc = false;
    f32x16 o0, o1;
#pragma unroll
    for (int i = 0; i < 16; ++i) { o0[i] = 0.f; o1[i] = 0.f; }
    f32x16 pA0, pA1, pB0, pB1; bf16x8 kf[8]; s16x4 vlo[8], vhi[8]; u32x4 pw0, pw1, pw2, pw3;
#pragma unroll
    for (int i = 0; i < 16; ++i) { pA1[i] = 0.f; pB1[i] = 0.f; }
    int sl_prev = 0, sl_cur = 0, sl_next = AT_SLOTB;
#define SBAR() __builtin_amdgcn_sched_barrier(0)
#define PIN(x) asm volatile("" : "+v"(x))
#define WBAR() asm volatile("s_waitcnt lgkmcnt(0)\n\ts_barrier" ::: "memory")
#define ROT() do { sl_prev = sl_cur; sl_cur = sl_next; sl_next = (sl_next == 2 * AT_SLOTB) ? 0 : sl_next + AT_SLOTB; } while (0)
#define MX3(a, b, c) __builtin_fmaxf(__builtin_fmaxf((a), (b)), (c))
#define KLD2(so, j) do { kf[2 * (j)] = *(const LAS bf16x8*)(kpA + (so) + (j) * 2048); kf[2 * (j) + 1] = *(const LAS bf16x8*)(kpB + (so) + (j) * 2048); } while (0)
#define CADDR(tt) (((tt) < n_win && (unsigned)(lo + (tt) - r0) < 8u) ? tlane + (lo + (tt) - r + 7) * (AT_ROWF * 4) : AT_INF)
#define CLDA(X0, q) do { const int ro_ = (((2 * (q)) & 3) + 8 * ((2 * (q)) >> 2)) * 4; X0[2 * (q)] = *(const LAS float*)(L + cad + offA + ro_); X0[2 * (q) + 1] = *(const LAS float*)(L + cad + offA + ro_ + 4); } while (0)
#define CLDB(X1, q) do { X1[2 * (q)] = *(const LAS float*)(L + cad + offB + 8 * (q)); X1[2 * (q) + 1] = *(const LAS float*)(L + cad + offB + 8 * (q) + 4); } while (0)
#define DEC_TAIL() do { { auto rr_ = __builtin_amdgcn_permlane32_swap(__float_as_uint(rm_), __float_as_uint(rm_), false, false); rm_ = __builtin_fmaxf(__uint_as_float(rr_[0]), __uint_as_float(rr_[1])); } \
        resc = false; \
        if (__builtin_amdgcn_ballot_w64(rm_ > mhat + ATT_THR) != 0ull) { const float mn_ = __builtin_fmaxf(mhat, rm_); fres = __builtin_amdgcn_exp2f(mhat - mn_); l_reg *= fres; mhat = mn_; resc = true; } \
        nmh = (mhat == -INFINITY) ? 0.f : -mhat; } while (0)
#define DECIDE_D(C0, C1) do { float a_ = MX3(C0[0], C0[1], C1[0]), b_ = MX3(C0[2], C0[3], C1[1]); a_ = MX3(a_, C1[2], C1[3]); \
        _Pragma("unroll") for (int r_ = 4; r_ < 16; r_ += 4) { a_ = MX3(a_, C0[r_], C0[r_ + 1]); b_ = MX3(b_, C0[r_ + 2], C0[r_ + 3]); a_ = MX3(a_, C1[r_], C1[r_ + 1]); b_ = MX3(b_, C1[r_ + 2], C1[r_ + 3]); } \
        float rm_ = __builtin_fmaxf(a_, b_); DEC_TAIL(); } while (0)
#define DECIDE_W(C0, C1) do { float a_ = MX3(C0[0], C0[1], C1[0]), b_ = MX3(C0[2], C0[3], C1[1]); a_ = MX3(a_, C1[2], C1[3]); \
        _Pragma("unroll") for (int r_ = 4; r_ < 16; r_ += 4) { a_ = MX3(a_, C0[r_], C0[r_ + 1]); b_ = MX3(b_, C0[r_ + 2], C0[r_ + 3]); } \
        float rm_ = __builtin_fmaxf(a_, b_); DEC_TAIL(); } while (0)
#define RESC() do { if (resc) { _Pragma("unroll") for (int r_ = 0; r_ < 16; ++r_) { o0[r_] *= fres; o1[r_] *= fres; } } } while (0)
#define EX(v) __builtin_amdgcn_exp2f((v) + nmh)
#define PKW(P, i) cvtpk_s(P[i], P[(i) + 1])
#define PAF(k) __builtin_bit_cast(bf16x8, pw##k)
#define VFR(i) (bf16x8){vlo[i][0], vlo[i][1], vlo[i][2], vlo[i][3], vhi[i][0], vhi[i][1], vhi[i][2], vhi[i][3]}
#define VRD(i, s) do { vlo[i] = vtr(vp_ + (((i) >> 2) * 4096 + vol##s)); vhi[i] = vtr(vp_ + (((i) >> 2) * 4096 + voh##s)); } while (0)
#define GAPA(MF, a0, a1, a2, a3, W0, W1, PW) do { MF; sacc += a0; sacc += a1; sacc += a2; sacc += a3; PIN(sacc); W0; W1; PIN(PW); SBAR(); } while (0)
#define GAPM(MF) do { MF; SBAR(); } while (0)
#define GAPB(MF, X, i) do { MF; X[i] = EX(X[i]); X[(i) + 1] = EX(X[(i) + 1]); X[(i) + 2] = EX(X[(i) + 2]); X[(i) + 3] = EX(X[(i) + 3]); PIN(X); SBAR(); } while (0)
#define EXG(X, i) do { X[i] = EX(X[i]); X[(i) + 1] = EX(X[(i) + 1]); X[(i) + 2] = EX(X[(i) + 2]); X[(i) + 3] = EX(X[(i) + 3]); PIN(X); SBAR(); } while (0)
#define STAGE(t, KR, VR) do { *(LAS u32x4*)(L + sl_prev + kdst) = KR; *(LAS u32x4*)(L + sl_next + vdst) = VR; \
        { const int tk_ = VT(min((t) + 4, NTV - 1)), tv_ = VT(min((t) + 3, NTV - 1)); const bf16_t *kp_, *vq_, *kq_, *vv_; ATT_SRC(tk_, kp_, vq_); ATT_SRC(tv_, kq_, vv_); (void)vq_; (void)kq_; \
          KR = *(const u32x4*)(kp_ + ksoff); VR = *(const u32x4*)(vv_ + vsoff); } SBAR(); } while (0)
#define QK0(C0, CZ) C0 = (CZ) ? MFMA32(kf[0], qr[0], zero16) : MFMA32(kf[0], qr[0], C0)
#define QK1(C1, CZ) C1 = (CZ) ? MFMA32(kf[1], qr[0], zero16) : MFMA32(kf[1], qr[0], C1)
#define PHASEA_PW(C0, C1, P0, P1, CZ) do { \
    VRD(0, 0); SBAR(); float sacc = P0[0] + P0[1]; \
                       GAPA(QK0(C0, CZ), P0[2], P0[3], P0[4], P0[5],     pw0[0] = PKW(P0, 0),  pw0[1] = PKW(P0, 2),  pw0); \
    VRD(4, 0); SBAR(); GAPA(QK1(C1, CZ), P0[6], P0[7], P0[8], P0[9],     pw0[2] = PKW(P0, 4),  pw0[3] = PKW(P0, 6),  pw0); \
    VRD(1, 1); SBAR(); GAPA(C0 = MFMA32(kf[2], qr[1], C0), P0[10], P0[11], P0[12], P0[13], pw1[0] = PKW(P0, 8),  pw1[1] = PKW(P0, 10), pw1); \
    VRD(5, 1); SBAR(); GAPA(C1 = MFMA32(kf[3], qr[1], C1), P0[14], P0[15], P1[0], P1[1],   pw1[2] = PKW(P0, 12), pw1[3] = PKW(P0, 14), pw1); \
    VRD(2, 2); SBAR(); GAPA(C0 = MFMA32(kf[4], qr[2], C0), P1[2], P1[3], 0.f, 0.f,         pw2[0] = PKW(P1, 0),  pw2[1] = PKW(P1, 2),  pw2); \
    VRD(6, 2); SBAR(); GAPM(C1 = MFMA32(kf[5], qr[2], C1)); pw2[2] = 0u; pw2[3] = 0u; \
                       GAPM(C0 = MFMA32(kf[6], qr[3], C0)); GAPM(C1 = MFMA32(kf[7], qr[3], C1)); \
    l_reg += sacc; } while (0)
#define PHASEA_PD(C0, C1, P0, P1, CZ) do { \
    VRD(0, 0); SBAR(); float sacc = P0[0] + P0[1]; \
                       GAPA(QK0(C0, CZ), P0[2], P0[3], P0[4], P0[5],     pw0[0] = PKW(P0, 0),  pw0[1] = PKW(P0, 2),  pw0); \
    VRD(4, 0); SBAR(); GAPA(QK1(C1, CZ), P0[6], P0[7], P0[8], P0[9],     pw0[2] = PKW(P0, 4),  pw0[3] = PKW(P0, 6),  pw0); \
    VRD(1, 1); SBAR(); GAPA(C0 = MFMA32(kf[2], qr[1], C0), P0[10], P0[11], P0[12], P0[13], pw1[0] = PKW(P0, 8),  pw1[1] = PKW(P0, 10), pw1); \
    VRD(5, 1); SBAR(); GAPA(C1 = MFMA32(kf[3], qr[1], C1), P0[14], P0[15], P1[0], P1[1],   pw1[2] = PKW(P0, 12), pw1[3] = PKW(P0, 14), pw1); \
    VRD(2, 2); SBAR(); GAPA(C0 = MFMA32(kf[4], qr[2], C0), P1[2], P1[3], P1[4], P1[5],     pw2[0] = PKW(P1, 0),  pw2[1] = PKW(P1, 2),  pw2); \
    VRD(6, 2); SBAR(); GAPA(C1 = MFMA32(kf[5], qr[2], C1), P1[6], P1[7], P1[8], P1[9],     pw2[2] = PKW(P1, 4),  pw2[3] = PKW(P1, 6),  pw2); \
    VRD(3, 3); SBAR(); GAPA(C0 = MFMA32(kf[6], qr[3], C0), P1[10], P1[11], P1[12], P1[13], pw3[0] = PKW(P1, 8),  pw3[1] = PKW(P1, 10), pw3); \
    VRD(7, 3); SBAR(); GAPA(C1 = MFMA32(kf[7], qr[3], C1), P1[14], P1[15], 0.f, 0.f,       pw3[2] = PKW(P1, 12), pw3[3] = PKW(P1, 14), pw3); \
    l_reg += sacc; } while (0)
#define STEP_WW(C0, C1, P0, P1, t, KR, VR) do { SBAR(); const LAS char* vp_ = vp0 + sl_prev; const int cad = CADDR((t) + 1); \
    PHASEA_PW(C0, C1, P0, P1, false); STAGE(t, KR, VR); float nmh; DECIDE_W(C0, C1); SBAR(); \
                               GAPB(o0 = MFMA32(VFR(0), PAF(0), o0), C0, 0);  CLDA(P0, 0); CLDA(P0, 1); SBAR(); \
                               GAPB(o1 = MFMA32(VFR(4), PAF(0), o1), C0, 4);  CLDA(P0, 2); CLDA(P0, 3); SBAR(); \
    KLD2(sl_next, 0); SBAR();  GAPB(o0 = MFMA32(VFR(1), PAF(1), o0), C0, 8);  CLDA(P0, 4); CLDA(P0, 5); SBAR(); \
    KLD2(sl_next, 1); SBAR();  GAPB(o1 = MFMA32(VFR(5), PAF(1), o1), C0, 12); CLDA(P0, 6); CLDA(P0, 7); SBAR(); \
    KLD2(sl_next, 2); SBAR();  GAPB(o0 = MFMA32(VFR(2), PAF(2), o0), C1, 0);  CLDB(P1, 0); CLDB(P1, 1); SBAR(); \
    KLD2(sl_next, 3); SBAR();  GAPM(o1 = MFMA32(VFR(6), PAF(2), o1)); } while (0)
#define STEP_DW(C0, C1, P0, P1, t, KR, VR) do { SBAR(); const LAS char* vp_ = vp0 + sl_prev; \
    PHASEA_PW(C0, C1, P0, P1, true); STAGE(t, KR, VR); float nmh; DECIDE_D(C0, C1); SBAR(); \
                               GAPB(o0 = MFMA32(VFR(0), PAF(0), o0), C0, 0); \
                               GAPB(o1 = MFMA32(VFR(4), PAF(0), o1), C0, 4); \
    KLD2(sl_next, 0); SBAR();  GAPB(o0 = MFMA32(VFR(1), PAF(1), o0), C0, 8); \
    KLD2(sl_next, 1); SBAR();  GAPB(o1 = MFMA32(VFR(5), PAF(1), o1), C0, 12); \
    KLD2(sl_next, 2); SBAR();  GAPB(o0 = MFMA32(VFR(2), PAF(2), o0), C1, 0); \
    KLD2(sl_next, 3); SBAR();  GAPB(o1 = MFMA32(VFR(6), PAF(2), o1), C1, 4); \
                               EXG(C1, 8); EXG(C1, 12); } while (0)
#define STEP_DD(C0, C1, P0, P1, t, KR, VR) do { SBAR(); const LAS char* vp_ = vp0 + sl_prev; \
    PHASEA_PD(C0, C1, P0, P1, true); STAGE(t, KR, VR); float nmh; DECIDE_D(C0, C1); SBAR(); \
                               GAPB(o0 = MFMA32(VFR(0), PAF(0), o0), C0, 0); \
                               GAPB(o1 = MFMA32(VFR(4), PAF(0), o1), C0, 4); \
    KLD2(sl_next, 0); SBAR();  GAPB(o0 = MFMA32(VFR(1), PAF(1), o0), C0, 8); \
    KLD2(sl_next, 1); SBAR();  GAPB(o1 = MFMA32(VFR(5), PAF(1), o1), C0, 12); \
    KLD2(sl_next, 2); SBAR();  GAPB(o0 = MFMA32(VFR(2), PAF(2), o0), C1, 0); \
    KLD2(sl_next, 3); SBAR();  GAPB(o1 = MFMA32(VFR(6), PAF(2), o1), C1, 4); \
                               GAPB(o0 = MFMA32(VFR(3), PAF(3), o0), C1, 8); \
                               GAPB(o1 = MFMA32(VFR(7), PAF(3), o1), C1, 12); } while (0)
    f32x16 zero16;
#pragma unroll
    for (int i = 0; i < 16; ++i) zero16[i] = 0.f;
    WBAR();
    sl_prev = 2 * AT_SLOTB; sl_cur = 0; sl_next = AT_SLOTB;
    if (!ctx) {
        { const int cad = CADDR(0);
#pragma unroll
          for (int q = 0; q < 8; ++q) CLDA(pA0, q);
          CLDB(pA1, 0); CLDB(pA1, 1); }
#pragma unroll
        for (int j = 0; j < 4; ++j) KLD2(0, j);
#pragma unroll
        for (int j = 0; j < 4; ++j) { pA0 = MFMA32(kf[2 * j], qr[j], pA0); pA1 = MFMA32(kf[2 * j + 1], qr[j], pA1); }
        STAGE(0, kreg, vreg);
        { float nmh; DECIDE_W(pA0, pA1);
#pragma unroll
          for (int r_ = 0; r_ < 16; ++r_) pA0[r_] = EX(pA0[r_]);
#pragma unroll
          for (int r_ = 0; r_ < 4; ++r_) pA1[r_] = EX(pA1[r_]); }
        { const int cad = CADDR(1);
#pragma unroll
          for (int q = 0; q < 8; ++q) CLDA(pB0, q);
          CLDB(pB1, 0); CLDB(pB1, 1); }
#pragma unroll
        for (int j = 0; j < 4; ++j) KLD2(AT_SLOTB, j);
        WBAR(); ROT();
#pragma unroll 1
        for (int t = 1; t < NWP; t += 2) {
            STEP_WW(pB0, pB1, pA0, pA1, t, kreg2, vreg2);     WBAR(); RESC(); ROT();
            STEP_WW(pA0, pA1, pB0, pB1, t + 1, kreg, vreg); WBAR(); RESC(); ROT();
        }
        STEP_DW(pB0, pB1, pA0, pA1, NWP, kreg2, vreg2); WBAR(); RESC(); ROT();
    } else {
#pragma unroll
        for (int j = 0; j < 4; ++j) KLD2(0, j);
        pB0 = MFMA32(kf[0], qr[0], zero16); pB1 = MFMA32(kf[1], qr[0], zero16);
#pragma unroll
        for (int j = 1; j < 4; ++j) { pB0 = MFMA32(kf[2 * j], qr[j], pB0); pB1 = MFMA32(kf[2 * j + 1], qr[j], pB1); }
        STAGE(0, kreg, vreg);
        { float nmh; DECIDE_D(pB0, pB1);
#pragma unroll
          for (int r_ = 0; r_ < 16; ++r_) { pB0[r_] = EX(pB0[r_]); pB1[r_] = EX(pB1[r_]); } }
#pragma unroll
        for (int j = 0; j < 4; ++j) KLD2(AT_SLOTB, j);
        WBAR(); ROT();
    }
    if (ctx) {
      STEP_DD(pA0, pA1, pB0, pB1, 1, kreg2, vreg2); WBAR(); RESC(); ROT();
      STEP_DD(pB0, pB1, pA0, pA1, 2, kreg, vreg);   WBAR(); RESC(); ROT();
      STEP_DD(pA0, pA1, pB0, pB1, 3, kreg2, vreg2); WBAR(); RESC(); ROT();
    } else {
      STEP_DD(pA0, pA1, pB0, pB1, NWP + 1, kreg, vreg);   WBAR(); RESC(); ROT();
      STEP_DD(pB0, pB1, pA0, pA1, NWP + 2, kreg2, vreg2); WBAR(); RESC(); ROT();
      STEP_DD(pA0, pA1, pB0, pB1, NWP + 3, kreg, vreg);   WBAR(); RESC(); ROT(); }
#define DRAIN(P0, P1) do { float sacc = P0[0] + P0[1]; \
      _Pragma("unroll") for (int r_ = 2; r_ < 16; ++r_) sacc += P0[r_]; \
      _Pragma("unroll") for (int r_ = 0; r_ < 16; ++r_) sacc += P1[r_]; \
      l_reg += sacc; \
      pw0 = (u32x4){PKW(P0, 0), PKW(P0, 2), PKW(P0, 4), PKW(P0, 6)}; pw1 = (u32x4){PKW(P0, 8), PKW(P0, 10), PKW(P0, 12), PKW(P0, 14)}; \
      pw2 = (u32x4){PKW(P1, 0), PKW(P1, 2), PKW(P1, 4), PKW(P1, 6)}; pw3 = (u32x4){PKW(P1, 8), PKW(P1, 10), PKW(P1, 12), PKW(P1, 14)}; \
      PIN(pw0); PIN(pw1); PIN(pw2); PIN(pw3); SBAR(); \
      _Pragma("unroll") for (int i_ = 0; i_ < 4; ++i_) zr[i_] = *(const u32x4*)(zp + (size_t)i_ * 8 * 512); \
      asm volatile("" ::: "memory"); if (next_ctx >= 0) attn_prefetch(F, layer, next_ctx, true, P); asm volatile("" ::: "memory");     \
      const LAS char* vp_ = vp0 + sl_prev; VRD(0, 0); VRD(4, 0); VRD(1, 1); VRD(5, 1); VRD(2, 2); VRD(6, 2); VRD(3, 3); VRD(7, 3); \
      o0 = MFMA32(VFR(0), PAF(0), o0); o1 = MFMA32(VFR(4), PAF(0), o1); o0 = MFMA32(VFR(1), PAF(1), o0); o1 = MFMA32(VFR(5), PAF(1), o1); \
      o0 = MFMA32(VFR(2), PAF(2), o0); o1 = MFMA32(VFR(6), PAF(2), o1); o0 = MFMA32(VFR(3), PAF(3), o0); o1 = MFMA32(VFR(7), PAF(3), o1); } while (0)
    int le = lane; asm volatile("" : "+v"(le));
    unsigned char* wse = kws();
    const bf16_t* zp = (const bf16_t*)(wse + WS_SZA) + (size_t)(R0 + (le >> 3)) * 512 + h * 64 + (le & 7) * 8;
    u32x4 zr[4];
    DRAIN(pA0, pA1);
#undef DRAIN
#undef STEP_DD
#undef STEP_DW
#undef STEP_WW
#undef PHASEA_PD
#undef PHASEA_PW
#undef QK0
#undef QK1
#undef STAGE
#undef EXG
#undef GAPB
#undef GAPM
#undef GAPA
#undef VRD
#undef VFR
#undef PAF
#undef PKW
#undef EX
#undef RESC
#undef DECIDE_W
#undef DECIDE_D
#undef DEC_TAIL
#undef CLDA
#undef CLDB
#undef CADDR
#undef KLD2
#undef MX3
#undef ROT
#undef VT
    { auto rr = __builtin_amdgcn_permlane32_swap(__float_as_uint(l_reg), __float_as_uint(l_reg), false, false); l_reg = __uint_as_float(rr[0]) + __uint_as_float(rr[1]); }
    const float inv = 1.0f / l_reg;
    { LAS char* stg = L + AT_TBL + wid * 4608; LAS char* srow = stg + (le >> 3) * 144 + (le & 7) * 16; LAS char* sfrag = stg + (le & 31) * 144 + (le >> 5) * 8;
#pragma unroll
      for (int i = 0; i < 4; ++i) *(LAS u32x4*)(srow + i * 8 * 144) = zr[i];
      asm volatile("s_waitcnt lgkmcnt(0)" ::: "memory");
      u32x2 zg0[4], zg1[4];
#pragma unroll
      for (int g = 0; g < 4; ++g) { zg0[g] = *(const LAS u32x2*)(sfrag + 16 * g); zg1[g] = *(const LAS u32x2*)(sfrag + 64 + 16 * g); }
      asm volatile("s_waitcnt lgkmcnt(0)" ::: "memory");
#pragma unroll
      for (int g = 0; g < 4; ++g) {
          const u32x2 z0 = zg0[g], z1 = zg1[g];
          u32x2 w0, w1;
          w0.x = cvtpk_s(o0[4 * g + 0] * inv * bflo(z0.x), o0[4 * g + 1] * inv * bfhi(z0.x)); w0.y = cvtpk_s(o0[4 * g + 2] * inv * bflo(z0.y), o0[4 * g + 3] * inv * bfhi(z0.y));
          w1.x = cvtpk_s(o1[4 * g + 0] * inv * bflo(z1.x), o1[4 * g + 1] * inv * bfhi(z1.x)); w1.y = cvtpk_s(o1[4 * g + 2] * inv * bflo(z1.y), o1[4 * g + 3] * inv * bfhi(z1.y));
          *(LAS u32x2*)(sfrag + 16 * g) = w0; *(LAS u32x2*)(sfrag + 64 + 16 * g) = w1; }
      asm volatile("s_waitcnt lgkmcnt(0)" ::: "memory");
      bf16_t* yp = (bf16_t*)(wse + WS_YAB) + (size_t)(R0 + (le >> 3)) * 1024 + h * 64 + (le & 7) * 8;
#pragma unroll
      for (int i = 0; i < 4; ++i) { const u32x4 v = *(const LAS u32x4*)(srow + i * 8 * 144); *(u32x4*)(yp + (size_t)i * 8 * 1024) = v; } }
    WBAR();
#undef WBAR
#undef PIN
#undef SBAR
}
#undef ATT_SRC
#undef ATT_DECODE

__device__ __forceinline__ void mix_phase(Frame& F, int layer) {
    AttnPre P;
    const int t_ctx = 255 - F.bx;
    for (int t = F.bx; t < M / 32; t += 256) conv_task(F, layer, t, P, t + 256 >= M / 32 ? F.bx : -1);
    attn_wg(F, layer, F.bx, false, P, t_ctx < 128 ? t_ctx : -1);
    if (t_ctx < 128) attn_wg(F, layer, t_ctx, true, P, -1);
}

__device__ __forceinline__ void cvec_phase(Frame& F) {
    const int gw = F.bx * 8 + F.wave, NGW = F.G * 8;
    const float* md = WSP(float, WS_MOD) + 5 * 3072;
    f32x4 sh[5][4];
#pragma unroll
    for (int g = 0; g < 5; ++g)
#pragma unroll
        for (int i = 0; i < 4; ++i) sh[g][i] = *(const f32x4*)(md + g * 3072 + 16 * F.lane + 4 * i);
    const bf16_t* W = WSP(bf16_t, WS_WTIN) + (size_t)DIN * D; const float* bp = WSP(float, WS_BIASP) + DIN; float* cv = WSP(float, WS_CVEC);
    for (int n = gw; n < DIN; n += NGW) {
        const u32x4 wa = *(const u32x4*)(W + (size_t)n * D + 16 * F.lane), wb = *(const u32x4*)(W + (size_t)n * D + 16 * F.lane + 8);
        const f32x4 w0 = {bflo(wa.x), bfhi(wa.x), bflo(wa.y), bfhi(wa.y)}, w1 = {bflo(wa.z), bfhi(wa.z), bflo(wa.w), bfhi(wa.w)};
        const f32x4 w2 = {bflo(wb.x), bfhi(wb.x), bflo(wb.y), bfhi(wb.y)}, w3 = {bflo(wb.z), bfhi(wb.z), bflo(wb.w), bfhi(wb.w)};
        const float bias = bp[n];
#pragma unroll
        for (int g = 0; g < 5; ++g) { const f32x4 p = sh[g][0] * w0 + sh[g][1] * w1 + sh[g][2] * w2 + sh[g][3] * w3;
            const float sm = wave_sum((p[0] + p[1]) + (p[2] + p[3])); if (F.lane == 0) cv[g * DIN + n] = sm + bias; }
    }
}

struct Args { const float* in[20]; float* out; unsigned char* ws; int ph_lo, ph_hi; };

__global__ void __launch_bounds__(512, 2) mk_fwd(Args args) {
    extern __shared__ __attribute__((aligned(16))) unsigned char lds_raw[];
    Frame F;
    F.lds = (LAS unsigned char*)lds_raw;
    F.tid = threadIdx.x; F.lane = F.tid & 63; F.wave = __builtin_amdgcn_readfirstlane(F.tid >> 6); F.G = gridDim.x; F.bx = blockIdx.x;
    for (int u = F.tid; u < (LDS_BYTES - LDSCTL_OFF) / 4; u += 512) ((LAS unsigned*)(F.lds + LDSCTL_OFF))[u] = 0u;
    __syncthreads();
    XcdBarrier bar; bar.bar = WSP(unsigned, WS_CTL) + CW_BAR; bar.x = 0; bar.st = nullptr;
#define lo (kint(176))
#define hi (kint(180))
    if (hi - lo > 1) bar = xcd_barrier_post(WSP(unsigned, WS_CTL) + CW_BAR, (volatile LAS unsigned*)(F.lds + MISC_OFF) + 8);
#ifndef PH_MASK
#define PH_MASK 0x7f
#endif
#define PHK(kind) ((PH_MASK >> (kind)) & 1)
#define IN(k) (lo <= (k) && (k) < hi)
#define SEAM(k) do { if (IN(k) && IN((k) + 1)) { XcdBarrier bb_; bb_.bar = WSP(unsigned, WS_CTL) + CW_BAR; bb_.x = xb_xcc_id(); bb_.st = (volatile LAS unsigned*)((LAS unsigned char*)lds_raw + MISC_OFF) + 8; xcd_barrier(bb_); } } while (0)
#define FRESH() do { F.tid = fresh_tid(); F.lane = F.tid & 63; F.wave = __builtin_amdgcn_readfirstlane(F.tid >> 6); } while (0)

    if (PHK(0) && IN(0)) { FRESH(); p0_prologue(F); SEAM(0); }
    for (int layer = 0; layer < DEPTH; ++layer) {
        const int pb = 1 + 5 * layer;
        if (PHK(1) && IN(pb) && layer == 0) { FRESH();
            if (layer == 0 && F.bx == F.G - 1) { const float* rg = kin(I_RMS_G) + D; const float* md = WSP(float, WS_MOD) + 5 * 3072; float* gm = WSP(float, WS_GM);
                for (int i = F.tid; i < 5 * 1024; i += 512) { const int g = i >> 10, c = i & 1023; gm[i] = rg[c] * (1.0f + md[g * 3072 + 1024 + c]); } }
            norm_phase(F, layer); SEAM(pb); }
        if (PHK(2) && IN(pb + 1)) {
            constexpr int M1 = 46 * 256;
            const bf16_t* Ain = layer == 0 ? WSP(bf16_t, WS_H) : WSP(bf16_t, WS_YAB);
            { pg8::Gemm g{Ain, WSP(bf16_t, WS_WTIN) + (size_t)layer * DIN * D, M1, DIN, D, D}; pg8::StaticOrder S; S.init(M1, DIN, F.G, F.bx);
              if (layer == 0) { EpiInT<4> E{layer, 0}; pg8::gemm_phase<EpiInT<4>>(F.lds, g, S, E); } else { EpiInT<4, true> E{layer, 0}; pg8::gemm_phase<EpiInT<4, true>>(F.lds, g, S, E); } }
            { pg8::Gemm g{Ain + (size_t)M1 * D, WSP(bf16_t, WS_WTIN) + (size_t)layer * DIN * D, M - M1, DIN, D, D}; pg8::StaticOrder S; S.init(M - M1, DIN, F.G, F.G - 1 - F.bx, 0, 128);
              if (layer == 0) { EpiInT<2> E{layer, M1}; pg8::gemm_phase<EpiInT<2>>(F.lds, g, S, E); } else { EpiInT<2, true> E{layer, M1}; pg8::gemm_phase<EpiInT<2, true>>(F.lds, g, S, E); } }
            if (layer == 0) { const int nidle = F.G - (M - M1) / 128 * (DIN / 256);
                if (nidle > 0 && F.bx < nidle) { FRESH(); __syncthreads(); wt_items(F, 1, F.bx * 8 + F.wave, nidle * 8); } }
            SEAM(pb + 1);
        }
        if (PHK(3) && IN(pb + 2)) { FRESH(); mix_phase(F, layer); SEAM(pb + 2); }
        if (PHK(4) && IN(pb + 3)) {
            if (layer == 0) { FRESH(); cvec_phase(F); }
            pg8::Gemm g{WSP(bf16_t, WS_YAB), WSP(bf16_t, WS_WTPROJ) + (size_t)layer * D * D, M, D, D, D}; pg8::StaticOrder S; S.init(M, D, F.G, F.bx, 0, 192);
            EpiProj E{};
            pg8::gemm_phase<EpiProj>(F.lds, g, S, E);
            SEAM(pb + 3);
        }
        if (PHK(5) && IN(pb + 4)) {
            pg8::Gemm g{WSP(bf16_t, WS_H), WSP(bf16_t, WS_WTOUT) + (size_t)layer * D * D, M, D, D, D}; pg8::StaticOrder S; S.init(M, D, F.G, F.bx, 0, 192);
            if (layer + 1 < DEPTH) { EpiOutT<false> E{layer}; pg8::gemm_phase<EpiOutT<false>>(F.lds, g, S, E); }
            else { EpiOutT<true> E{layer}; pg8::gemm_phase<EpiOutT<true>>(F.lds, g, S, E); }
            SEAM(pb + 4);
        }
    }
    if (PHK(6) && IN(11)) { FRESH(); final_norm_phase(F); }
#undef IN
#undef SEAM
#undef lo
#undef hi
}

extern "C" void kernel_launch(void* const* d_in, const int* in_sizes, int n_in, void* d_out, int out_size, void* d_ws, size_t ws_size, hipStream_t stream) {
    static int grid = 0;
    if (grid == 0) {
        if (n_in != 20 || ws_size < WS_END) { fprintf(stderr, "kernel_launch: unexpected inputs (n_in %d, ws %zu)\n", n_in, ws_size); grid = -1; return; }
        int dev = 0, cus = 0, per_cu = 0;
        if (hipGetDevice(&dev) != hipSuccess || hipDeviceGetAttribute(&cus, hipDeviceAttributeMultiprocessorCount, dev) != hipSuccess) { grid = -1; return; }
        if (hipFuncSetAttribute((const void*)mk_fwd, hipFuncAttributeMaxDynamicSharedMemorySize, LDS_BYTES) != hipSuccess) { fprintf(stderr, "kernel_launch: hipFuncSetAttribute failed\n"); grid = -1; return; }
        if (hipOccupancyMaxActiveBlocksPerMultiprocessor(&per_cu, (const void*)mk_fwd, 512, LDS_BYTES) != hipSuccess || per_cu < 1) { fprintf(stderr, "kernel_launch: occupancy query says %d\n", per_cu); per_cu = 1; }
        (void)hipGetLastError();
        if (cus < 256) { fprintf(stderr, "kernel_launch: %d CUs; the mixer's work split is written for a grid of 256 workgroups\n", cus); grid = -1; return; }
        grid = 256;
    }
    if (grid < 0) return;
    (void)hipMemsetAsync((char*)d_ws + WS_CTL, 0, CTL_ZERO_BYTES, stream);
    Args a{};
    for (int i = 0; i < 20; ++i) a.in[i] = (const float*)d_in[i];
    a.out = (float*)d_out; a.ws = (unsigned char*)d_ws;
    if (MK_N_LAUNCHES == 1) { a.ph_lo = 0; a.ph_hi = NPHASE; hipLaunchKernelGGL(mk_fwd, dim3(grid), dim3(512), LDS_BYTES, stream, a); }
    else for (int p = 0; p < NPHASE; ++p) { a.ph_lo = p; a.ph_hi = p + 1; hipLaunchKernelGGL(mk_fwd, dim3(grid), dim3(512), LDS_BYTES, stream, a); }
}
```

```cpp
#include <hip/hip_runtime.h>
#include <cstdio>
#include <cstdint>

#ifndef MK_N_LAUNCHES
#define MK_N_LAUNCHES 1
#endif

#define GAS __attribute__((address_space(1)))
#define LAS __attribute__((address_space(3)))
typedef unsigned short bf16_t;
typedef short bf16x8 __attribute__((ext_vector_type(8)));
typedef float f32x4 __attribute__((ext_vector_type(4)));
typedef float f32x2 __attribute__((ext_vector_type(2)));
typedef unsigned u32x4 __attribute__((ext_vector_type(4)));
typedef unsigned u32x2 __attribute__((ext_vector_type(2)));
typedef GAS unsigned gu32;
#define RLX_AGENT __ATOMIC_RELAXED, __HIP_MEMORY_SCOPE_AGENT
#define LDS_WAIT() asm volatile("s_waitcnt lgkmcnt(0)" ::: "memory")
#define VM_WAIT() asm volatile("s_waitcnt vmcnt(0)" ::: "memory")

constexpr int D = 1024, NCTX = 4096, NLAT = 8192, M = NCTX + NLAT, DIN = 5632, DEPTH = 2, NH = 8, HD = 64;
constexpr int NPHASE = 12;
constexpr float EPS = 1e-6f;

constexpr size_t MiB = 1u << 20;
constexpr size_t WS_CTL = 0, CTL_ZERO_BYTES = 192 * 1024;
constexpr size_t WS_RSS2 = 128 * 1024;
constexpr size_t WS_RSS = 64 * 1024;
constexpr size_t WS_GM = 1 * MiB + 192 * 1024;
constexpr size_t WS_CVEC = 1 * MiB + 256 * 1024;
constexpr size_t WS_MOD = 1 * MiB;
constexpr size_t WS_BIASP = 1 * MiB + 128 * 1024;
constexpr size_t WS_WTIN = 2 * MiB;
constexpr size_t WS_WTPROJ = 24 * MiB;
constexpr size_t WS_WTOUT = 28 * MiB;
constexpr size_t WS_CK = 32 * MiB, WS_CV = 34 * MiB;
constexpr size_t WS_H = 36 * MiB;
constexpr size_t WS_Q = 60 * MiB, WS_K = 72 * MiB, WS_V = 84 * MiB, WS_SZA = 96 * MiB, WS_U = 108 * MiB, WS_SZB = 120 * MiB;
constexpr size_t WS_GR = 132 * MiB, WS_GB = 156 * MiB;
constexpr size_t WS_YAB = 180 * MiB;
constexpr size_t WS_X1 = 204 * MiB;
constexpr size_t WS_END = 228 * MiB;
constexpr int CW_BAR = 4096;
constexpr int CW_ROWBLK = 8192;

constexpr int RING_BYTES = 131072;
constexpr int LDSCTL_OFF = RING_BYTES, MISC_OFF = LDSCTL_OFF + 320;
constexpr int LDS_BYTES = 147456;

__device__ __forceinline__ unsigned f2bf(float f) { unsigned u = __builtin_bit_cast(unsigned, f); return (u + 0x7fffu + ((u >> 16) & 1u)) >> 16; }
__device__ __forceinline__ unsigned pk2(float lo, float hi) { return f2bf(lo) | (f2bf(hi) << 16); }
typedef __bf16 bf16x2_cv __attribute__((ext_vector_type(2)));
__device__ __forceinline__ unsigned cvt_pk_bf16(float lo, float hi) { f32x2 v = {lo, hi}; bf16x2_cv b = __builtin_convertvector(v, bf16x2_cv); return __builtin_bit_cast(unsigned, b); }
__device__ __forceinline__ float bflo(unsigned w) { return __builtin_bit_cast(float, w << 16); }
__device__ __forceinline__ float bfhi(unsigned w) { return __builtin_bit_cast(float, w & 0xffff0000u); }
__device__ __forceinline__ float sigmoid_f(float x) { return __builtin_amdgcn_rcpf(1.0f + __expf(-x)); }
__device__ __forceinline__ float silu_f(float x) { return x * sigmoid_f(x); }
__device__ __forceinline__ float dpp_f(float v, float o) { return v + o; }
__device__ __forceinline__ float wave_sum(float v) {
#define DPP_ADD(ctrl, rm, bc) v += __builtin_bit_cast(float, __builtin_amdgcn_update_dpp(0, __builtin_bit_cast(int, v), ctrl, rm, 0xf, bc))
    DPP_ADD(0x111, 0xf, true); DPP_ADD(0x112, 0xf, true); DPP_ADD(0x114, 0xf, true); DPP_ADD(0x118, 0xf, true);
    DPP_ADD(0x142, 0xa, false); DPP_ADD(0x143, 0xc, false);
#undef DPP_ADD
    return __builtin_bit_cast(float, __builtin_amdgcn_readlane(__builtin_bit_cast(int, v), 63));
}

__device__ __forceinline__ int fresh_tid() { int t = threadIdx.x; asm volatile("" : "+v"(t)); return t; }

namespace pg8 {
constexpr int BM = 256, BK = 64, HALF = 128, HTB = HALF * BK * 2, STAGE_BYTES = 8 * HTB, NXCD = 8, WGM = 8;
__host__ __device__ __forceinline__ int lds_byte(int r, int c) { const int st = (r >> 4) * 2 + (c >> 5), rr = r & 15, cc = c & 31, ob = rr * 64 + cc * 2; return st * 1024 + (ob ^ (((ob >> 9) & 1) << 5)); }
__host__ __device__ __forceinline__ void stage_rc(int b, int& R, int& C) { const int st = b / 1024, sb = b % 1024, swz = sb ^ (((sb >> 9) & 1) << 5); R = (st >> 1) * 16 + swz / 64; C = (st & 1) * 32 + (swz % 64) / 2; }
__host__ __device__ __forceinline__ int perm32(int rho) { const int n = rho >> 4, i = rho & 15; return 8 * (i >> 2) + 4 * n + (i & 3); }

struct Unit { int pm, pn, kh; };
struct Gemm { const bf16_t* A; const bf16_t* Bt; int M, N, K, ld; };

struct StaticOrder {
    int nM, nN, nwg, G, c;
    __host__ __device__ void init(int M_, int N_, int G_, int c_, int split_ = 0, int bm_ = BM) { nM = M_ / bm_; nN = N_ / BM; nwg = nM * nN; G = G_; c = c_; split = split_; }
    int split;
    __host__ __device__ bool next(int i0, Unit& u) const {
        const int i = split ? (i0 >> 1) : i0; u.kh = split ? (i0 & 1) : 0;
        const long L = (long)i * G + c; if (L >= nwg) return false;
        int wgid = (int)L; { const int q = nwg / NXCD, r = nwg % NXCD, xcd = wgid % NXCD, off = wgid / NXCD; wgid = (xcd < r ? xcd * (q + 1) : r * (q + 1) + (xcd - r) * q) + off; }
        const int nig = WGM * nN, gid = wgid / nig, fm = gid * WGM, gsz = (nM - fm) < WGM ? (nM - fm) : WGM;
        u.pm = fm + ((wgid % nig) % gsz); u.pn = (wgid % nig) / gsz; return true;
    }
};

template <class Epi, bool ALIGN_EPI = true, bool SP2 = true>
__device__ __forceinline__ void gemm_phase(LAS unsigned char* lds, const Gemm g, const StaticOrder& S, const Epi& E) {
    const int tid = fresh_tid(), wid = __builtin_amdgcn_readfirstlane(tid >> 6), lane = tid & 63, wr = wid >> 2, wc = wid & 3, fr = lane & 15, fq = lane >> 4;
    static_assert(SP2 || Epi::MB == 4, "tiles lower than 256 rows use the SP2 loop");
    constexpr int MB = Epi::MB, HROWS = 32 * MB;
    const int K = g.ld, nt = g.K / BK;
    const size_t khstep = (size_t)g.K * 2;
    unsigned voffA[2], voffB[2];
#pragma unroll
    for (int i = 0; i < 2; ++i) { int R, C; stage_rc(tid * 16 + i * 8192, R, C); const int Rb = Epi::PERM ? ((R & ~31) + perm32(R & 31)) : R;
        voffA[i] = (unsigned)(R * K + C) * 2u; voffB[i] = (unsigned)(Rb * K + C) * 2u; }
    const size_t kstep = (size_t)(BK * 2);
    const size_t hstep = (size_t)HROWS * K * 2;
    const size_t hstepB = (size_t)HALF * K * 2;
    const size_t tstep = 2 * hstep, tstepB = 2 * hstepB;
    const unsigned ldsw = (unsigned)wid * 1024u;
    const int aoff = lds_byte(wr * (16 * MB) + fr, fq * 8), boff = lds_byte(wc * 32 + fr, fq * 8);
#define PG8_SA(b, h) (((b) * 2 + (h)) * HTB)
#define PG8_SB(b, h) ((4 + (b) * 2 + (h)) * HTB)
#define PG8_STAGE(bufoff, gbase, voff) do { _Pragma("unroll") for (int _i = 0; _i < 2; ++_i) \
        __builtin_amdgcn_global_load_lds((const unsigned*)((const char*)(gbase) + (voff)[_i]), (LAS unsigned*)(lds + (bufoff) + ldsw + _i * 8192), 16, 0, 0); } while (0)
#define PG8_LDA(dst, b, h) do { _Pragma("unroll") for (int m = 0; m < MB; ++m) _Pragma("unroll") for (int k = 0; k < 2; ++k) dst[m][k] = *(const LAS bf16x8*)(lds + PG8_SA(b, h) + aoff + m * 2048 + k * 1024); } while (0)
#define PG8_LDB(dst, b, h) do { _Pragma("unroll") for (int n = 0; n < 2; ++n) _Pragma("unroll") for (int k = 0; k < 2; ++k) dst[n][k] = *(const LAS bf16x8*)(lds + PG8_SB(b, h) + boff + n * 2048 + k * 1024); } while (0)
#define PG8_MMA(ai, bj, At, Bt) do { __builtin_amdgcn_s_setprio(1); _Pragma("unroll") for (int m = 0; m < MB; ++m) _Pragma("unroll") for (int n = 0; n < 2; ++n) _Pragma("unroll") for (int k = 0; k < 2; ++k) \
        acc[ai][bj][m][n] = __builtin_amdgcn_mfma_f32_16x16x32_bf16(Bt[n][k], At[m][k], acc[ai][bj][m][n], 0, 0, 0); __builtin_amdgcn_s_setprio(0); } while (0)
#define PG8_WAIT_V(n) asm volatile("s_waitcnt vmcnt(" #n ")" ::: "memory")
    const int aIss = (MB == 4) ? 2 : (MB == 3) ? (wid < 4 ? 2 : 1) : (MB == 2) ? 1 : (wid < 4 ? 1 : 0);
#define PG8_STAGE_A(bufoff, gbase, voff) do { _Pragma("unroll") for (int _i = 0; _i < 2; ++_i) if (MB == 4 || _i < aIss) \
        __builtin_amdgcn_global_load_lds((const unsigned*)((const char*)(gbase) + (voff)[_i]), (LAS unsigned*)(lds + (bufoff) + ldsw + _i * 8192), 16, 0, 0); } while (0)
#define PG8_WAIT_VN(n) do { switch (n) { case 0: PG8_WAIT_V(0); break; case 1: PG8_WAIT_V(1); break; case 2: PG8_WAIT_V(2); break; case 4: PG8_WAIT_V(4); break; case 5: PG8_WAIT_V(5); break; \
        case 6: PG8_WAIT_V(6); break; default: PG8_WAIT_V(8); break; } } while (0)
#define PG8_WAIT_LOOP() do { if constexpr (MB == 4) PG8_WAIT_V(8); else PG8_WAIT_VN(4 + 2 * aIss); } while (0)
#define PG8_WAIT_P1() do { if constexpr (MB == 4) PG8_WAIT_V(2); else PG8_WAIT_VN(aIss); } while (0)
#define PG8_WAIT_P2() do { if constexpr (MB == 4) PG8_WAIT_V(6); else PG8_WAIT_VN(4 + aIss); } while (0)
#define PG8_WAIT_L(n) asm volatile("s_waitcnt lgkmcnt(" #n ")" ::: "memory")
#define PG8_BAR __builtin_amdgcn_s_barrier()
#define PG8_SCHED __builtin_amdgcn_sched_barrier(0)
    Unit cur, nxt; int ui = 0;
    if (!S.next(0, cur)) return;
    f32x4 acc[2][2][MB][2];
#pragma unroll
    for (int a = 0; a < 2; ++a)
#pragma unroll
        for (int b = 0; b < 2; ++b)
#pragma unroll
            for (int m = 0; m < MB; ++m)
#pragma unroll
                for (int n = 0; n < 2; ++n) acc[a][b][m][n] = (f32x4){0.f, 0.f, 0.f, 0.f};
    bf16x8 At[MB][2], B0[2][2], B1[2][2];
    const char* cA = (const char*)g.A + (size_t)cur.pm * tstep + cur.kh * khstep; const char* cB = (const char*)g.Bt + (size_t)cur.pn * tstepB + cur.kh * khstep;
    if constexpr (SP2) {
        PG8_STAGE(PG8_SB(0, 0), cB, voffB); PG8_STAGE(PG8_SB(0, 1), cB + hstepB, voffB); PG8_STAGE_A(PG8_SA(0, 0), cA, voffA); PG8_STAGE_A(PG8_SA(0, 1), cA + hstep, voffA);
        if (wr == 1) PG8_BAR;
        PG8_WAIT_P1(); PG8_BAR;
        PG8_STAGE(PG8_SB(1, 0), cB + kstep, voffB); PG8_STAGE_A(PG8_SA(1, 0), cA + kstep, voffA); PG8_STAGE(PG8_SB(1, 1), cB + hstepB + kstep, voffB);
        PG8_WAIT_P2(); PG8_BAR;
    } else {
        PG8_STAGE(PG8_SB(0, 0), cB, voffB); PG8_STAGE(PG8_SA(0, 0), cA, voffA); PG8_STAGE(PG8_SB(0, 1), cB + hstepB, voffB); PG8_STAGE(PG8_SA(0, 1), cA + hstep, voffA);
        if (wr == 1) PG8_BAR;
        PG8_WAIT_V(4); PG8_BAR;
        PG8_STAGE(PG8_SB(1, 0), cB + kstep, voffB); PG8_STAGE(PG8_SA(1, 0), cA + kstep, voffA); PG8_STAGE(PG8_SB(1, 1), cB + hstepB + kstep, voffB);
        PG8_WAIT_V(6); PG8_BAR;
    }
    for (;;) {
        const bool has_next = S.next(ui + 1, nxt);
        const char* nA = has_next ? (const char*)g.A + (size_t)nxt.pm * tstep + nxt.kh * khstep : cA; const char* nB = has_next ? (const char*)g.Bt + (size_t)nxt.pn * tstepB + nxt.kh * khstep : cB;
        for (int t = 0; t < nt; t += 2) {
            const bool last = (t == nt - 2);
            const char* a1 = cA + (size_t)(t + 1) * kstep;
            const char* a2 = last ? nA : cA + (size_t)(t + 2) * kstep; const char* b2 = last ? nB : cB + (size_t)(t + 2) * kstep;
            const char* a3 = a2 + kstep; const char* b3 = b2 + kstep;
            if constexpr (SP2) {
            PG8_LDB(B0, 0, 0); PG8_LDB(B1, 0, 1); PG8_SCHED; PG8_LDA(At, 0, 0); PG8_STAGE_A(PG8_SA(1, 1), a1 + hstep, voffA);
            PG8_WAIT_LOOP(); PG8_WAIT_L(0); PG8_BAR; PG8_MMA(0, 0, At, B0); PG8_MMA(0, 1, At, B1); PG8_BAR; PG8_SCHED;
            PG8_LDA(At, 0, 1); PG8_STAGE(PG8_SB(0, 0), b2, voffB); PG8_STAGE(PG8_SB(0, 1), b2 + hstepB, voffB); PG8_STAGE_A(PG8_SA(0, 0), a2, voffA);
            PG8_WAIT_LOOP(); PG8_WAIT_L(0); PG8_BAR; PG8_MMA(1, 0, At, B0); PG8_MMA(1, 1, At, B1); PG8_BAR; PG8_SCHED;
            PG8_LDB(B0, 1, 0); PG8_LDB(B1, 1, 1); PG8_SCHED; PG8_LDA(At, 1, 0); PG8_STAGE_A(PG8_SA(0, 1), a2 + hstep, voffA);
            PG8_WAIT_LOOP(); PG8_WAIT_L(0); PG8_BAR; PG8_MMA(0, 0, At, B0); PG8_MMA(0, 1, At, B1); PG8_BAR; PG8_SCHED;
            PG8_LDA(At, 1, 1); PG8_STAGE(PG8_SB(1, 0), b3, voffB); PG8_STAGE(PG8_SB(1, 1), b3 + hstepB, voffB); PG8_STAGE_A(PG8_SA(1, 0), a3, voffA);
            PG8_WAIT_LOOP(); PG8_WAIT_L(0); PG8_BAR; PG8_MMA(1, 0, At, B0); PG8_MMA(1, 1, At, B1); PG8_BAR; PG8_SCHED;
            } else {
            PG8_LDB(B0, 0, 0); PG8_SCHED; PG8_LDA(At, 0, 0); PG8_STAGE(PG8_SA(1, 1), a1 + hstep, voffA);
            PG8_WAIT_L(8); PG8_BAR; PG8_WAIT_L(0); PG8_MMA(0, 0, At, B0); PG8_BAR; PG8_SCHED;
            PG8_LDB(B1, 0, 1); PG8_STAGE(PG8_SB(0, 0), b2, voffB);
            PG8_BAR; PG8_WAIT_L(0); PG8_MMA(0, 1, At, B1); PG8_BAR;
            PG8_LDA(At, 0, 1); PG8_STAGE(PG8_SA(0, 0), a2, voffA);
            PG8_BAR; PG8_WAIT_L(0); PG8_MMA(1, 0, At, B0); PG8_BAR; PG8_SCHED;
            PG8_STAGE(PG8_SB(0, 1), b2 + hstepB, voffB);
            PG8_WAIT_V(6); PG8_BAR; PG8_MMA(1, 1, At, B1); PG8_BAR;
            PG8_LDB(B0, 1, 0); PG8_SCHED; PG8_LDA(At, 1, 0); PG8_STAGE(PG8_SA(0, 1), a2 + hstep, voffA);
            PG8_WAIT_L(8); PG8_BAR; PG8_WAIT_L(0); PG8_MMA(0, 0, At, B0); PG8_BAR; PG8_SCHED;
            PG8_LDB(B1, 1, 1); PG8_STAGE(PG8_SB(1, 0), b3, voffB);
            PG8_BAR; PG8_WAIT_L(0); PG8_MMA(0, 1, At, B1); PG8_BAR;
            PG8_LDA(At, 1, 1); PG8_STAGE(PG8_SA(1, 0), a3, voffA);
            PG8_BAR; PG8_WAIT_L(0); PG8_MMA(1, 0, At, B0); PG8_BAR; PG8_SCHED;
            PG8_STAGE(PG8_SB(1, 1), b3 + hstepB, voffB);
            PG8_WAIT_V(6); PG8_BAR; PG8_MMA(1, 1, At, B1); PG8_BAR;
            }
            if constexpr (Epi::MIDHOOK) { if (t + 2 == nt / 2) { E.mid(acc, cur, wr, wc, fr, fq); PG8_SCHED; } }
        }
        if constexpr (ALIGN_EPI) { if (wr == 0) PG8_BAR; }
        E(acc, cur, wr, wc, fr, fq);
        if (!has_next) break;
        {
#pragma unroll
        for (int a = 0; a < 2; ++a)
#pragma unroll
            for (int b = 0; b < 2; ++b)
#pragma unroll
                for (int m = 0; m < MB; ++m)
#pragma unroll
                    for (int n = 0; n < 2; ++n) acc[a][b][m][n] = (f32x4){0.f, 0.f, 0.f, 0.f};
        }
        cur = nxt; cA = nA; cB = nB; ++ui;
        if constexpr (ALIGN_EPI) { if (wr == 1) PG8_BAR; }
    }
    PG8_WAIT_V(0);
    if constexpr (!ALIGN_EPI) { if (wr == 0) PG8_BAR; }
    PG8_BAR;
#undef PG8_SA
#undef PG8_SB
#undef PG8_STAGE
#undef PG8_STAGE_A
#undef PG8_WAIT_VN
#undef PG8_WAIT_LOOP
#undef PG8_WAIT_P1
#undef PG8_WAIT_P2
#undef PG8_LDA
#undef PG8_LDB
#undef PG8_MMA
#undef PG8_WAIT_V
#undef PG8_WAIT_L
#undef PG8_BAR
#undef PG8_SCHED
}
}

#define AS4 __attribute__((address_space(4)))
__device__ __forceinline__ const float* kin(int k) { const AS4 char* p = (const AS4 char*)__builtin_amdgcn_kernarg_segment_ptr(); asm volatile("" : "+s"(p)); return *(const float* const AS4*)(p + 8 * k); }
__device__ __forceinline__ float* kout() { const AS4 char* p = (const AS4 char*)__builtin_amdgcn_kernarg_segment_ptr(); asm volatile("" : "+s"(p)); return *(float* const AS4*)(p + 160); }
__device__ __forceinline__ int kint(int off) { const AS4 char* p = (const AS4 char*)__builtin_amdgcn_kernarg_segment_ptr(); asm volatile("" : "+s"(p)); return *(const int AS4*)(p + off); }
__device__ __forceinline__ unsigned char* kws() { const AS4 char* p = (const AS4 char*)__builtin_amdgcn_kernarg_segment_ptr(); asm volatile("" : "+s"(p)); return *(unsigned char* const AS4*)(p + 168); }
#define I_X_PROMPT 0
#define I_X_SAMPLE 1
#define I_CACHE_K 2
#define I_CACHE_V 3
#define I_C 4
#define I_C_CTX 5
#define I_RMS_G 6
#define I_W_ADA 7
#define I_B_ADA 8
#define I_W_IN 9
#define I_B_IN 10
#define I_REL_BIAS 11
#define I_DW_W 12
#define I_DW_B 13
#define I_LN_G 14
#define I_LN_B 15
#define I_W_PROJ_A 16
#define I_W_PROJ_B 17
#define I_W_OUT 18
#define I_FINAL_G 19
#define WSP(T, off) ((T*)(kws() + (off)))

constexpr float QSCALE = 0.125f * 1.4426950408889634f;
typedef f32x4 acc_t[2][2][4][2];
typedef f32x4 acc3_t[2][2][3][2];

template <int MB_, bool FU = false> struct EpiInT {
    static constexpr bool PERM = true, SPLIT2 = false, MIDHOOK = false; static constexpr int MB = MB_;
    typedef f32x4 accm_t[2][2][MB_][2];
    int layer, rowbase;
    template <bool ACT, bool ST, bool QS = false> __device__ __forceinline__ void plain(accm_t& acc, const f32x4 (&bv)[2][2], bf16_t* dst, float* st, int row0, int colbase) const {
#pragma unroll
        for (int ai = 0; ai < 2; ++ai)
#pragma unroll
            for (int m = 0; m < MB_; ++m) { const int row = row0 + ai * (32 * MB_) + m * 16;
#pragma unroll
                for (int bj = 0; bj < 2; ++bj) { f32x4 v0 = acc[ai][bj][m][0] + bv[bj][0], v1 = acc[ai][bj][m][1] + bv[bj][1];
                    if (QS) { v0 = v0 * QSCALE; v1 = v1 * QSCALE; }
                    if (ST) { float* sp = st + ((size_t)((row >> 8) * 512 + layer * 256 + (row & 255))) * 512 + colbase + bj * 128; *(f32x4*)sp = v0; *(f32x4*)(sp + 4) = v1; }
                    if (ACT) {
#pragma unroll
                        for (int j = 0; j < 4; ++j) { v0[j] = silu_f(v0[j]); v1[j] = silu_f(v1[j]); } }
                    u32x4 w; w.x = cvt_pk_bf16(v0[0], v0[1]); w.y = cvt_pk_bf16(v0[2], v0[3]); w.z = cvt_pk_bf16(v1[0], v1[1]); w.w = cvt_pk_bf16(v1[2], v1[3]);
                    *(u32x4*)(dst + (size_t)row * 512 + colbase + bj * 128) = w; } }
    }
    __device__ __forceinline__ void operator()(accm_t& acc, const pg8::Unit& u, int wr, int wc, int fr, int fq) const {
        asm volatile("" : "+v"(fr), "+v"(fq));
        const int row0 = rowbase + u.pm * (64 * MB_) + wr * (16 * MB_) + fr, c8 = wc * 32 + 8 * fq, pn = u.pn;
        const bool ctxrows = rowbase + u.pm * (64 * MB_) < NCTX;
        unsigned char* wsb = kws();
        bf16_t* Q = (bf16_t*)(wsb + WS_Q); bf16_t* K = (bf16_t*)(wsb + WS_K); bf16_t* V = (bf16_t*)(wsb + WS_V); bf16_t* SZA = (bf16_t*)(wsb + WS_SZA); bf16_t* U = (bf16_t*)(wsb + WS_U);
        bf16_t* SZB = (bf16_t*)(wsb + WS_SZB); bf16_t* GR = (bf16_t*)(wsb + WS_GR); bf16_t* GB = (bf16_t*)(wsb + WS_GB);
        const int tr0 = rowbase + u.pm * (64 * MB_), tg = tr0 < NCTX ? 0 : 1 + ((tr0 - NCTX) >> 11);
        const float* bp = FU ? (const float*)(wsb + WS_CVEC) + tg * DIN + pn * 256 + c8 : (const float*)(wsb + WS_BIASP) + layer * DIN + pn * 256 + c8;
        if (FU) { const float* rss = (const float*)(wsb + WS_RSS); float rq[2][MB_];
#pragma unroll
            for (int ai = 0; ai < 2; ++ai)
#pragma unroll
                for (int m = 0; m < MB_; ++m) rq[ai][m] = rss[row0 + ai * (32 * MB_) + m * 16];
#pragma unroll
            for (int ai = 0; ai < 2; ++ai)
#pragma unroll
                for (int m = 0; m < MB_; ++m) { const float rs = rsqrtf(rq[ai][m] * (1.0f / D) + EPS);
#pragma unroll
                    for (int bj = 0; bj < 2; ++bj) { acc[ai][bj][m][0] = acc[ai][bj][m][0] * rs; acc[ai][bj][m][1] = acc[ai][bj][m][1] * rs; } } }
        float* stk = kout() + (size_t)M * D; float* stv = stk + (size_t)16 * 2 * 256 * 512;
        f32x4 bv[2][2];
#pragma unroll
        for (int bj = 0; bj < 2; ++bj)
#pragma unroll
            for (int n = 0; n < 2; ++n) bv[bj][n] = *(const f32x4*)(bp + bj * 128 + 4 * n);
        const int colbase = (pn & 1) * 256 + c8;
        if (pn < 2) plain<false, false, true>(acc, bv, Q, nullptr, row0, colbase);
        else if (pn < 4) { if (ctxrows) plain<false, true>(acc, bv, K, stk, row0, colbase); else plain<false, false>(acc, bv, K, nullptr, row0, colbase); }
        else if (pn < 6) { if (ctxrows) plain<false, true>(acc, bv, V, stv, row0, colbase); else plain<false, false>(acc, bv, V, nullptr, row0, colbase); }
        else if (pn < 8) plain<true, false>(acc, bv, SZA, nullptr, row0, colbase);
        else if (pn == 12 || pn == 13) plain<true, false>(acc, bv, SZB, nullptr, row0, colbase);
        else if (pn < 12) {
            const int cb = (pn - 8) * 128 + c8;
#pragma unroll
            for (int ai = 0; ai < 2; ++ai)
#pragma unroll
                for (int m = 0; m < MB_; ++m) { const int row = row0 + ai * (32 * MB_) + m * 16;
                    f32x4 a0 = acc[ai][0][m][0] + bv[0][0], a1 = acc[ai][0][m][1] + bv[0][1], b0 = acc[ai][1][m][0] + bv[1][0], b1 = acc[ai][1][m][1] + bv[1][1];
#pragma unroll
                    for (int j = 0; j < 4; ++j) { a0[j] *= sigmoid_f(b0[j]); a1[j] *= sigmoid_f(b1[j]); }
                    u32x4 w; w.x = cvt_pk_bf16(a0[0], a0[1]); w.y = cvt_pk_bf16(a0[2], a0[3]); w.z = cvt_pk_bf16(a1[0], a1[1]); w.w = cvt_pk_bf16(a1[2], a1[3]);
                    *(u32x4*)(U + (size_t)row * 512 + cb) = w; }
        } else {
            const int cb = (pn - 14) * 128 + c8;
#pragma unroll
            for (int ai = 0; ai < 2; ++ai)
#pragma unroll
                for (int m = 0; m < MB_; ++m) { const int row = row0 + ai * (32 * MB_) + m * 16;
                    f32x4 a0 = acc[ai][0][m][0] + bv[0][0], a1 = acc[ai][0][m][1] + bv[0][1], b0 = acc[ai][1][m][0] + bv[1][0], b1 = acc[ai][1][m][1] + bv[1][1];
                    f32x4 r0, r1, g0, g1;
#pragma unroll
                    for (int j = 0; j < 4; ++j) {
                        const float ea0 = __expf(-a0[j]), ea1 = __expf(-a1[j]), eb0 = fminf(__expf(-b0[j]), 1e30f), eb1 = fminf(__expf(-b1[j]), 1e30f);
                        g0[j] = __builtin_amdgcn_rcpf(1.0f + eb0); g1[j] = __builtin_amdgcn_rcpf(1.0f + eb1);
                        r0[j] = (1.0f + eb0) * __builtin_amdgcn_rcpf(1.0f + ea0); r1[j] = (1.0f + eb1) * __builtin_amdgcn_rcpf(1.0f + ea1); }
                    u32x4 w; w.x = cvt_pk_bf16(r0[0], r0[1]); w.y = cvt_pk_bf16(r0[2], r0[3]); w.z = cvt_pk_bf16(r1[0], r1[1]); w.w = cvt_pk_bf16(r1[2], r1[3]);
                    *(u32x4*)(GR + (size_t)row * 1024 + cb) = w;
                    w.x = cvt_pk_bf16(g0[0], g0[1]); w.y = cvt_pk_bf16(g0[2], g0[3]); w.z = cvt_pk_bf16(g1[0], g1[1]); w.w = cvt_pk_bf16(g1[2], g1[3]);
                    *(u32x4*)(GB + (size_t)row * 1024 + cb) = w; }
        }
    }
};

struct EpiProj {
    static constexpr bool PERM = true, SPLIT2 = false, MIDHOOK = true; static constexpr int MB = 3;
    __device__ __forceinline__ void mid(acc3_t& acc, const pg8::Unit& u, int wr, int wc, int fr, int fq) const {
        asm volatile("" : "+v"(fr), "+v"(fq));
        const int row0 = u.pm * 192 + wr * 48 + fr, col0 = u.pn * 256 + wc * 32 + 8 * fq;
        const bf16_t* G = WSP(bf16_t, WS_GR);
#pragma unroll
        for (int ai = 0; ai < 2; ++ai)
#pragma unroll
            for (int m = 0; m < 3; ++m) { const size_t off = (size_t)(row0 + ai * 96 + m * 16) * 1024 + col0;
#pragma unroll
                for (int bj = 0; bj < 2; ++bj) { const u32x4 w = *(const u32x4*)(G + off + bj * 128);
                    acc[ai][bj][m][0] = acc[ai][bj][m][0] * (f32x4){bflo(w.x), bfhi(w.x), bflo(w.y), bfhi(w.y)}; acc[ai][bj][m][1] = acc[ai][bj][m][1] * (f32x4){bflo(w.z), bfhi(w.z), bflo(w.w), bfhi(w.w)}; } }
    }
    __device__ __forceinline__ void operator()(acc3_t& acc, const pg8::Unit& u, int wr, int wc, int fr, int fq) const {
        asm volatile("" : "+v"(fr), "+v"(fq));
        const int row0 = u.pm * 192 + wr * 48 + fr, col0 = u.pn * 256 + wc * 32 + 8 * fq;
        unsigned char* wsb = kws();
        const bf16_t* G = (const bf16_t*)(wsb + WS_GB); bf16_t* Mo = (bf16_t*)(wsb + WS_H);
#pragma unroll
        for (int ai = 0; ai < 2; ++ai)
#pragma unroll
            for (int m = 0; m < 3; ++m) { const size_t off = (size_t)(row0 + ai * 96 + m * 16) * 1024 + col0;
#pragma unroll
                for (int bj = 0; bj < 2; ++bj) { const u32x4 w = *(const u32x4*)(G + off + bj * 128);
                    const f32x4 v0 = acc[ai][bj][m][0] * (f32x4){bflo(w.x), bfhi(w.x), bflo(w.y), bfhi(w.y)}, v1 = acc[ai][bj][m][1] * (f32x4){bflo(w.z), bfhi(w.z), bflo(w.w), bfhi(w.w)};
                    u32x4 o; o.x = cvt_pk_bf16(v0[0], v0[1]); o.y = cvt_pk_bf16(v0[2], v0[3]); o.z = cvt_pk_bf16(v1[0], v1[1]); o.w = cvt_pk_bf16(v1[2], v1[3]);
                    *(u32x4*)(Mo + off + bj * 128) = o; }
                asm volatile("" ::: "memory"); }
    }
};

template <bool LAST> struct EpiOutT {
    static constexpr bool PERM = true, SPLIT2 = false, MIDHOOK = false; static constexpr int MB = 3;
    int layer;
    __device__ __forceinline__ void operator()(acc3_t& acc, const pg8::Unit& u, int wr, int wc, int fr, int fq) const {
        asm volatile("" : "+v"(fr), "+v"(fq));
        const int row0 = u.pm * 192 + wr * 48 + fr, col0 = u.pn * 256 + wc * 32 + 8 * fq;
        const float* modl = WSP(float, WS_MOD) + layer * 5 * 3072 + 2048 + col0;
        const float* xp = kin(I_X_PROMPT); const float* xs = kin(I_X_SAMPLE) - (size_t)NCTX * D;
        bf16_t* X1 = WSP(bf16_t, WS_X1); bf16_t* XG = WSP(bf16_t, WS_YAB);
        float* rss = WSP(float, LAST ? WS_RSS2 : WS_RSS);
        const float* gfin = kin(I_FINAL_G) + col0;
        float olds[6];
#pragma unroll
        for (int ai = 0; ai < 2; ++ai)
#pragma unroll
            for (int m = 0; m < 3; ++m) { const int row = row0 + ai * 96 + m * 16; const size_t off = (size_t)row * D + col0;
                const int g = row < NCTX ? 0 : 1 + ((row - NCTX) >> 11);
                const float* gate = modl + g * 3072; const float* xin = row < NCTX ? xp : xs;
                float ssq = 0.f;
#pragma unroll
                for (int bj = 0; bj < 2; ++bj) { const size_t o_ = off + bj * 128;
                    const f32x4 gv0 = *(const f32x4*)(gate + bj * 128), gv1 = *(const f32x4*)(gate + bj * 128 + 4);
                    f32x4 xi0, xi1;
                    if (LAST) { const u32x4 xw = *(const u32x4*)(X1 + o_); xi0 = (f32x4){bflo(xw.x), bfhi(xw.x), bflo(xw.y), bfhi(xw.y)}; xi1 = (f32x4){bflo(xw.z), bfhi(xw.z), bflo(xw.w), bfhi(xw.w)}; }
                    else { xi0 = *(const f32x4*)(xin + o_); xi1 = *(const f32x4*)(xin + o_ + 4); }
                    const f32x4 xn0 = xi0 + gv0 * acc[ai][bj][m][0], xn1 = xi1 + gv1 * acc[ai][bj][m][1];
                    ssq += ((xn0[0] * xn0[0] + xn0[1] * xn0[1]) + (xn0[2] * xn0[2] + xn0[3] * xn0[3])) + ((xn1[0] * xn1[0] + xn1[1] * xn1[1]) + (xn1[2] * xn1[2] + xn1[3] * xn1[3]));
                    const float* gmp = LAST ? gfin + bj * 128 : WSP(float, WS_GM) + g * 1024 + col0 + bj * 128;
                    const f32x4 y0 = xn0 * *(const f32x4*)gmp, y1 = xn1 * *(const f32x4*)(gmp + 4);
                    if (LAST) { acc[ai][bj][m][0] = y0; acc[ai][bj][m][1] = y1; }
                    else { u32x4 w; w.x = cvt_pk_bf16(y0[0], y0[1]); w.y = cvt_pk_bf16(y0[2], y0[3]); w.z = cvt_pk_bf16(y1[0], y1[1]); w.w = cvt_pk_bf16(y1[2], y1[3]);
                        *(u32x4*)(XG + o_) = w;
                        u32x4 xw; xw.x = cvt_pk_bf16(xn0[0], xn0[1]); xw.y = cvt_pk_bf16(xn0[2], xn0[3]); xw.z = cvt_pk_bf16(xn1[0], xn1[1]); xw.w = cvt_pk_bf16(xn1[2], xn1[3]);
                        *(u32x4*)(X1 + o_) = xw; } }
                ssq += __shfl_xor(ssq, 16); ssq += __shfl_xor(ssq, 32);
                float o = 0.f;
                if (LAST) { if (fq == 0) o = __hip_atomic_fetch_add(rss + row, ssq, __ATOMIC_RELAXED, __HIP_MEMORY_SCOPE_AGENT); }
                else { if (fq == 0) (void)__hip_atomic_fetch_add(rss + row, ssq, __ATOMIC_RELAXED, __HIP_MEMORY_SCOPE_AGENT); }
                olds[ai * 3 + m] = o;
                asm volatile("" ::: "memory"); }
        if constexpr (LAST) {
            asm volatile("" :: "v"(olds[0]), "v"(olds[1]), "v"(olds[2]), "v"(olds[3]), "v"(olds[4]), "v"(olds[5]));
            asm volatile("s_waitcnt vmcnt(0)" ::: "memory");
            __syncthreads();
            if (fresh_tid() == 0) { unsigned* cnt = WSP(unsigned, WS_CTL) + CW_ROWBLK + u.pm * 16;
                (void)__hip_atomic_fetch_add(cnt, 1u, __ATOMIC_RELAXED, __HIP_MEMORY_SCOPE_AGENT);
                unsigned sp = 0; while (__hip_atomic_load(cnt, __ATOMIC_RELAXED, __HIP_MEMORY_SCOPE_AGENT) < 4u) { __builtin_amdgcn_s_sleep(1); if (++sp > (1u << 22)) break; } }
            __syncthreads();
            float* out = kout();
            float sq[6];
#pragma unroll
            for (int k = 0; k < 6; ++k) sq[k] = __hip_atomic_load(rss + row0 + (k / 3) * 96 + (k % 3) * 16, __ATOMIC_RELAXED, __HIP_MEMORY_SCOPE_AGENT);
#pragma unroll
            for (int ai = 0; ai < 2; ++ai)
#pragma unroll
                for (int m = 0; m < 3; ++m) { const int row = row0 + ai * 96 + m * 16; float* yr = out + (size_t)row * D + col0;
                    const float rstd = rsqrtf(sq[ai * 3 + m] * (1.f / D) + EPS);
#pragma unroll
                    for (int bj = 0; bj < 2; ++bj) { *(f32x4*)(yr + bj * 128) = acc[ai][bj][m][0] * rstd; *(f32x4*)(yr + bj * 128 + 4) = acc[ai][bj][m][1] * rstd; } }
        }
    }
};

#define XB_TMO      128
#define XB_XCNT(j)  (256  + 64 * (j))
#define XB_XSUB(j)  (1280 + 64 * (j))
#define XB_XGEN(j)  (2304 + 64 * (j))
#define XB_TOP      3328
#define XB_TOPGEN   3392
#define XCD_BAR_WORDS 3456
#define XB_SPIN_CAP (1u << 18)
__device__ __forceinline__ unsigned xb_ld(unsigned* p)              { return __hip_atomic_load(p, __ATOMIC_RELAXED, __HIP_MEMORY_SCOPE_AGENT); }
__device__ __forceinline__ unsigned xb_add(unsigned* p, unsigned v) { return __hip_atomic_fetch_add(p, v, __ATOMIC_RELAXED, __HIP_MEMORY_SCOPE_AGENT); }
__device__ __forceinline__ unsigned xb_xcc_id() { return (unsigned)__builtin_amdgcn_s_getreg((3 << 11) | 20) & 0xFu; }
#define XB_SPIN(cond, bar) do { unsigned _sp = 0; while (cond) { __builtin_amdgcn_s_sleep(1); \
    if ((++_sp & 255u) == 0u) { if (xb_ld(&(bar)[XB_TMO])) break; if (_sp > XB_SPIN_CAP) { atomicAdd(&(bar)[XB_TMO], 1u); break; } } } } while (0)
struct XcdBarrier { unsigned* bar; unsigned x; volatile LAS unsigned* st; };
__device__ __forceinline__ XcdBarrier xcd_barrier_post(unsigned* bar, volatile LAS unsigned* st) {
    XcdBarrier b; b.bar = bar; b.x = xb_xcc_id(); b.st = st;
    if (threadIdx.x == 0) (void)xb_add(&bar[XB_XCNT(b.x)], 1u);
    return b;
}
__device__ __forceinline__ void xcd_barrier_complete(unsigned* bar, unsigned x, unsigned& nloc, unsigned& nx) {
    const unsigned G = gridDim.x * gridDim.y * gridDim.z;
    unsigned sum, cnt, mine, sp = 0u;
    for (;;) {
        sum = 0u; cnt = 0u; mine = 0u;
#pragma unroll
        for (unsigned j = 0; j < 16; ++j) { const unsigned c = xb_ld(&bar[XB_XCNT(j)]); sum += c; cnt += (c > 0u) ? 1u : 0u; mine = (j == x) ? c : mine; }
        if (sum == G) break;
        __builtin_amdgcn_s_sleep(1);
        if ((++sp & 255u) == 0u) { if (xb_ld(&bar[XB_TMO])) break; if (sp > XB_SPIN_CAP) { atomicAdd(&bar[XB_TMO], 1u); break; } }
    }
    nloc = mine > 0u ? mine : 1u; nx = cnt > 0u ? cnt : 1u;
}
__device__ __forceinline__ void xcd_barrier(const XcdBarrier& b) {
    asm volatile("s_waitcnt vmcnt(0)" ::: "memory");
    __syncthreads();
    if (fresh_tid() == 0) {
        unsigned* bar = b.bar;
        __builtin_amdgcn_s_waitcnt(0);
        unsigned nloc = b.st[0], nx = b.st[1];
        if (nloc == 0u) { xcd_barrier_complete(bar, b.x, nloc, nx); b.st[0] = nloc; b.st[1] = nx; }
        const unsigned old = xb_add(&bar[XB_XSUB(b.x)], 1u);
        const unsigned gen = old / nloc;
        if (old + 1u == (gen + 1u) * nloc) {
            __builtin_amdgcn_fence(__ATOMIC_RELEASE, "agent");
            asm volatile("s_waitcnt vmcnt(0)" ::: "memory");
            const unsigned og = xb_add(&bar[XB_TOP], 1u);
            const unsigned tg = og / nx;
            if (og + 1u == (tg + 1u) * nx) xb_add(&bar[XB_TOPGEN], 1u);
            else XB_SPIN(xb_ld(&bar[XB_TOPGEN]) == tg, bar);
            __builtin_amdgcn_fence(__ATOMIC_ACQUIRE, "agent");
            xb_add(&bar[XB_XGEN(b.x)], 1u);
            asm volatile("s_waitcnt vmcnt(0)" ::: "memory");
        } else {
            XB_SPIN(xb_ld(&bar[XB_XGEN(b.x)]) == gen, bar);
            __builtin_amdgcn_fence(__ATOMIC_ACQUIRE, "agent");
            asm volatile("s_waitcnt vmcnt(0)" ::: "memory");
        }
    }
    __syncthreads();
}

struct Frame {
    LAS unsigned char* lds;
    int tid, lane, wave, G, bx;
};


__device__ __forceinline__ int in_srccol(int n) {
    const int tile = n >> 8, r = n & 255;
    if (tile < 8 || tile == 12 || tile == 13) return n;
    if (tile < 12) { const int i = tile - 8; return (r < 128 ? 2048 : 2560) + 128 * i + (r & 127); }
    const int i = tile - 14; return (r < 128 ? 3584 : 4608) + 128 * i + (r & 127);
}

__device__ __forceinline__ void transpose_item(const float* W, int ldw, int srccol0, int k0, bf16_t* WT, int dstrow0, int dstk0, LAS float* scr, int lane) {
    float tv[32];
#pragma unroll
    for (int i = 0; i < 32; ++i) { const int kk = 2 * i + (lane >> 5); tv[i] = W[(size_t)(k0 + kk) * ldw + srccol0 + (lane & 31)]; }
#pragma unroll
    for (int i = 0; i < 32; ++i) { const int kk = 2 * i + (lane >> 5); scr[kk * 33 + (lane & 31)] = tv[i]; }
    LDS_WAIT(); asm volatile("" ::: "memory");
    const int c = lane & 7;
#pragma unroll
    for (int j = 0; j < 4; ++j) { const int n = (lane >> 3) + 8 * j; const LAS float* s = scr + (8 * c) * 33 + n;
        u32x4 o; o.x = pk2(s[0 * 33], s[1 * 33]); o.y = pk2(s[2 * 33], s[3 * 33]); o.z = pk2(s[4 * 33], s[5 * 33]); o.w = pk2(s[6 * 33], s[7 * 33]);
        *(GAS u32x4*)(WT + (size_t)(dstrow0 + n) * 1024 + dstk0 + 8 * c) = o; }
    LDS_WAIT(); asm volatile("" ::: "memory");
}

__device__ __forceinline__ void mod_task(Frame& F, int t) {
    const int l = t / 48, j0 = (t % 48) * 64;
    const float* c_ctx = kin(I_C_CTX); const float* cvec = kin(I_C); const float* w_ada = kin(I_W_ADA); const float* b_ada = kin(I_B_ADA); float* MOD = WSP(float, WS_MOD);
    LAS float* sv = (LAS float*)F.lds;
    LAS float* part = (LAS float*)(F.lds + 20480);
    for (int i = F.tid; i < 5 * 1024; i += 512) { const int g = i >> 10, k = i & 1023; const float c = (g == 0) ? c_ctx[k] : cvec[(g - 1) * 1024 + k]; sv[i] = silu_f(c); }
    __syncthreads();
    const float* W = w_ada + (size_t)l * 1024 * 3072 + (size_t)(128 * F.wave) * 3072 + j0 + F.lane;
    float a0 = 0.f, a1 = 0.f, a2 = 0.f, a3 = 0.f, a4 = 0.f;
#pragma unroll 32
    for (int kk = 0; kk < 128; ++kk) { const float wv = W[(size_t)kk * 3072]; const int k = 128 * F.wave + kk;
        a0 += sv[k] * wv; a1 += sv[1024 + k] * wv; a2 += sv[2048 + k] * wv; a3 += sv[3072 + k] * wv; a4 += sv[4096 + k] * wv; }
    part[(F.wave * 5 + 0) * 64 + F.lane] = a0; part[(F.wave * 5 + 1) * 64 + F.lane] = a1; part[(F.wave * 5 + 2) * 64 + F.lane] = a2;
    part[(F.wave * 5 + 3) * 64 + F.lane] = a3; part[(F.wave * 5 + 4) * 64 + F.lane] = a4;
    __syncthreads();
    if (F.tid < 320) { const int g = F.tid >> 6, ln = F.tid & 63; float s = 0.f;
#pragma unroll
        for (int w = 0; w < 8; ++w) s += part[(w * 5 + g) * 64 + ln];
        MOD[(l * 5 + g) * 3072 + j0 + ln] = s + b_ada[l * 3072 + j0 + ln]; }
    __syncthreads();
}

__device__ __forceinline__ void wt_items(Frame& F, int l, int w0, int nw);
__device__ __forceinline__ void p0_prologue(Frame& F) {
    if (F.bx < 96) mod_task(F, F.bx);
    const int gw = F.bx * 8 + F.wave, NGW = F.G * 8;
    const int gt = F.bx * 512 + F.tid, NGT = F.G * 512;
    { float* BIASP = WSP(float, WS_BIASP); const float* b_in = kin(I_B_IN);
      for (int i = gt; i < DEPTH * DIN; i += NGT) { const int l = i / DIN, n = i % DIN; BIASP[i] = b_in[l * DIN + in_srccol(n)]; } }
    const float* cache_k = kin(I_CACHE_K); const float* cache_v = kin(I_CACHE_V); bf16_t* CK = WSP(bf16_t, WS_CK); bf16_t* CV = WSP(bf16_t, WS_CV);
    for (int i0 = gt; i0 < 2 * 131072; i0 += 2 * NGT) { f32x4 a[2], b[2];
#pragma unroll
        for (int k = 0; k < 2; ++k) { const int i = i0 + k * NGT; if (i < 2 * 131072) { const int which = i >> 17, e = (i & 131071) * 8; const float* src = (which ? cache_v : cache_k) + e; a[k] = *(const f32x4*)src; b[k] = *(const f32x4*)(src + 4); } }
#pragma unroll
        for (int k = 0; k < 2; ++k) { const int i = i0 + k * NGT; if (i < 2 * 131072) { const int which = i >> 17, e = (i & 131071) * 8; bf16_t* dst = (which ? CV : CK) + e;
            u32x4 w; w.x = pk2(a[k][0], a[k][1]); w.y = pk2(a[k][2], a[k][3]); w.z = pk2(b[k][0], b[k][1]); w.w = pk2(b[k][2], b[k][3]); *(u32x4*)dst = w; } } }
    wt_items(F, 0, gw, NGW);
    { const int nidle = F.G - (M - 46 * 256) / 128 * (DIN / 256); if (nidle <= 0) wt_items(F, 1, gw, NGW); }
}

__device__ __forceinline__ void wt_items(Frame& F, int l, int w0, int nw) {
    LAS float* scr = (LAS float*)(F.lds + F.wave * 16384);
    const float* w_in = kin(I_W_IN); const float* w_proj_a = kin(I_W_PROJ_A); const float* w_proj_b = kin(I_W_PROJ_B); const float* w_out = kin(I_W_OUT);
    bf16_t* WTIN = WSP(bf16_t, WS_WTIN); bf16_t* WTPROJ = WSP(bf16_t, WS_WTPROJ); bf16_t* WTOUT = WSP(bf16_t, WS_WTOUT);
    constexpr int I_IN = 16 * 176, I_P = 8 * 32, I_O = 16 * 32, I_L = I_IN + 2 * I_P + I_O;
    for (int it = w0; it < I_L; it += nw) {
        int r = it;
        if (r < I_IN) { const int kb = r / 176, nb = r % 176; transpose_item(w_in + (size_t)l * D * DIN, DIN, in_srccol(32 * nb), 64 * kb, WTIN + (size_t)l * DIN * D, 32 * nb, 64 * kb, scr, F.lane); continue; } r -= I_IN;
        if (r < I_P) { const int kb = r / 32, nb = r % 32; transpose_item(w_proj_a + (size_t)l * 512 * D, D, 32 * nb, 64 * kb, WTPROJ + (size_t)l * D * D, 32 * nb, 64 * kb, scr, F.lane); continue; } r -= I_P;
        if (r < I_P) { const int kb = r / 32, nb = r % 32; transpose_item(w_proj_b + (size_t)l * 512 * D, D, 32 * nb, 64 * kb, WTPROJ + (size_t)l * D * D, 32 * nb, 512 + 64 * kb, scr, F.lane); continue; } r -= I_P;
        { const int kb = r / 32, nb = r % 32; transpose_item(w_out + (size_t)l * D * D, D, 32 * nb, 64 * kb, WTOUT + (size_t)l * D * D, 32 * nb, 64 * kb, scr, F.lane); }
    }
}

__device__ __forceinline__ void norm_phase(Frame& F, int layer) {
    const int gw = F.bx * 8 + F.wave, NGW = F.G * 8;
    const float* xa = layer == 0 ? kin(I_X_PROMPT) : kout(); const float* xb = layer == 0 ? kin(I_X_SAMPLE) : kout() + (size_t)NCTX * D;
    const float* MOD = WSP(float, WS_MOD); const float* rms_g = kin(I_RMS_G) + layer * D; bf16_t* H = WSP(bf16_t, WS_H);
    for (int rb = gw; rb < M; rb += 3 * NGW) {
        f32x4 v[3][4];
#pragma unroll
        for (int k = 0; k < 3; ++k) { const int r = rb + k * NGW; if (r < M) {
            const float* xrow = r < NCTX ? xa + (size_t)r * D : xb + (size_t)(r - NCTX) * D; const f32x4* xr = (const f32x4*)xrow + F.lane;
#pragma unroll
            for (int j = 0; j < 4; ++j) v[k][j] = xr[64 * j]; } }
#pragma unroll
        for (int k = 0; k < 3; ++k) { const int r = rb + k * NGW; if (r < M) {
            const int g = r < NCTX ? 0 : 1 + ((r - NCTX) >> 11);
            const float* mod = MOD + (layer * 5 + g) * 3072;
            float s = 0.f;
#pragma unroll
            for (int j = 0; j < 4; ++j) s += (v[k][j][0] * v[k][j][0] + v[k][j][1] * v[k][j][1]) + (v[k][j][2] * v[k][j][2] + v[k][j][3] * v[k][j][3]);
            const float rstd = rsqrtf(wave_sum(s) * (1.f / D) + EPS);
            unsigned long long* o8 = (unsigned long long*)(H + (size_t)r * D) + F.lane;
#pragma unroll
            for (int j = 0; j < 4; ++j) { const int c = 4 * F.lane + 256 * j;
                const f32x4 gg = *(const f32x4*)(rms_g + c), sh = *(const f32x4*)(mod + c), sc = *(const f32x4*)(mod + 1024 + c);
                const f32x4 y = v[k][j] * rstd * gg * (sc + 1.0f) + sh;
                o8[64 * j] = (unsigned long long)cvt_pk_bf16(y[0], y[1]) | ((unsigned long long)cvt_pk_bf16(y[2], y[3]) << 32); } } }
    }
}

struct AttnPre { u32x4 qrow[4], pa0, pc0, pa1, kreg, vreg, kreg2, vreg2; float bvv[8]; };
__device__ __forceinline__ void attn_prefetch(Frame& F, int layer, int task, const bool ctx, AttnPre& P);
__device__ __forceinline__ void conv_task(Frame& F, int layer, int tile, AttnPre& pre, int pre_task) {
    const int t0 = tile * 32;
    int s0, s1; if (t0 < NCTX) { s0 = t0 & ~255; s1 = s0 + 256; } else { s0 = NCTX + ((t0 - NCTX) & ~2047); s1 = s0 + 2048; }
    const bf16_t* Ub = WSP(bf16_t, WS_U); const bf16_t* SZB = WSP(bf16_t, WS_SZB); bf16_t* YAB = WSP(bf16_t, WS_YAB);
    const float* dw_w = kin(I_DW_W); const float* dw_b = kin(I_DW_B); const float* ln_g = kin(I_LN_G) + layer * 512; const float* ln_b = kin(I_LN_B) + layer * 512;
    LAS unsigned* Ul = (LAS unsigned*)F.lds;
    LAS float* Cl = (LAS float*)(F.lds + 62 * 1024);
    u32x4 xs[8];
#pragma unroll
    for (int k = 0; k < 8; ++k) { const int i = F.tid + 512 * k; const int lr = i >> 6, ch = i & 63; const int t = t0 - 15 + lr; xs[k] = (u32x4){0u, 0u, 0u, 0u};
        if (i < 62 * 64 && t >= s0 && t < s1) xs[k] = *(const u32x4*)(Ub + (size_t)t * 512 + ch * 8); }
    const int cp = F.tid & 255, th = F.tid >> 8;
    float w0[31], w1[31];
#pragma unroll
    for (int j = 0; j < 31; ++j) { const f32x2 w = *(const f32x2*)(dw_w + (size_t)(layer * 31 + j) * 512 + 2 * cp); w0[j] = w[0]; w1[j] = w[1]; }
    const f32x2 bb = *(const f32x2*)(dw_b + layer * 512 + 2 * cp);
    u32x2 zq[4][2];
#pragma unroll
    for (int k = 0; k < 4; ++k) { const int t = t0 + F.wave * 4 + k; zq[k][0] = *(const u32x2*)(SZB + (size_t)t * 512 + 4 * F.lane); zq[k][1] = *(const u32x2*)(SZB + (size_t)t * 512 + 256 + 4 * F.lane); }
#pragma unroll
    for (int k = 0; k < 8; ++k) { const int i = F.tid + 512 * k; if (i < 62 * 64) *(LAS u32x4*)(Ul + (i >> 6) * 256 + (i & 63) * 4) = xs[k]; }
    __syncthreads();
    {
        for (int blk = 0; blk < 4; ++blk) { const int tt0 = th * 16 + blk * 4;
            float a0[4], a1[4];
#pragma unroll
            for (int o = 0; o < 4; ++o) { a0[o] = bb[0]; a1[o] = bb[1]; }
#pragma unroll
            for (int i = 0; i < 34; ++i) { const unsigned x = Ul[(tt0 + i) * 256 + cp]; const float x0 = bflo(x), x1 = bfhi(x);
#pragma unroll
                for (int o = 0; o < 4; ++o) { const int j = i - o; if (j >= 0 && j < 31) { a0[o] += w0[j] * x0; a1[o] += w1[j] * x1; } } }
#pragma unroll
            for (int o = 0; o < 4; ++o) *(LAS f32x2*)(Cl + (tt0 + o) * 512 + 2 * cp) = (f32x2){a0[o], a1[o]};
        }
    }
    __syncthreads();
    const f32x4 g0 = *(const f32x4*)(ln_g + 4 * F.lane), g1 = *(const f32x4*)(ln_g + 256 + 4 * F.lane);
    const f32x4 b0 = *(const f32x4*)(ln_b + 4 * F.lane), b1 = *(const f32x4*)(ln_b + 256 + 4 * F.lane);
    asm volatile("" ::: "memory");
    if (pre_task >= 0) attn_prefetch(F, layer, pre_task, false, pre);
    asm volatile("" ::: "memory");
#pragma unroll
    for (int k = 0; k < 4; ++k) { const int tt = F.wave * 4 + k, t = t0 + tt;
        f32x4 v0 = *(LAS f32x4*)(Cl + tt * 512 + 4 * F.lane), v1 = *(LAS f32x4*)(Cl + tt * 512 + 256 + 4 * F.lane);
        const float mean = wave_sum((v0[0] + v0[1]) + (v0[2] + v0[3]) + (v1[0] + v1[1]) + (v1[2] + v1[3])) * (1.f / 512.f);
        v0 = v0 - mean; v1 = v1 - mean;
        const float var = wave_sum((v0[0] * v0[0] + v0[1] * v0[1]) + (v0[2] * v0[2] + v0[3] * v0[3]) + (v1[0] * v1[0] + v1[1] * v1[1]) + (v1[2] * v1[2] + v1[3] * v1[3])) * (1.f / 512.f);
        const float rstd = rsqrtf(var + EPS);
        f32x4 y0 = v0 * rstd * g0 + b0, y1 = v1 * rstd * g1 + b1;
        const u32x2 z0 = zq[k][0], z1 = zq[k][1];
        const f32x4 zz0 = (f32x4){bflo(z0.x), bfhi(z0.x), bflo(z0.y), bfhi(z0.y)}, zz1 = (f32x4){bflo(z1.x), bfhi(z1.x), bflo(z1.y), bfhi(z1.y)};
#pragma unroll
        for (int j = 0; j < 4; ++j) { y0[j] = silu_f(y0[j]) * zz0[j]; y1[j] = silu_f(y1[j]) * zz1[j]; }
        u32x2 o0, o1; o0.x = cvt_pk_bf16(y0[0], y0[1]); o0.y = cvt_pk_bf16(y0[2], y0[3]); o1.x = cvt_pk_bf16(y1[0], y1[1]); o1.y = cvt_pk_bf16(y1[2], y1[3]);
        *(u32x2*)(YAB + (size_t)t * 1024 + 512 + 4 * F.lane) = o0; *(u32x2*)(YAB + (size_t)t * 1024 + 768 + 4 * F.lane) = o1;
    }
    __syncthreads();
}

typedef float f32x16 __attribute__((ext_vector_type(16)));
typedef short s16x4 __attribute__((ext_vector_type(4)));
typedef __bf16 bf16x2_t __attribute__((ext_vector_type(2)));
__device__ __forceinline__ unsigned cvtpk_s(float lo, float hi) { f32x2 v = {lo, hi}; bf16x2_t b = __builtin_convertvector(v, bf16x2_t); return __builtin_bit_cast(unsigned, b); }
__device__ __forceinline__ s16x4 vtr(const LAS char* p) { return __builtin_bit_cast(s16x4, __builtin_amdgcn_ds_read_tr16_b64_v4i16((LAS s16x4*)p)); }
#define MFMA32(a, b, c) __builtin_amdgcn_mfma_f32_32x32x16_bf16((a), (b), (c), 0, 0, 0)
constexpr float LOG2E = 1.4426950408889634f;
constexpr float ATT_QSCALE = 0.125f * LOG2E;
constexpr int AT_SLOTB = 8192, AT_K = 0, AT_V = 3 * AT_SLOTB, AT_TBL = 6 * AT_SLOTB;
constexpr int AT_VSTRIDE = 68, AT_ROWF = 16 * AT_VSTRIDE + 52, AT_INF = AT_TBL + 15 * AT_ROWF * 4, AT_ZERO = AT_INF + 512, AT_END = AT_ZERO + 512;
static_assert(AT_END <= RING_BYTES, "attention LDS");
constexpr float ATT_THR = 8.0f;

#define ATT_DECODE() \
    int b, h, R0, r = 0, n_win = 0, lo = 0, qc = 0, r0 = 0; \
    if (!ctx) { const int R = 4 * (task & 7); h = (task >> 3) & 7; b = task >> 6; r = R + (wid >> 1); const int HALF = wid & 1; \
        R0 = NCTX + b * 2048 + r * 64 + HALF * 32; qc = HALF * 32 + r32; r0 = min(max(r - 4, 0), 24); \
        lo = min(max(R - 4, 0), 24); n_win = min(max(R - 1, 0), 24) + 8 - lo; \
    } else { h = task & 7; b = task >> 3; R0 = b * 256 + wid * 32; } \
    const int NT = n_win + 4; (void)qc; (void)r0; (void)r; (void)NT; \
    const unsigned ksoff = (unsigned)(lane * 512 + wid * 8), vsoff = (unsigned)((16 * (wid & 3) + (lane >> 2)) * 512 + (wid >> 2) * 32 + (lane & 3) * 8);
#define ATT_SRC(t, KP, VP) do { if ((t) < n_win) { const size_t o_ = (size_t)(NCTX + b * 2048 + (lo + (t)) * 64) * 512 + h * 64; KP = (const bf16_t*)(wsb + WS_K) + o_; VP = (const bf16_t*)(wsb + WS_V) + o_; } \
        else if (ctx) { const size_t o_ = (size_t)(b * 256 + ((t) - n_win) * 64) * 512 + h * 64; KP = (const bf16_t*)(wsb + WS_K) + o_; VP = (const bf16_t*)(wsb + WS_V) + o_; } \
        else { const size_t o_ = ((size_t)((b * 2 + layer) * 256 + ((t) - n_win) * 64)) * 512 + h * 64; KP = (const bf16_t*)(wsb + WS_CK) + o_; VP = (const bf16_t*)(wsb + WS_CV) + o_; } } while (0)
__device__ __forceinline__ void attn_prefetch(Frame& F, int layer, int task, const bool ctx, AttnPre& P) {
    const int tid = fresh_tid(), lane = tid & 63, r32 = lane & 31, wid = __builtin_amdgcn_readfirstlane(tid >> 6);
    unsigned char* wsb = kws();
    ATT_DECODE()
    { const bf16_t* qp = (const bf16_t*)(wsb + WS_Q) + (size_t)(R0 + (lane >> 3)) * 512 + h * 64 + (lane & 7) * 8;
#pragma unroll
      for (int i = 0; i < 4; ++i) P.qrow[i] = *(const u32x4*)(qp + (size_t)i * 8 * 512); }
    { const bf16_t *k0, *v0, *k1, *v1, *k2, *v2, *k3, *v3; ATT_SRC(0, k0, v0); ATT_SRC(1, k1, v1); ATT_SRC(2, k2, v2); ATT_SRC(3, k3, v3); (void)v3;
      P.pa0 = *(const u32x4*)(k0 + ksoff); P.pc0 = *(const u32x4*)(v0 + vsoff); P.pa1 = *(const u32x4*)(k1 + ksoff);
      P.kreg = *(const u32x4*)(k2 + ksoff); P.vreg = *(const u32x4*)(v1 + vsoff); P.kreg2 = *(const u32x4*)(k3 + ksoff); P.vreg2 = *(const u32x4*)(v2 + vsoff); }
    if (!ctx) { const float* rb = kin(I_REL_BIAS) + (size_t)(layer * 8 + h) * 465;
#pragma unroll
        for (int k = 0; k < 8; ++k) { const int i = tid + 512 * k, dr = i >> 8, v = (i >> 4) & 15, j = i & 15; P.bvv[k] = (i < 3840) ? rb[dr * 31 + v + j] : 0.f; } }
}

__device__ __forceinline__ void attn_wg(Frame& F, int layer, int task, const bool ctx, AttnPre& P, int next_ctx) {
    const int tid = fresh_tid(), lane = tid & 63, r32 = lane & 31, hi = lane >> 5, wid = __builtin_amdgcn_readfirstlane(tid >> 6);
    LAS char* L = (LAS char*)F.lds;
    unsigned char* wsb = kws();
    ATT_DECODE()
    const int kdst = AT_K + wid * 1024 + lane * 16, vdst = AT_V + wid * 1024 + lane * 16;
    u32x4 kreg = P.kreg, vreg = P.vreg, kreg2 = P.kreg2, vreg2 = P.vreg2;
    bf16x8 qr[4];
    { LAS char* stg = L + AT_TBL + wid * 4608; LAS char* srow = stg + (lane >> 3) * 144 + (lane & 7) * 16;
#pragma unroll
      for (int i = 0; i < 4; ++i) *(LAS u32x4*)(srow + i * 8 * 144) = P.qrow[i];
      asm volatile("s_waitcnt lgkmcnt(0)" ::: "memory");
#pragma unroll
      for (int s_ = 0; s_ < 4; ++s_) qr[s_] = *(const LAS bf16x8*)(stg + r32 * 144 + hi * 16 + s_ * 32);
      asm volatile("s_waitcnt lgkmcnt(0)" ::: "memory"); }
    { unsigned zz = 0u; asm volatile("" : "+v"(zz));
      if (tid < 32) *(LAS u32x4*)(L + AT_ZERO + 16 * tid) = (u32x4){zz, zz, zz, zz}; }
    if (!ctx) { unsigned ninf = 0xff800000u; asm volatile("" : "+v"(ninf));
        for (int i = lane; i < 4608 / 16; i += 64) *(LAS u32x4*)(L + AT_TBL + wid * 4608 + 16 * i) = (u32x4){ninf, ninf, ninf, ninf};
        for (int i = 8 * 4608 / 16 + tid; i < (AT_ZERO - AT_TBL) / 16; i += 512) *(LAS u32x4*)(L + AT_TBL + 16 * i) = (u32x4){ninf, ninf, ninf, ninf}; }
    *(LAS u32x4*)(L + kdst) = P.pa0; *(LAS u32x4*)(L + vdst) = P.pc0; *(LAS u32x4*)(L + AT_SLOTB + kdst) = P.pa1;
    if (!ctx) {
        asm volatile("s_waitcnt lgkmcnt(0)\n\ts_barrier" ::: "memory");
#pragma unroll
        for (int k = 0; k < 8; ++k) { const int i = tid + 512 * k, dr = i >> 8, v = (i >> 4) & 15, j = i & 15; if (i < 3840) *(LAS float*)(L + AT_TBL + (dr * AT_ROWF + v * AT_VSTRIDE + 48 + j) * 4) = P.bvv[k] * LOG2E; }
    }
    const int HALFW = ctx ? 0 : (wid & 1);
    const LAS char* kpA = L + AT_K + hi * 1024 + (32 * HALFW + r32) * 16;
    const LAS char* kpB = L + AT_K + hi * 1024 + (32 * (1 - HALFW) + ((r32 + 24 * HALFW) & 31)) * 16;
    const LAS char* vp0 = L + AT_V + ((lane >> 4) & 1) * 32 + (lane & 3) * 8 + (4 * hi + ((lane & 15) >> 2)) * 64;
    const int H2 = HALFW * 2048, O2 = (1 - HALFW) * 2048, rot = 3 * HALFW;
    const int vol0 = H2, voh0 = H2 + 512, vol1 = H2 + 1024, voh1 = H2 + 1536;
    const int vol2 = O2 + ((0 + rot) & 3) * 512, voh2 = O2 + ((1 + rot) & 3) * 512, vol3 = O2 + ((2 + rot) & 3) * 512, voh3 = O2 + ((3 + rot) & 3) * 512;
    const int vsh = (qc < 8 ? 8 - qc : (qc > 56 ? 56 - qc : 0)) + 7;
    const int tlane = AT_TBL + (67 * vsh + 4 * hi - qc + 63) * 4;
    const int offA = 128 * HALFW, offB = HALFW ? 96 : 128;
    const int NWP = n_win + ((n_win > 0 && ((n_win - 1) & 1)) ? 1 : 0), NTV = NWP + 4;
#define VT(t) ((t) < n_win ? (t) : ((t) < NWP ? n_win - 1 : (t) - (NWP - n_win)))
    float mhat = -INFINITY, l_reg = 0.f, fres = 1.f; bool resc = false;
    f32x16 o0, o1;
#pragma unroll
    for (int i = 0; i < 16; ++i) { o0[i] = 0.f; o1[i] = 0.f; }
    f32x16 pA0, pA1, pB0, pB1; bf16x8 kf[8]; s16x4 vlo[8], vhi[8]; u32x4 pw0, pw1, pw2, pw3;
#pragma unroll
    for (int i = 0; i < 16; ++i) { pA1[i] = 0.f; pB1[i] = 0.f; }
    int sl_prev = 0, sl_cur = 0, sl_next = AT_SLOTB;
#define SBAR() __builtin_amdgcn_sched_barrier(0)
#define PIN(x) asm volatile("" : "+v"(x))
#define WBAR() asm volatile("s_waitcnt lgkmcnt(0)\n\ts_barrier" ::: "memory")
#define ROT() do { sl_prev = sl_cur; sl_cur = sl_next; sl_next = (sl_next == 2 * AT_SLOTB) ? 0 : sl_next + AT_SLOTB; } while (0)
#define MX3(a, b, c) __builtin_fmaxf(__builtin_fmaxf((a), (b)), (c))
#define KLD2(so, j) do { kf[2 * (j)] = *(const LAS bf16x8*)(kpA + (so) + (j) * 2048); kf[2 * (j) + 1] = *(const LAS bf16x8*)(kpB + (so) + (j) * 2048); } while (0)
#define CADDR(tt) (((tt) < n_win && (unsigned)(lo + (tt) - r0) < 8u) ? tlane + (lo + (tt) - r + 7) * (AT_ROWF * 4) : AT_INF)
#define CLDA(X0, q) do { const int ro_ = (((2 * (q)) & 3) + 8 * ((2 * (q)) >> 2)) * 4; X0[2 * (q)] = *(const LAS float*)(L + cad + offA + ro_); X0[2 * (q) + 1] = *(const LAS float*)(L + cad + offA + ro_ + 4); } while (0)
#define CLDB(X1, q) do { X1[2 * (q)] = *(const LAS float*)(L + cad + offB + 8 * (q)); X1[2 * (q) + 1] = *(const LAS float*)(L + cad + offB + 8 * (q) + 4); } while (0)
#define DEC_TAIL() do { { auto rr_ = __builtin_amdgcn_permlane32_swap(__float_as_uint(rm_), __float_as_uint(rm_), false, false); rm_ = __builtin_fmaxf(__uint_as_float(rr_[0]), __uint_as_float(rr_[1])); } \
        resc = false; \
        if (__builtin_amdgcn_ballot_w64(rm_ > mhat + ATT_THR) != 0ull) { const float mn_ = __builtin_fmaxf(mhat, rm_); fres = __builtin_amdgcn_exp2f(mhat - mn_); l_reg *= fres; mhat = mn_; resc = true; } \
        nmh = (mhat == -INFINITY) ? 0.f : -mhat; } while (0)
#define DECIDE_D(C0, C1) do { float a_ = MX3(C0[0], C0[1], C1[0]), b_ = MX3(C0[2], C0[3], C1[1]); a_ = MX3(a_, C1[2], C1[3]); \
        _Pragma("unroll") for (int r_ = 4; r_ < 16; r_ += 4) { a_ = MX3(a_, C0[r_], C0[r_ + 1]); b_ = MX3(b_, C0[r_ + 2], C0[r_ + 3]); a_ = MX3(a_, C1[r_], C1[r_ + 1]); b_ = MX3(b_, C1[r_ + 2], C1[r_ + 3]); } \
        float rm_ = __builtin_fmaxf(a_, b_); DEC_TAIL(); } while (0)
#define DECIDE_W(C0, C1) do { float a_ = MX3(C0[0], C0[1], C1[0]), b_ = MX3(C0[2], C0[3], C1[1]); a_ = MX3(a_, C1[2], C1[3]); \
        _Pragma("unroll") for (int r_ = 4; r_ < 16; r_ += 4) { a_ = MX3(a_, C0[r_], C0[r_ + 1]); b_ = MX3(b_, C0[r_ + 2], C0[r_ + 3]); } \
        float rm_ = __builtin_fmaxf(a_, b_); DEC_TAIL(); } while (0)
#define RESC() do { if (resc) { _Pragma("unroll") for (int r_ = 0; r_ < 16; ++r_) { o0[r_] *= fres; o1[r_] *= fres; } } } while (0)
#define EX(v) __builtin_amdgcn_exp2f((v) + nmh)
#define PKW(P, i) cvtpk_s(P[i], P[(i) + 1])
#define PAF(k) __builtin_bit_cast(bf16x8, pw##k)
#define VFR(i) (bf16x8){vlo[i][0], vlo[i][1], vlo[i][2], vlo[i][3], vhi[i][0], vhi[i][1], vhi[i][2], vhi[i][3]}
#define VRD(i, s) do { vlo[i] = vtr(vp_ + (((i) >> 2) * 4096 + vol##s)); vhi[i] = vtr(vp_ + (((i) >> 2) * 4096 + voh##s)); } while (0)
#define GAPA(MF, a0, a1, a2, a3, W0, W1, PW) do { MF; sacc += a0; sacc += a1; sacc += a2; sacc += a3; PIN(sacc); W0; W1; PIN(PW); SBAR(); } while (0)
#define GAPM(MF) do { MF; SBAR(); } while (0)
#define GAPB(MF, X, i) do { MF; X[i] = EX(X[i]); X[(i) + 1] = EX(X[(i) + 1]); X[(i) + 2] = EX(X[(i) + 2]); X[(i) + 3] = EX(X[(i) + 3]); PIN(X); SBAR(); } while (0)
#define EXG(X, i) do { X[i] = EX(X[i]); X[(i) + 1] = EX(X[(i) + 1]); X[(i) + 2] = EX(X[(i) + 2]); X[(i) + 3] = EX(X[(i) + 3]); PIN(X); SBAR(); } while (0)
#define STAGE(t, KR, VR) do { *(LAS u32x4*)(L + sl_prev + kdst) = KR; *(LAS u32x4*)(L + sl_next + vdst) = VR; \
        { const int tk_ = VT(min((t) + 4, NTV - 1)), tv_ = VT(min((t) + 3, NTV - 1)); const bf16_t *kp_, *vq_, *kq_, *vv_; ATT_SRC(tk_, kp_, vq_); ATT_SRC(tv_, kq_, vv_); (void)vq_; (void)kq_; \
          KR = *(const u32x4*)(kp_ + ksoff); VR = *(const u32x4*)(vv_ + vsoff); } SBAR(); } while (0)
#define QK0(C0, CZ) C0 = (CZ) ? MFMA32(kf[0], qr[0], zero16) : MFMA32(kf[0], qr[0], C0)
#define QK1(C1, CZ) C1 = (CZ) ? MFMA32(kf[1], qr[0], zero16) : MFMA32(kf[1], qr[0], C1)
#define PHASEA_PW(C0, C1, P0, P1, CZ) do { \
    VRD(0, 0); SBAR(); float sacc = P0[0] + P0[1]; \
                       GAPA(QK0(C0, CZ), P0[2], P0[3], P0[4], P0[5],     pw0[0] = PKW(P0, 0),  pw0[1] = PKW(P0, 2),  pw0); \
    VRD(4, 0); SBAR(); GAPA(QK1(C1, CZ), P0[6], P0[7], P0[8], P0[9],     pw0[2] = PKW(P0, 4),  pw0[3] = PKW(P0, 6),  pw0); \
    VRD(1, 1); SBAR(); GAPA(C0 = MFMA32(kf[2], qr[1], C0), P0[10], P0[11], P0[12], P0[13], pw1[0] = PKW(P0, 8),  pw1[1] = PKW(P0, 10), pw1); \
    VRD(5, 1); SBAR(); GAPA(C1 = MFMA32(kf[3], qr[1], C1), P0[14], P0[15], P1[0], P1[1],   pw1[2] = PKW(P0, 12), pw1[3] = PKW(P0, 14), pw1); \
    VRD(2, 2); SBAR(); GAPA(C0 = MFMA32(kf[4], qr[2], C0), P1[2], P1[3], 0.f, 0.f,         pw2[0] = PKW(P1, 0),  pw2[1] = PKW(P1, 2),  pw2); \
    VRD(6, 2); SBAR(); GAPM(C1 = MFMA32(kf[5], qr[2], C1)); pw2[2] = 0u; pw2[3] = 0u; \
                       GAPM(C0 = MFMA32(kf[6], qr[3], C0)); GAPM(C1 = MFMA32(kf[7], qr[3], C1)); \
    l_reg += sacc; } while (0)
#define PHASEA_PD(C0, C1, P0, P1, CZ) do { \
    VRD(0, 0); SBAR(); float sacc = P0[0] + P0[1]; \
                       GAPA(QK0(C0, CZ), P0[2], P0[3], P0[4], P0[5],     pw0[0] = PKW(P0, 0),  pw0[1] = PKW(P0, 2),  pw0); \
    VRD(4, 0); SBAR(); GAPA(QK1(C1, CZ), P0[6], P0[7], P0[8], P0[9],     pw0[2] = PKW(P0, 4),  pw0[3] = PKW(P0, 6),  pw0); \
    VRD(1, 1); SBAR(); GAPA(C0 = MFMA32(kf[2], qr[1], C0), P0[10], P0[11], P0[12], P0[13], pw1[0] = PKW(P0, 8),  pw1[1] = PKW(P0, 10), pw1); \
    VRD(5, 1); SBAR(); GAPA(C1 = MFMA32(kf[3], qr[1], C1), P0[14], P0[15], P1[0], P1[1],   pw1[2] = PKW(P0, 12), pw1[3] = PKW(P0, 14), pw1); \
    VRD(2, 2); SBAR(); GAPA(C0 = MFMA32(kf[4], qr[2], C0), P1[2], P1[3], P1[4], P1[5],     pw2[0] = PKW(P1, 0),  pw2[1] = PKW(P1, 2),  pw2); \
    VRD(6, 2); SBAR(); GAPA(C1 = MFMA32(kf[5], qr[2], C1), P1[6], P1[7], P1[8], P1[9],     pw2[2] = PKW(P1, 4),  pw2[3] = PKW(P1, 6),  pw2); \
    VRD(3, 3); SBAR(); GAPA(C0 = MFMA32(kf[6], qr[3], C0), P1[10], P1[11], P1[12], P1[13], pw3[0] = PKW(P1, 8),  pw3[1] = PKW(P1, 10), pw3); \
    VRD(7, 3); SBAR(); GAPA(C1 = MFMA32(kf[7], qr[3], C1), P1[14], P1[15], 0.f, 0.f,       pw3[2] = PKW(P1, 12), pw3[3] = PKW(P1, 14), pw3); \
    l_reg += sacc; } while (0)
#define STEP_WW(C0, C1, P0, P1, t, KR, VR) do { SBAR(); const LAS char* vp_ = vp0 + sl_prev; const int cad = CADDR((t) + 1); \
    PHASEA_PW(C0, C1, P0, P1, false); STAGE(t, KR, VR); float nmh; DECIDE_W(C0, C1); SBAR(); \
                               GAPB(o0 = MFMA32(VFR(0), PAF(0), o0), C0, 0);  CLDA(P0, 0); CLDA(P0, 1); SBAR(); \
                               GAPB(o1 = MFMA32(VFR(4), PAF(0), o1), C0, 4);  CLDA(P0, 2); CLDA(P0, 3); SBAR(); \
    KLD2(sl_next, 0); SBAR();  GAPB(o0 = MFMA32(VFR(1), PAF(1), o0), C0, 8);  CLDA(P0, 4); CLDA(P0, 5); SBAR(); \
    KLD2(sl_next, 1); SBAR();  GAPB(o1 = MFMA32(VFR(5), PAF(1), o1), C0, 12); CLDA(P0, 6); CLDA(P0, 7); SBAR(); \
    KLD2(sl_next, 2); SBAR();  GAPB(o0 = MFMA32(VFR(2), PAF(2), o0), C1, 0);  CLDB(P1, 0); CLDB(P1, 1); SBAR(); \
    KLD2(sl_next, 3); SBAR();  GAPM(o1 = MFMA32(VFR(6), PAF(2), o1)); } while (0)
#define STEP_DW(C0, C1, P0, P1, t, KR, VR) do { SBAR(); const LAS char* vp_ = vp0 + sl_prev; \
    PHASEA_PW(C0, C1, P0, P1, true); STAGE(t, KR, VR); float nmh; DECIDE_D(C0, C1); SBAR(); \
                               GAPB(o0 = MFMA32(VFR(0), PAF(0), o0), C0, 0); \
                               GAPB(o1 = MFMA32(VFR(4), PAF(0), o1), C0, 4); \
    KLD2(sl_next, 0); SBAR();  GAPB(o0 = MFMA32(VFR(1), PAF(1), o0), C0, 8); \
    KLD2(sl_next, 1); SBAR();  GAPB(o1 = MFMA32(VFR(5), PAF(1), o1), C0, 12); \
    KLD2(sl_next, 2); SBAR();  GAPB(o0 = MFMA32(VFR(2), PAF(2), o0), C1, 0); \
    KLD2(sl_next, 3); SBAR();  GAPB(o1 = MFMA32(VFR(6), PAF(2), o1), C1, 4); \
                               EXG(C1, 8); EXG(C1, 12); } while (0)
#define STEP_DD(C0, C1, P0, P1, t, KR, VR) do { SBAR(); const LAS char* vp_ = vp0 + sl_prev; \
    PHASEA_PD(C0, C1, P0, P1, true); STAGE(t, KR, VR); float nmh; DECIDE_D(C0, C1); SBAR(); \
                               GAPB(o0 = MFMA32(VFR(0), PAF(0), o0), C0, 0); \
                               GAPB(o1 = MFMA32(VFR(4), PAF(0), o1), C0, 4); \
    KLD2(sl_next, 0); SBAR();  GAPB(o0 = MFMA32(VFR(1), PAF(1), o0), C0, 8); \
    KLD2(sl_next, 1); SBAR();  GAPB(o1 = MFMA32(VFR(5), PAF(1), o1), C0, 12); \
    KLD2(sl_next, 2); SBAR();  GAPB(o0 = MFMA32(VFR(2), PAF(2), o0), C1, 0); \
    KLD2(sl_next, 3); SBAR();  GAPB(o1 = MFMA32(VFR(6), PAF(2), o1), C1, 4); \
                               GAPB(o0 = MFMA32(VFR(3), PAF(3), o0), C1, 8); \
                               GAPB(o1 = MFMA32(VFR(7), PAF(3), o1), C1, 12); } while (0)
    f32x16 zero16;
#pragma unroll
    for (int i = 0; i < 16; ++i) zero16[i] = 0.f;
    WBAR();
    sl_prev = 2 * AT_SLOTB; sl_cur = 0; sl_next = AT_SLOTB;
    if (!ctx) {
        { const int cad = CADDR(0);
#pragma unroll
          for (int q = 0; q < 8; ++q) CLDA(pA0, q);
          CLDB(pA1, 0); CLDB(pA1, 1); }
#pragma unroll
        for (int j = 0; j < 4; ++j) KLD2(0, j);
#pragma unroll
        for (int j = 0; j < 4; ++j) { pA0 = MFMA32(kf[2 * j], qr[j], pA0); pA1 = MFMA32(kf[2 * j + 1], qr[j], pA1); }
        STAGE(0, kreg, vreg);
        { float nmh; DECIDE_W(pA0, pA1);
#pragma unroll
          for (int r_ = 0; r_ < 16; ++r_) pA0[r_] = EX(pA0[r_]);
#pragma unroll
          for (int r_ = 0; r_ < 4; ++r_) pA1[r_] = EX(pA1[r_]); }
        { const int cad = CADDR(1);
#pragma unroll
          for (int q = 0; q < 8; ++q) CLDA(pB0, q);
          CLDB(pB1, 0); CLDB(pB1, 1); }
#pragma unroll
        for (int j = 0; j < 4; ++j) KLD2(AT_SLOTB, j);
        WBAR(); ROT();
#pragma unroll 1
        for (int t = 1; t < NWP; t += 2) {
            STEP_WW(pB0, pB1, pA0, pA1, t, kreg2, vreg2);     WBAR(); RESC(); ROT();
            STEP_WW(pA0, pA1, pB0, pB1, t + 1, kreg, vreg); WBAR(); RESC(); ROT();
        }
        STEP_DW(pB0, pB1, pA0, pA1, NWP, kreg2, vreg2); WBAR(); RESC(); ROT();
    } else {
#pragma unroll
        for (int j = 0; j < 4; ++j) KLD2(0, j);
        pB0 = MFMA32(kf[0], qr[0], zero16); pB1 = MFMA32(kf[1], qr[0], zero16);
#pragma unroll
        for (int j = 1; j < 4; ++j) { pB0 = MFMA32(kf[2 * j], qr[j], pB0); pB1 = MFMA32(kf[2 * j + 1], qr[j], pB1); }
        STAGE(0, kreg, vreg);
        { float nmh; DECIDE_D(pB0, pB1);
#pragma unroll
          for (int r_ = 0; r_ < 16; ++r_) { pB0[r_] = EX(pB0[r_]); pB1[r_] = EX(pB1[r_]); } }
#pragma unroll
        for (int j = 0; j < 4; ++j) KLD2(AT_SLOTB, j);
        WBAR(); ROT();
    }
    if (ctx) {
      STEP_DD(pA0, pA1, pB0, pB1, 1, kreg2, vreg2); WBAR(); RESC(); ROT();
      STEP_DD(pB0, pB1, pA0, pA1, 2, kreg, vreg);   WBAR(); RESC(); ROT();
      STEP_DD(pA0, pA1, pB0, pB1, 3, kreg2, vreg2); WBAR(); RESC(); ROT();
    } else {
      STEP_DD(pA0, pA1, pB0, pB1, NWP + 1, kreg, vreg);   WBAR(); RESC(); ROT();
      STEP_DD(pB0, pB1, pA0, pA1, NWP + 2, kreg2, vreg2); WBAR(); RESC(); ROT();
      STEP_DD(pA0, pA1, pB0, pB1, NWP + 3, kreg, vreg);   WBAR(); RESC(); ROT(); }
#define DRAIN(P0, P1) do { float sacc = P0[0] + P0[1]; \
      _Pragma("unroll") for (int r_ = 2; r_ < 16; ++r_) sacc += P0[r_]; \
      _Pragma("unroll") for (int r_ = 0; r_ < 16; ++r_) sacc += P1[r_]; \
      l_reg += sacc; \
      pw0 = (u32x4){PKW(P0, 0), PKW(P0, 2), PKW(P0, 4), PKW(P0, 6)}; pw1 = (u32x4){PKW(P0, 8), PKW(P0, 10), PKW(P0, 12), PKW(P0, 14)}; \
      pw2 = (u32x4){PKW(P1, 0), PKW(P1, 2), PKW(P1, 4), PKW(P1, 6)}; pw3 = (u32x4){PKW(P1, 8), PKW(P1, 10), PKW(P1, 12), PKW(P1, 14)}; \
      PIN(pw0); PIN(pw1); PIN(pw2); PIN(pw3); SBAR(); \
      _Pragma("unroll") for (int i_ = 0; i_ < 4; ++i_) zr[i_] = *(const u32x4*)(zp + (size_t)i_ * 8 * 512); \
      asm volatile("" ::: "memory"); if (next_ctx >= 0) attn_prefetch(F, layer, next_ctx, true, P); asm volatile("" ::: "memory");     \
      const LAS char* vp_ = vp0 + sl_prev; VRD(0, 0); VRD(4, 0); VRD(1, 1); VRD(5, 1); VRD(2, 2); VRD(6, 2); VRD(3, 3); VRD(7, 3); \
      o0 = MFMA32(VFR(0), PAF(0), o0); o1 = MFMA32(VFR(4), PAF(0), o1); o0 = MFMA32(VFR(1), PAF(1), o0); o1 = MFMA32(VFR(5), PAF(1), o1); \
      o0 = MFMA32(VFR(2), PAF(2), o0); o1 = MFMA32(VFR(6), PAF(2), o1); o0 = MFMA32(VFR(3), PAF(3), o0); o1 = MFMA32(VFR(7), PAF(3), o1); } while (0)
    int le = lane; asm volatile("" : "+v"(le));
    unsigned char* wse = kws();
    const bf16_t* zp = (const bf16_t*)(wse + WS_SZA) + (size_t)(R0 + (le >> 3)) * 512 + h * 64 + (le & 7) * 8;
    u32x4 zr[4];
    DRAIN(pA0, pA1);
#undef DRAIN
#undef STEP_DD
#undef STEP_DW
#undef STEP_WW
#undef PHASEA_PD
#undef PHASEA_PW
#undef QK0
#undef QK1
#undef STAGE
#undef EXG
#undef GAPB
#undef GAPM
#undef GAPA
#undef VRD
#undef VFR
#undef PAF
#undef PKW
#undef EX
#undef RESC
#undef DECIDE_W
#undef DECIDE_D
#undef DEC_TAIL
#undef CLDA
#undef CLDB
#undef CADDR
#undef KLD2
#undef MX3
#undef ROT
#undef VT
    { auto rr = __builtin_amdgcn_permlane32_swap(__float_as_uint(l_reg), __float_as_uint(l_reg), false, false); l_reg = __uint_as_float(rr[0]) + __uint_as_float(rr[1]); }
    const float inv = 1.0f / l_reg;
    { LAS char* stg = L + AT_TBL + wid * 4608; LAS char* srow = stg + (le >> 3) * 144 + (le & 7) * 16; LAS char* sfrag = stg + (le & 31) * 144 + (le >> 5) * 8;
#pragma unroll
      for (int i = 0; i < 4; ++i) *(LAS u32x4*)(srow + i * 8 * 144) = zr[i];
      asm volatile("s_waitcnt lgkmcnt(0)" ::: "memory");
      u32x2 zg0[4], zg1[4];
#pragma unroll
      for (int g = 0; g < 4; ++g) { zg0[g] = *(const LAS u32x2*)(sfrag + 16 * g); zg1[g] = *(const LAS u32x2*)(sfrag + 64 + 16 * g); }
      asm volatile("s_waitcnt lgkmcnt(0)" ::: "memory");
#pragma unroll
      for (int g = 0; g < 4; ++g) {
          const u32x2 z0 = zg0[g], z1 = zg1[g];
          u32x2 w0, w1;
          w0.x = cvtpk_s(o0[4 * g + 0] * inv * bflo(z0.x), o0[4 * g + 1] * inv * bfhi(z0.x)); w0.y = cvtpk_s(o0[4 * g + 2] * inv * bflo(z0.y), o0[4 * g + 3] * inv * bfhi(z0.y));
          w1.x = cvtpk_s(o1[4 * g + 0] * inv * bflo(z1.x), o1[4 * g + 1] * inv * bfhi(z1.x)); w1.y = cvtpk_s(o1[4 * g + 2] * inv * bflo(z1.y), o1[4 * g + 3] * inv * bfhi(z1.y));
          *(LAS u32x2*)(sfrag + 16 * g) = w0; *(LAS u32x2*)(sfrag + 64 + 16 * g) = w1; }
      asm volatile("s_waitcnt lgkmcnt(0)" ::: "memory");
      bf16_t* yp = (bf16_t*)(wse + WS_YAB) + (size_t)(R0 + (le >> 3)) * 1024 + h * 64 + (le & 7) * 8;
#pragma unroll
      for (int i = 0; i < 4; ++i) { const u32x4 v = *(const LAS u32x4*)(srow + i * 8 * 144); *(u32x4*)(yp + (size_t)i * 8 * 1024) = v; } }
    WBAR();
#undef WBAR
#undef PIN
#undef SBAR
}
#undef ATT_SRC
#undef ATT_DECODE

__device__ __forceinline__ void mix_phase(Frame& F, int layer) {
    AttnPre P;
    const int t_ctx = 255 - F.bx;
    for (int t = F.bx; t < M / 32; t += 256) conv_task(F, layer, t, P, t + 256 >= M / 32 ? F.bx : -1);
    attn_wg(F, layer, F.bx, false, P, t_ctx < 128 ? t_ctx : -1);
    if (t_ctx < 128) attn_wg(F, layer, t_ctx, true, P, -1);
}

__device__ __forceinline__ void cvec_phase(Frame& F) {
    const int gw = F.bx * 8 + F.wave, NGW = F.G * 8;
    const float* md = WSP(float, WS_MOD) + 5 * 3072;
    f32x4 sh[5][4];
#pragma unroll
    for (int g = 0; g < 5; ++g)
#pragma unroll
        for (int i = 0; i < 4; ++i) sh[g][i] = *(const f32x4*)(md + g * 3072 + 16 * F.lane + 4 * i);
    const bf16_t* W = WSP(bf16_t, WS_WTIN) + (size_t)DIN * D; const float* bp = WSP(float, WS_BIASP) + DIN; float* cv = WSP(float, WS_CVEC);
    for (int n = gw; n < DIN; n += NGW) {
        const u32x4 wa = *(const u32x4*)(W + (size_t)n * D + 16 * F.lane), wb = *(const u32x4*)(W + (size_t)n * D + 16 * F.lane + 8);
        const f32x4 w0 = {bflo(wa.x), bfhi(wa.x), bflo(wa.y), bfhi(wa.y)}, w1 = {bflo(wa.z), bfhi(wa.z), bflo(wa.w), bfhi(wa.w)};
        const f32x4 w2 = {bflo(wb.x), bfhi(wb.x), bflo(wb.y), bfhi(wb.y)}, w3 = {bflo(wb.z), bfhi(wb.z), bflo(wb.w), bfhi(wb.w)};
        const float bias = bp[n];
#pragma unroll
        for (int g = 0; g < 5; ++g) { const f32x4 p = sh[g][0] * w0 + sh[g][1] * w1 + sh[g][2] * w2 + sh[g][3] * w3;
            const float sm = wave_sum((p[0] + p[1]) + (p[2] + p[3])); if (F.lane == 0) cv[g * DIN + n] = sm + bias; }
    }
}

struct Args { const float* in[20]; float* out; unsigned char* ws; int ph_lo, ph_hi; };

__global__ void __launch_bounds__(512, 2) mk_fwd(Args args) {
    extern __shared__ __attribute__((aligned(16))) unsigned char lds_raw[];
    Frame F;
    F.lds = (LAS unsigned char*)lds_raw;
    F.tid = threadIdx.x; F.lane = F.tid & 63; F.wave = __builtin_amdgcn_readfirstlane(F.tid >> 6); F.G = gridDim.x; F.bx = blockIdx.x;
    for (int u = F.tid; u < (LDS_BYTES - LDSCTL_OFF) / 4; u += 512) ((LAS unsigned*)(F.lds + LDSCTL_OFF))[u] = 0u;
    __syncthreads();
    XcdBarrier bar; bar.bar = WSP(unsigned, WS_CTL) + CW_BAR; bar.x = 0; bar.st = nullptr;
#define lo (kint(176))
#define hi (kint(180))
    if (hi - lo > 1) bar = xcd_barrier_post(WSP(unsigned, WS_CTL) + CW_BAR, (volatile LAS unsigned*)(F.lds + MISC_OFF) + 8);
#ifndef PH_MASK
#define PH_MASK 0x7f
#endif
#define PHK(kind) ((PH_MASK >> (kind)) & 1)
#define IN(k) (lo <= (k) && (k) < hi)
#define SEAM(k) do { if (IN(k) && IN((k) + 1)) { XcdBarrier bb_; bb_.bar = WSP(unsigned, WS_CTL) + CW_BAR; bb_.x = xb_xcc_id(); bb_.st = (volatile LAS unsigned*)((LAS unsigned char*)lds_raw + MISC_OFF) + 8; xcd_barrier(bb_); } } while (0)
#define FRESH() do { F.tid = fresh_tid(); F.lane = F.tid & 63; F.wave = __builtin_amdgcn_readfirstlane(F.tid >> 6); } while (0)

    if (PHK(0) && IN(0)) { FRESH(); p0_prologue(F); SEAM(0); }
    for (int layer = 0; layer < DEPTH; ++layer) {
        const int pb = 1 + 5 * layer;
        if (PHK(1) && IN(pb) && layer == 0) { FRESH();
            if (layer == 0 && F.bx == F.G - 1) { const float* rg = kin(I_RMS_G) + D; const float* md = WSP(float, WS_MOD) + 5 * 3072; float* gm = WSP(float, WS_GM);
                for (int i = F.tid; i < 5 * 1024; i += 512) { const int g = i >> 10, c = i & 1023; gm[i] = rg[c] * (1.0f + md[g * 3072 + 1024 + c]); } }
            norm_phase(F, layer); SEAM(pb); }
        if (PHK(2) && IN(pb + 1)) {
            constexpr int M1 = 46 * 256;
            const bf16_t* Ain = layer == 0 ? WSP(bf16_t, WS_H) : WSP(bf16_t, WS_YAB);
            { pg8::Gemm g{Ain, WSP(bf16_t, WS_WTIN) + (size_t)layer * DIN * D, M1, DIN, D, D}; pg8::StaticOrder S; S.init(M1, DIN, F.G, F.bx);
              if (layer == 0) { EpiInT<4> E{layer, 0}; pg8::gemm_phase<EpiInT<4>>(F.lds, g, S, E); } else { EpiInT<4, true> E{layer, 0}; pg8::gemm_phase<EpiInT<4, true>>(F.lds, g, S, E); } }
            { pg8::Gemm g{Ain + (size_t)M1 * D, WSP(bf16_t, WS_WTIN) + (size_t)layer * DIN * D, M - M1, DIN, D, D}; pg8::StaticOrder S; S.init(M - M1, DIN, F.G, F.G - 1 - F.bx, 0, 128);
              if (layer == 0) { EpiInT<2> E{layer, M1}; pg8::gemm_phase<EpiInT<2>>(F.lds, g, S, E); } else { EpiInT<2, true> E{layer, M1}; pg8::gemm_phase<EpiInT<2, true>>(F.lds, g, S, E); } }
            if (layer == 0) { const int nidle = F.G - (M - M1) / 128 * (DIN / 256);
                if (nidle > 0 && F.bx < nidle) { FRESH(); __syncthreads(); wt_items(F, 1, F.bx * 8 + F.wave, nidle * 8); } }
            SEAM(pb + 1);
        }
        if (PHK(3) && IN(pb + 2)) { FRESH(); mix_phase(F, layer); SEAM(pb + 2); }
        if (PHK(4) && IN(pb + 3)) {
            if (layer == 0) { FRESH(); cvec_phase(F); }
            pg8::Gemm g{WSP(bf16_t, WS_YAB), WSP(bf16_t, WS_WTPROJ) + (size_t)layer * D * D, M, D, D, D}; pg8::StaticOrder S; S.init(M, D, F.G, F.bx, 0, 192);
            EpiProj E{};
            pg8::gemm_phase<EpiProj>(F.lds, g, S, E);
            SEAM(pb + 3);
        }
        if (PHK(5) && IN(pb + 4)) {
            pg8::Gemm g{WSP(bf16_t, WS_H), WSP(bf16_t, WS_WTOUT) + (size_t)layer * D * D, M, D, D, D}; pg8::StaticOrder S; S.init(M, D, F.G, F.bx, 0, 192);
            if (layer + 1 < DEPTH) { EpiOutT<false> E{layer}; pg8::gemm_phase<EpiOutT<false>>(F.lds, g, S, E); }
            else { EpiOutT<true> E{layer}; pg8::gemm_phase<EpiOutT<true>>(F.lds, g, S, E); }
            if (layer + 1 < DEPTH) SEAM(pb + 4);
        }
    }
#undef IN
#undef SEAM
#undef lo
#undef hi
}

extern "C" void kernel_launch(void* const* d_in, const int* in_sizes, int n_in, void* d_out, int out_size, void* d_ws, size_t ws_size, hipStream_t stream) {
    static int grid = 0;
    if (grid == 0) {
        if (n_in != 20 || ws_size < WS_END) { fprintf(stderr, "kernel_launch: unexpected inputs (n_in %d, ws %zu)\n", n_in, ws_size); grid = -1; return; }
        int dev = 0, cus = 0, per_cu = 0;
        if (hipGetDevice(&dev) != hipSuccess || hipDeviceGetAttribute(&cus, hipDeviceAttributeMultiprocessorCount, dev) != hipSuccess) { grid = -1; return; }
        if (hipFuncSetAttribute((const void*)mk_fwd, hipFuncAttributeMaxDynamicSharedMemorySize, LDS_BYTES) != hipSuccess) { fprintf(stderr, "kernel_launch: hipFuncSetAttribute failed\n"); grid = -1; return; }
        if (hipOccupancyMaxActiveBlocksPerMultiprocessor(&per_cu, (const void*)mk_fwd, 512, LDS_BYTES) != hipSuccess || per_cu < 1) { fprintf(stderr, "kernel_launch: occupancy query says %d\n", per_cu); per_cu = 1; }
        (void)hipGetLastError();
        if (cus < 256) { fprintf(stderr, "kernel_launch: %d CUs; the mixer's work split is written for a grid of 256 workgroups\n", cus); grid = -1; return; }
        grid = 256;
    }
    if (grid < 0) return;
    (void)hipMemsetAsync((char*)d_ws + WS_CTL, 0, CTL_ZERO_BYTES, stream);
    Args a{};
    for (int i = 0; i < 20; ++i) a.in[i] = (const float*)d_in[i];
    a.out = (float*)d_out; a.ws = (unsigned char*)d_ws;
    if (MK_N_LAUNCHES == 1) { a.ph_lo = 0; a.ph_hi = NPHASE; hipLaunchKernelGGL(mk_fwd, dim3(grid), dim3(512), LDS_BYTES, stream, a); }
    else for (int p = 0; p < NPHASE; ++p) { a.ph_lo = p; a.ph_hi = p + 1; hipLaunchKernelGGL(mk_fwd, dim3(grid), dim3(512), LDS_BYTES, stream, a); }
}
```

```cpp
#include <hip/hip_runtime.h>
#include <cstdio>
#include <cstdint>

#ifndef MK_N_LAUNCHES
#define MK_N_LAUNCHES 1
#endif

#define GAS __attribute__((address_space(1)))
#define LAS __attribute__((address_space(3)))
typedef unsigned short bf16_t;
typedef short bf16x8 __attribute__((ext_vector_type(8)));
typedef float f32x4 __attribute__((ext_vector_type(4)));
typedef float f32x2 __attribute__((ext_vector_type(2)));
typedef unsigned u32x4 __attribute__((ext_vector_type(4)));
typedef unsigned u32x2 __attribute__((ext_vector_type(2)));
typedef GAS unsigned gu32;
#define RLX_AGENT __ATOMIC_RELAXED, __HIP_MEMORY_SCOPE_AGENT
#define LDS_WAIT() asm volatile("s_waitcnt lgkmcnt(0)" ::: "memory")
#define VM_WAIT() asm volatile("s_waitcnt vmcnt(0)" ::: "memory")

constexpr int D = 1024, NCTX = 4096, NLAT = 8192, M = NCTX + NLAT, DIN = 5632, DEPTH = 2, NH = 8, HD = 64;
constexpr int NPHASE = 12;
constexpr float EPS = 1e-6f;

constexpr size_t MiB = 1u << 20;
constexpr size_t WS_CTL = 0, CTL_ZERO_BYTES = 192 * 1024;
constexpr size_t WS_RSS2 = 128 * 1024;
constexpr size_t WS_RSS = 64 * 1024;
constexpr size_t WS_GM = 1 * MiB + 192 * 1024;
constexpr size_t WS_CVEC = 1 * MiB + 256 * 1024;
constexpr size_t WS_MOD = 1 * MiB;
constexpr size_t WS_BIASP = 1 * MiB + 128 * 1024;
constexpr size_t WS_WTIN = 2 * MiB;
constexpr size_t WS_WTPROJ = 24 * MiB;
constexpr size_t WS_WTOUT = 28 * MiB;
constexpr size_t WS_CK = 32 * MiB, WS_CV = 34 * MiB;
constexpr size_t WS_H = 36 * MiB;
constexpr size_t WS_Q = 60 * MiB, WS_K = 72 * MiB, WS_V = 84 * MiB, WS_SZA = 96 * MiB, WS_U = 108 * MiB, WS_SZB = 120 * MiB;
constexpr size_t WS_GR = 132 * MiB, WS_GB = 156 * MiB;
constexpr size_t WS_YAB = 180 * MiB;
constexpr size_t WS_X1 = 204 * MiB;
constexpr size_t WS_END = 228 * MiB;
constexpr int CW_BAR = 4096;
constexpr int CW_ROWBLK = 8192;

constexpr int RING_BYTES = 131072;
constexpr int LDSCTL_OFF = RING_BYTES, MISC_OFF = LDSCTL_OFF + 320;
constexpr int LDS_BYTES = 147456;

__device__ __forceinline__ unsigned f2bf(float f) { unsigned u = __builtin_bit_cast(unsigned, f); return (u + 0x7fffu + ((u >> 16) & 1u)) >> 16; }
__device__ __forceinline__ unsigned pk2(float lo, float hi) { return f2bf(lo) | (f2bf(hi) << 16); }
typedef __bf16 bf16x2_cv __attribute__((ext_vector_type(2)));
__device__ __forceinline__ unsigned cvt_pk_bf16(float lo, float hi) { f32x2 v = {lo, hi}; bf16x2_cv b = __builtin_convertvector(v, bf16x2_cv); return __builtin_bit_cast(unsigned, b); }
__device__ __forceinline__ float bflo(unsigned w) { return __builtin_bit_cast(float, w << 16); }
__device__ __forceinline__ float bfhi(unsigned w) { return __builtin_bit_cast(float, w & 0xffff0000u); }
__device__ __forceinline__ float sigmoid_f(float x) { return __builtin_amdgcn_rcpf(1.0f + __expf(-x)); }
__device__ __forceinline__ float silu_f(float x) { return x * sigmoid_f(x); }
__device__ __forceinline__ float dpp_f(float v, float o) { return v + o; }
__device__ __forceinline__ float wave_sum(float v) {
#define DPP_ADD(ctrl, rm, bc) v += __builtin_bit_cast(float, __builtin_amdgcn_update_dpp(0, __builtin_bit_cast(int, v), ctrl, rm, 0xf, bc))
    DPP_ADD(0x111, 0xf, true); DPP_ADD(0x112, 0xf, true); DPP_ADD(0x114, 0xf, true); DPP_ADD(0x118, 0xf, true);
    DPP_ADD(0x142, 0xa, false); DPP_ADD(0x143, 0xc, false);
#undef DPP_ADD
    return __builtin_bit_cast(float, __builtin_amdgcn_readlane(__builtin_bit_cast(int, v), 63));
}

__device__ __forceinline__ int fresh_tid() { int t = threadIdx.x; asm volatile("" : "+v"(t)); return t; }

namespace pg8 {
constexpr int BM = 256, BK = 64, HALF = 128, HTB = HALF * BK * 2, STAGE_BYTES = 8 * HTB, NXCD = 8, WGM = 8;
__host__ __device__ __forceinline__ int lds_byte(int r, int c) { const int st = (r >> 4) * 2 + (c >> 5), rr = r & 15, cc = c & 31, ob = rr * 64 + cc * 2; return st * 1024 + (ob ^ (((ob >> 9) & 1) << 5)); }
__host__ __device__ __forceinline__ void stage_rc(int b, int& R, int& C) { const int st = b / 1024, sb = b % 1024, swz = sb ^ (((sb >> 9) & 1) << 5); R = (st >> 1) * 16 + swz / 64; C = (st & 1) * 32 + (swz % 64) / 2; }
__host__ __device__ __forceinline__ int perm32(int rho) { const int n = rho >> 4, i = rho & 15; return 8 * (i >> 2) + 4 * n + (i & 3); }

struct Unit { int pm, pn, kh; };
struct Gemm { const bf16_t* A; const bf16_t* Bt; int M, N, K, ld; };

struct StaticOrder {
    int nM, nN, nwg, G, c;
    __host__ __device__ void init(int M_, int N_, int G_, int c_, int split_ = 0, int bm_ = BM) { nM = M_ / bm_; nN = N_ / BM; nwg = nM * nN; G = G_; c = c_; split = split_; }
    int split;
    __host__ __device__ bool next(int i0, Unit& u) const {
        const int i = split ? (i0 >> 1) : i0; u.kh = split ? (i0 & 1) : 0;
        const long L = (long)i * G + c; if (L >= nwg) return false;
        int wgid = (int)L; { const int q = nwg / NXCD, r = nwg % NXCD, xcd = wgid % NXCD, off = wgid / NXCD; wgid = (xcd < r ? xcd * (q + 1) : r * (q + 1) + (xcd - r) * q) + off; }
        const int nig = WGM * nN, gid = wgid / nig, fm = gid * WGM, gsz = (nM - fm) < WGM ? (nM - fm) : WGM;
        u.pm = fm + ((wgid % nig) % gsz); u.pn = (wgid % nig) / gsz; return true;
    }
};

template <class Epi, bool ALIGN_EPI = true, bool SP2 = true>
__device__ __forceinline__ void gemm_phase(LAS unsigned char* lds, const Gemm g, const StaticOrder& S, const Epi& E) {
    const int tid = fresh_tid(), wid = __builtin_amdgcn_readfirstlane(tid >> 6), lane = tid & 63, wr = wid >> 2, wc = wid & 3, fr = lane & 15, fq = lane >> 4;
    static_assert(SP2 || Epi::MB == 4, "tiles lower than 256 rows use the SP2 loop");
    constexpr int MB = Epi::MB, HROWS = 32 * MB;
    const int K = g.ld, nt = g.K / BK;
    const size_t khstep = (size_t)g.K * 2;
    unsigned voffA[2], voffB[2];
#pragma unroll
    for (int i = 0; i < 2; ++i) { int R, C; stage_rc(tid * 16 + i * 8192, R, C); const int Rb = Epi::PERM ? ((R & ~31) + perm32(R & 31)) : R;
        voffA[i] = (unsigned)(R * K + C) * 2u; voffB[i] = (unsigned)(Rb * K + C) * 2u; }
    const size_t kstep = (size_t)(BK * 2);
    const size_t hstep = (size_t)HROWS * K * 2;
    const size_t hstepB = (size_t)HALF * K * 2;
    const size_t tstep = 2 * hstep, tstepB = 2 * hstepB;
    const unsigned ldsw = (unsigned)wid * 1024u;
    const int aoff = lds_byte(wr * (16 * MB) + fr, fq * 8), boff = lds_byte(wc * 32 + fr, fq * 8);
#define PG8_SA(b, h) (((b) * 2 + (h)) * HTB)
#define PG8_SB(b, h) ((4 + (b) * 2 + (h)) * HTB)
#define PG8_STAGE(bufoff, gbase, voff) do { _Pragma("unroll") for (int _i = 0; _i < 2; ++_i) \
        __builtin_amdgcn_global_load_lds((const unsigned*)((const char*)(gbase) + (voff)[_i]), (LAS unsigned*)(lds + (bufoff) + ldsw + _i * 8192), 16, 0, 0); } while (0)
#define PG8_LDA(dst, b, h) do { _Pragma("unroll") for (int m = 0; m < MB; ++m) _Pragma("unroll") for (int k = 0; k < 2; ++k) dst[m][k] = *(const LAS bf16x8*)(lds + PG8_SA(b, h) + aoff + m * 2048 + k * 1024); } while (0)
#define PG8_LDB(dst, b, h) do { _Pragma("unroll") for (int n = 0; n < 2; ++n) _Pragma("unroll") for (int k = 0; k < 2; ++k) dst[n][k] = *(const LAS bf16x8*)(lds + PG8_SB(b, h) + boff + n * 2048 + k * 1024); } while (0)
#define PG8_MMA(ai, bj, At, Bt) do { __builtin_amdgcn_s_setprio(1); _Pragma("unroll") for (int m = 0; m < MB; ++m) _Pragma("unroll") for (int n = 0; n < 2; ++n) _Pragma("unroll") for (int k = 0; k < 2; ++k) \
        acc[ai][bj][m][n] = __builtin_amdgcn_mfma_f32_16x16x32_bf16(Bt[n][k], At[m][k], acc[ai][bj][m][n], 0, 0, 0); __builtin_amdgcn_s_setprio(0); } while (0)
#define PG8_WAIT_V(n) asm volatile("s_waitcnt vmcnt(" #n ")" ::: "memory")
    const int aIss = (MB == 4) ? 2 : (MB == 3) ? (wid < 4 ? 2 : 1) : (MB == 2) ? 1 : (wid < 4 ? 1 : 0);
#define PG8_STAGE_A(bufoff, gbase, voff) do { _Pragma("unroll") for (int _i = 0; _i < 2; ++_i) if (MB == 4 || _i < aIss) \
        __builtin_amdgcn_global_load_lds((const unsigned*)((const char*)(gbase) + (voff)[_i]), (LAS unsigned*)(lds + (bufoff) + ldsw + _i * 8192), 16, 0, 0); } while (0)
#define PG8_WAIT_VN(n) do { switch (n) { case 0: PG8_WAIT_V(0); break; case 1: PG8_WAIT_V(1); break; case 2: PG8_WAIT_V(2); break; case 4: PG8_WAIT_V(4); break; case 5: PG8_WAIT_V(5); break; \
        case 6: PG8_WAIT_V(6); break; default: PG8_WAIT_V(8); break; } } while (0)
#define PG8_WAIT_LOOP() do { if constexpr (MB == 4) PG8_WAIT_V(8); else PG8_WAIT_VN(4 + 2 * aIss); } while (0)
#define PG8_WAIT_P1() do { if constexpr (MB == 4) PG8_WAIT_V(2); else PG8_WAIT_VN(aIss); } while (0)
#define PG8_WAIT_P2() do { if constexpr (MB == 4) PG8_WAIT_V(6); else PG8_WAIT_VN(4 + aIss); } while (0)
#define PG8_WAIT_L(n) asm volatile("s_waitcnt lgkmcnt(" #n ")" ::: "memory")
#define PG8_BAR __builtin_amdgcn_s_barrier()
#define PG8_SCHED __builtin_amdgcn_sched_barrier(0)
    Unit cur, nxt; int ui = 0;
    if (!S.next(0, cur)) return;
    f32x4 acc[2][2][MB][2];
#pragma unroll
    for (int a = 0; a < 2; ++a)
#pragma unroll
        for (int b = 0; b < 2; ++b)
#pragma unroll
            for (int m = 0; m < MB; ++m)
#pragma unroll
                for (int n = 0; n < 2; ++n) acc[a][b][m][n] = (f32x4){0.f, 0.f, 0.f, 0.f};
    bf16x8 At[MB][2], B0[2][2], B1[2][2];
    const char* cA = (const char*)g.A + (size_t)cur.pm * tstep + cur.kh * khstep; const char* cB = (const char*)g.Bt + (size_t)cur.pn * tstepB + cur.kh * khstep;
    if constexpr (SP2) {
        PG8_STAGE(PG8_SB(0, 0), cB, voffB); PG8_STAGE(PG8_SB(0, 1), cB + hstepB, voffB); PG8_STAGE_A(PG8_SA(0, 0), cA, voffA); PG8_STAGE_A(PG8_SA(0, 1), cA + hstep, voffA);
        if (wr == 1) PG8_BAR;
        PG8_WAIT_P1(); PG8_BAR;
        PG8_STAGE(PG8_SB(1, 0), cB + kstep, voffB); PG8_STAGE_A(PG8_SA(1, 0), cA + kstep, voffA); PG8_STAGE(PG8_SB(1, 1), cB + hstepB + kstep, voffB);
        PG8_WAIT_P2(); PG8_BAR;
    } else {
        PG8_STAGE(PG8_SB(0, 0), cB, voffB); PG8_STAGE(PG8_SA(0, 0), cA, voffA); PG8_STAGE(PG8_SB(0, 1), cB + hstepB, voffB); PG8_STAGE(PG8_SA(0, 1), cA + hstep, voffA);
        if (wr == 1) PG8_BAR;
        PG8_WAIT_V(4); PG8_BAR;
        PG8_STAGE(PG8_SB(1, 0), cB + kstep, voffB); PG8_STAGE(PG8_SA(1, 0), cA + kstep, voffA); PG8_STAGE(PG8_SB(1, 1), cB + hstepB + kstep, voffB);
        PG8_WAIT_V(6); PG8_BAR;
    }
    for (;;) {
        const bool has_next = S.next(ui + 1, nxt);
        const char* nA = has_next ? (const char*)g.A + (size_t)nxt.pm * tstep + nxt.kh * khstep : cA; const char* nB = has_next ? (const char*)g.Bt + (size_t)nxt.pn * tstepB + nxt.kh * khstep : cB;
        for (int t = 0; t < nt; t += 2) {
            const bool last = (t == nt - 2);
            const char* a1 = cA + (size_t)(t + 1) * kstep;
            const char* a2 = last ? nA : cA + (size_t)(t + 2) * kstep; const char* b2 = last ? nB : cB + (size_t)(t + 2) * kstep;
            const char* a3 = a2 + kstep; const char* b3 = b2 + kstep;
            if constexpr (SP2) {
            PG8_LDB(B0, 0, 0); PG8_LDB(B1, 0, 1); PG8_SCHED; PG8_LDA(At, 0, 0); PG8_STAGE_A(PG8_SA(1, 1), a1 + hstep, voffA);
            PG8_WAIT_LOOP(); PG8_WAIT_L(0); PG8_BAR; PG8_MMA(0, 0, At, B0); PG8_MMA(0, 1, At, B1); PG8_BAR; PG8_SCHED;
            PG8_LDA(At, 0, 1); PG8_STAGE(PG8_SB(0, 0), b2, voffB); PG8_STAGE(PG8_SB(0, 1), b2 + hstepB, voffB); PG8_STAGE_A(PG8_SA(0, 0), a2, voffA);
            PG8_WAIT_LOOP(); PG8_WAIT_L(0); PG8_BAR; PG8_MMA(1, 0, At, B0); PG8_MMA(1, 1, At, B1); PG8_BAR; PG8_SCHED;
            PG8_LDB(B0, 1, 0); PG8_LDB(B1, 1, 1); PG8_SCHED; PG8_LDA(At, 1, 0); PG8_STAGE_A(PG8_SA(0, 1), a2 + hstep, voffA);
            PG8_WAIT_LOOP(); PG8_WAIT_L(0); PG8_BAR; PG8_MMA(0, 0, At, B0); PG8_MMA(0, 1, At, B1); PG8_BAR; PG8_SCHED;
            PG8_LDA(At, 1, 1); PG8_STAGE(PG8_SB(1, 0), b3, voffB); PG8_STAGE(PG8_SB(1, 1), b3 + hstepB, voffB); PG8_STAGE_A(PG8_SA(1, 0), a3, voffA);
            PG8_WAIT_LOOP(); PG8_WAIT_L(0); PG8_BAR; PG8_MMA(1, 0, At, B0); PG8_MMA(1, 1, At, B1); PG8_BAR; PG8_SCHED;
            } else {
            PG8_LDB(B0, 0, 0); PG8_SCHED; PG8_LDA(At, 0, 0); PG8_STAGE(PG8_SA(1, 1), a1 + hstep, voffA);
            PG8_WAIT_L(8); PG8_BAR; PG8_WAIT_L(0); PG8_MMA(0, 0, At, B0); PG8_BAR; PG8_SCHED;
            PG8_LDB(B1, 0, 1); PG8_STAGE(PG8_SB(0, 0), b2, voffB);
            PG8_BAR; PG8_WAIT_L(0); PG8_MMA(0, 1, At, B1); PG8_BAR;
            PG8_LDA(At, 0, 1); PG8_STAGE(PG8_SA(0, 0), a2, voffA);
            PG8_BAR; PG8_WAIT_L(0); PG8_MMA(1, 0, At, B0); PG8_BAR; PG8_SCHED;
            PG8_STAGE(PG8_SB(0, 1), b2 + hstepB, voffB);
            PG8_WAIT_V(6); PG8_BAR; PG8_MMA(1, 1, At, B1); PG8_BAR;
            PG8_LDB(B0, 1, 0); PG8_SCHED; PG8_LDA(At, 1, 0); PG8_STAGE(PG8_SA(0, 1), a2 + hstep, voffA);
            PG8_WAIT_L(8); PG8_BAR; PG8_WAIT_L(0); PG8_MMA(0, 0, At, B0); PG8_BAR; PG8_SCHED;
            PG8_LDB(B1, 1, 1); PG8_STAGE(PG8_SB(1, 0), b3, voffB);
            PG8_BAR; PG8_WAIT_L(0); PG8_MMA(0, 1, At, B1); PG8_BAR;
            PG8_LDA(At, 1, 1); PG8_STAGE(PG8_SA(1, 0), a3, voffA);
            PG8_BAR; PG8_WAIT_L(0); PG8_MMA(1, 0, At, B0); PG8_BAR; PG8_SCHED;
            PG8_STAGE(PG8_SB(1, 1), b3 + hstepB, voffB);
            PG8_WAIT_V(6); PG8_BAR; PG8_MMA(1, 1, At, B1); PG8_BAR;
            }
            if constexpr (Epi::MIDHOOK) { if (t + 2 == nt / 2) { E.mid(acc, cur, wr, wc, fr, fq); PG8_SCHED; } }
        }
        if constexpr (ALIGN_EPI) { if (wr == 0) PG8_BAR; }
        E(acc, cur, wr, wc, fr, fq);
        if (!has_next) break;
        {
#pragma unroll
        for (int a = 0; a < 2; ++a)
#pragma unroll
            for (int b = 0; b < 2; ++b)
#pragma unroll
                for (int m = 0; m < MB; ++m)
#pragma unroll
                    for (int n = 0; n < 2; ++n) acc[a][b][m][n] = (f32x4){0.f, 0.f, 0.f, 0.f};
        }
        cur = nxt; cA = nA; cB = nB; ++ui;
        if constexpr (ALIGN_EPI) { if (wr == 1) PG8_BAR; }
    }
    PG8_WAIT_V(0);
    if constexpr (!ALIGN_EPI) { if (wr == 0) PG8_BAR; }
    PG8_BAR;
#undef PG8_SA
#undef PG8_SB
#undef PG8_STAGE
#undef PG8_STAGE_A
#undef PG8_WAIT_VN
#undef PG8_WAIT_LOOP
#undef PG8_WAIT_P1
#undef PG8_WAIT_P2
#undef PG8_LDA
#undef PG8_LDB
#undef PG8_MMA
#undef PG8_WAIT_V
#undef PG8_WAIT_L
#undef PG8_BAR
#undef PG8_SCHED
}
}

#define AS4 __attribute__((address_space(4)))
__device__ __forceinline__ const float* kin(int k) { const AS4 char* p = (const AS4 char*)__builtin_amdgcn_kernarg_segment_ptr(); asm volatile("" : "+s"(p)); return *(const float* const AS4*)(p + 8 * k); }
__device__ __forceinline__ float* kout() { const AS4 char* p = (const AS4 char*)__builtin_amdgcn_kernarg_segment_ptr(); asm volatile("" : "+s"(p)); return *(float* const AS4*)(p + 160); }
__device__ __forceinline__ int kint(int off) { const AS4 char* p = (const AS4 char*)__builtin_amdgcn_kernarg_segment_ptr(); asm volatile("" : "+s"(p)); return *(const int AS4*)(p + off); }
__device__ __forceinline__ unsigned char* kws() { const AS4 char* p = (const AS4 char*)__builtin_amdgcn_kernarg_segment_ptr(); asm volatile("" : "+s"(p)); return *(unsigned char* const AS4*)(p + 168); }
#define I_X_PROMPT 0
#define I_X_SAMPLE 1
#define I_CACHE_K 2
#define I_CACHE_V 3
#define I_C 4
#define I_C_CTX 5
#define I_RMS_G 6
#define I_W_ADA 7
#define I_B_ADA 8
#define I_W_IN 9
#define I_B_IN 10
#define I_REL_BIAS 11
#define I_DW_W 12
#define I_DW_B 13
#define I_LN_G 14
#define I_LN_B 15
#define I_W_PROJ_A 16
#define I_W_PROJ_B 17
#define I_W_OUT 18
#define I_FINAL_G 19
#define WSP(T, off) ((T*)(kws() + (off)))

constexpr float QSCALE = 0.125f * 1.4426950408889634f;
typedef f32x4 acc_t[2][2][4][2];
typedef f32x4 acc3_t[2][2][3][2];

template <int MB_, bool FU = false> struct EpiInT {
    static constexpr bool PERM = true, SPLIT2 = false, MIDHOOK = false; static constexpr int MB = MB_;
    typedef f32x4 accm_t[2][2][MB_][2];
    int layer, rowbase;
    template <bool ACT, bool ST, bool QS = false> __device__ __forceinline__ void plain(accm_t& acc, const f32x4 (&bv)[2][2], bf16_t* dst, float* st, int row0, int colbase) const {
#pragma unroll
        for (int ai = 0; ai < 2; ++ai)
#pragma unroll
            for (int m = 0; m < MB_; ++m) { const int row = row0 + ai * (32 * MB_) + m * 16;
#pragma unroll
                for (int bj = 0; bj < 2; ++bj) { f32x4 v0 = acc[ai][bj][m][0] + bv[bj][0], v1 = acc[ai][bj][m][1] + bv[bj][1];
                    if (QS) { v0 = v0 * QSCALE; v1 = v1 * QSCALE; }
                    if (ST) { float* sp = st + ((size_t)((row >> 8) * 512 + layer * 256 + (row & 255))) * 512 + colbase + bj * 128; *(f32x4*)sp = v0; *(f32x4*)(sp + 4) = v1; }
                    if (ACT) {
#pragma unroll
                        for (int j = 0; j < 4; ++j) { v0[j] = silu_f(v0[j]); v1[j] = silu_f(v1[j]); } }
                    u32x4 w; w.x = cvt_pk_bf16(v0[0], v0[1]); w.y = cvt_pk_bf16(v0[2], v0[3]); w.z = cvt_pk_bf16(v1[0], v1[1]); w.w = cvt_pk_bf16(v1[2], v1[3]);
                    *(u32x4*)(dst + (size_t)row * 512 + colbase + bj * 128) = w; } }
    }
    __device__ __forceinline__ void operator()(accm_t& acc, const pg8::Unit& u, int wr, int wc, int fr, int fq) const {
        asm volatile("" : "+v"(fr), "+v"(fq));
        const int row0 = rowbase + u.pm * (64 * MB_) + wr * (16 * MB_) + fr, c8 = wc * 32 + 8 * fq, pn = u.pn;
        const bool ctxrows = rowbase + u.pm * (64 * MB_) < NCTX;
        unsigned char* wsb = kws();
        bf16_t* Q = (bf16_t*)(wsb + WS_Q); bf16_t* K = (bf16_t*)(wsb + WS_K); bf16_t* V = (bf16_t*)(wsb + WS_V); bf16_t* SZA = (bf16_t*)(wsb + WS_SZA); bf16_t* U = (bf16_t*)(wsb + WS_U);
        bf16_t* SZB = (bf16_t*)(wsb + WS_SZB); bf16_t* GR = (bf16_t*)(wsb + WS_GR); bf16_t* GB = (bf16_t*)(wsb + WS_GB);
        const int tr0 = rowbase + u.pm * (64 * MB_), tg = tr0 < NCTX ? 0 : 1 + ((tr0 - NCTX) >> 11);
        const float* bp = FU ? (const float*)(wsb + WS_CVEC) + tg * DIN + pn * 256 + c8 : (const float*)(wsb + WS_BIASP) + layer * DIN + pn * 256 + c8;
        if (FU) { const float* rss = (const float*)(wsb + WS_RSS); float rq[2][MB_];
#pragma unroll
            for (int ai = 0; ai < 2; ++ai)
#pragma unroll
                for (int m = 0; m < MB_; ++m) rq[ai][m] = rss[row0 + ai * (32 * MB_) + m * 16];
#pragma unroll
            for (int ai = 0; ai < 2; ++ai)
#pragma unroll
                for (int m = 0; m < MB_; ++m) { const float rs = rsqrtf(rq[ai][m] * (1.0f / D) + EPS);
#pragma unroll
                    for (int bj = 0; bj < 2; ++bj) { acc[ai][bj][m][0] = acc[ai][bj][m][0] * rs; acc[ai][bj][m][1] = acc[ai][bj][m][1] * rs; } } }
        float* stk = kout() + (size_t)M * D; float* stv = stk + (size_t)16 * 2 * 256 * 512;
        f32x4 bv[2][2];
#pragma unroll
        for (int bj = 0; bj < 2; ++bj)
#pragma unroll
            for (int n = 0; n < 2; ++n) bv[bj][n] = *(const f32x4*)(bp + bj * 128 + 4 * n);
        const int colbase = (pn & 1) * 256 + c8;
        if (pn < 2) plain<false, false, true>(acc, bv, Q, nullptr, row0, colbase);
        else if (pn < 4) { if (ctxrows) plain<false, true>(acc, bv, K, stk, row0, colbase); else plain<false, false>(acc, bv, K, nullptr, row0, colbase); }
        else if (pn < 6) { if (ctxrows) plain<false, true>(acc, bv, V, stv, row0, colbase); else plain<false, false>(acc, bv, V, nullptr, row0, colbase); }
        else if (pn < 8) plain<true, false>(acc, bv, SZA, nullptr, row0, colbase);
        else if (pn == 12 || pn == 13) plain<true, false>(acc, bv, SZB, nullptr, row0, colbase);
        else if (pn < 12) {
            const int cb = (pn - 8) * 128 + c8;
#pragma unroll
            for (int ai = 0; ai < 2; ++ai)
#pragma unroll
                for (int m = 0; m < MB_; ++m) { const int row = row0 + ai * (32 * MB_) + m * 16;
                    f32x4 a0 = acc[ai][0][m][0] + bv[0][0], a1 = acc[ai][0][m][1] + bv[0][1], b0 = acc[ai][1][m][0] + bv[1][0], b1 = acc[ai][1][m][1] + bv[1][1];
#pragma unroll
                    for (int j = 0; j < 4; ++j) { a0[j] *= sigmoid_f(b0[j]); a1[j] *= sigmoid_f(b1[j]); }
                    u32x4 w; w.x = cvt_pk_bf16(a0[0], a0[1]); w.y = cvt_pk_bf16(a0[2], a0[3]); w.z = cvt_pk_bf16(a1[0], a1[1]); w.w = cvt_pk_bf16(a1[2], a1[3]);
                    *(u32x4*)(U + (size_t)row * 512 + cb) = w; }
        } else {
            const int cb = (pn - 14) * 128 + c8;
#pragma unroll
            for (int ai = 0; ai < 2; ++ai)
#pragma unroll
                for (int m = 0; m < MB_; ++m) { const int row = row0 + ai * (32 * MB_) + m * 16;
                    f32x4 a0 = acc[ai][0][m][0] + bv[0][0], a1 = acc[ai][0][m][1] + bv[0][1], b0 = acc[ai][1][m][0] + bv[1][0], b1 = acc[ai][1][m][1] + bv[1][1];
                    f32x4 r0, r1, g0, g1;
#pragma unroll
                    for (int j = 0; j < 4; ++j) {
                        const float ea0 = __expf(-a0[j]), ea1 = __expf(-a1[j]), eb0 = fminf(__expf(-b0[j]), 1e30f), eb1 = fminf(__expf(-b1[j]), 1e30f);
                        g0[j] = __builtin_amdgcn_rcpf(1.0f + eb0); g1[j] = __builtin_amdgcn_rcpf(1.0f + eb1);
                        r0[j] = (1.0f + eb0) * __builtin_amdgcn_rcpf(1.0f + ea0); r1[j] = (1.0f + eb1) * __builtin_amdgcn_rcpf(1.0f + ea1); }
                    u32x4 w; w.x = cvt_pk_bf16(r0[0], r0[1]); w.y = cvt_pk_bf16(r0[2], r0[3]); w.z = cvt_pk_bf16(r1[0], r1[1]); w.w = cvt_pk_bf16(r1[2], r1[3]);
                    *(u32x4*)(GR + (size_t)row * 1024 + cb) = w;
                    w.x = cvt_pk_bf16(g0[0], g0[1]); w.y = cvt_pk_bf16(g0[2], g0[3]); w.z = cvt_pk_bf16(g1[0], g1[1]); w.w = cvt_pk_bf16(g1[2], g1[3]);
                    *(u32x4*)(GB + (size_t)row * 1024 + cb) = w; }
        }
    }
};

struct EpiProj {
    static constexpr bool PERM = true, SPLIT2 = false, MIDHOOK = true; static constexpr int MB = 3;
    __device__ __forceinline__ void mid(acc3_t& acc, const pg8::Unit& u, int wr, int wc, int fr, int fq) const {
        asm volatile("" : "+v"(fr), "+v"(fq));
        const int row0 = u.pm * 192 + wr * 48 + fr, col0 = u.pn * 256 + wc * 32 + 8 * fq;
        const bf16_t* G = WSP(bf16_t, WS_GR);
#pragma unroll
        for (int ai = 0; ai < 2; ++ai)
#pragma unroll
            for (int m = 0; m < 3; ++m) { const size_t off = (size_t)(row0 + ai * 96 + m * 16) * 1024 + col0;
#pragma unroll
                for (int bj = 0; bj < 2; ++bj) { const u32x4 w = *(const u32x4*)(G + off + bj * 128);
                    acc[ai][bj][m][0] = acc[ai][bj][m][0] * (f32x4){bflo(w.x), bfhi(w.x), bflo(w.y), bfhi(w.y)}; acc[ai][bj][m][1] = acc[ai][bj][m][1] * (f32x4){bflo(w.z), bfhi(w.z), bflo(w.w), bfhi(w.w)}; } }
    }
    __device__ __forceinline__ void operator()(acc3_t& acc, const pg8::Unit& u, int wr, int wc, int fr, int fq) const {
        asm volatile("" : "+v"(fr), "+v"(fq));
        const int row0 = u.pm * 192 + wr * 48 + fr, col0 = u.pn * 256 + wc * 32 + 8 * fq;
        unsigned char* wsb = kws();
        const bf16_t* G = (const bf16_t*)(wsb + WS_GB); bf16_t* Mo = (bf16_t*)(wsb + WS_H);
#pragma unroll
        for (int ai = 0; ai < 2; ++ai)
#pragma unroll
            for (int m = 0; m < 3; ++m) { const size_t off = (size_t)(row0 + ai * 96 + m * 16) * 1024 + col0;
#pragma unroll
                for (int bj = 0; bj < 2; ++bj) { const u32x4 w = *(const u32x4*)(G + off + bj * 128);
                    const f32x4 v0 = acc[ai][bj][m][0] * (f32x4){bflo(w.x), bfhi(w.x), bflo(w.y), bfhi(w.y)}, v1 = acc[ai][bj][m][1] * (f32x4){bflo(w.z), bfhi(w.z), bflo(w.w), bfhi(w.w)};
                    u32x4 o; o.x = cvt_pk_bf16(v0[0], v0[1]); o.y = cvt_pk_bf16(v0[2], v0[3]); o.z = cvt_pk_bf16(v1[0], v1[1]); o.w = cvt_pk_bf16(v1[2], v1[3]);
                    *(u32x4*)(Mo + off + bj * 128) = o; }
                asm volatile("" ::: "memory"); }
    }
};

template <bool LAST> struct EpiOutT {
    static constexpr bool PERM = true, SPLIT2 = false, MIDHOOK = false; static constexpr int MB = 3;
    int layer;
    __device__ __forceinline__ void operator()(acc3_t& acc, const pg8::Unit& u, int wr, int wc, int fr, int fq) const {
        asm volatile("" : "+v"(fr), "+v"(fq));
        const int row0 = u.pm * 192 + wr * 48 + fr, col0 = u.pn * 256 + wc * 32 + 8 * fq;
        const float* modl = WSP(float, WS_MOD) + layer * 5 * 3072 + 2048 + col0;
        const float* xp = kin(I_X_PROMPT); const float* xs = kin(I_X_SAMPLE) - (size_t)NCTX * D;
        bf16_t* X1 = WSP(bf16_t, WS_X1); bf16_t* XG = WSP(bf16_t, WS_YAB);
        float* rss = WSP(float, LAST ? WS_RSS2 : WS_RSS);
        const float* gfin = kin(I_FINAL_G) + col0;
        float olds[6];
#pragma unroll
        for (int ai = 0; ai < 2; ++ai)
#pragma unroll
            for (int m = 0; m < 3; ++m) { const int row = row0 + ai * 96 + m * 16; const size_t off = (size_t)row * D + col0;
                const int g = row < NCTX ? 0 : 1 + ((row - NCTX) >> 11);
                const float* gate = modl + g * 3072; const float* xin = row < NCTX ? xp : xs;
                float ssq = 0.f;
#pragma unroll
                for (int bj = 0; bj < 2; ++bj) { const size_t o_ = off + bj * 128;
                    const f32x4 gv0 = *(const f32x4*)(gate + bj * 128), gv1 = *(const f32x4*)(gate + bj * 128 + 4);
                    f32x4 xi0, xi1;
                    if (LAST) { const u32x4 xw = *(const u32x4*)(X1 + o_); xi0 = (f32x4){bflo(xw.x), bfhi(xw.x), bflo(xw.y), bfhi(xw.y)}; xi1 = (f32x4){bflo(xw.z), bfhi(xw.z), bflo(xw.w), bfhi(xw.w)}; }
                    else { xi0 = *(const f32x4*)(xin + o_); xi1 = *(const f32x4*)(xin + o_ + 4); }
                    const f32x4 xn0 = xi0 + gv0 * acc[ai][bj][m][0], xn1 = xi1 + gv1 * acc[ai][bj][m][1];
                    ssq += ((xn0[0] * xn0[0] + xn0[1] * xn0[1]) + (xn0[2] * xn0[2] + xn0[3] * xn0[3])) + ((xn1[0] * xn1[0] + xn1[1] * xn1[1]) + (xn1[2] * xn1[2] + xn1[3] * xn1[3]));
                    const float* gmp = LAST ? gfin + bj * 128 : WSP(float, WS_GM) + g * 1024 + col0 + bj * 128;
                    const f32x4 y0 = xn0 * *(const f32x4*)gmp, y1 = xn1 * *(const f32x4*)(gmp + 4);
                    if (LAST) { acc[ai][bj][m][0] = y0; acc[ai][bj][m][1] = y1; }
                    else { u32x4 w; w.x = cvt_pk_bf16(y0[0], y0[1]); w.y = cvt_pk_bf16(y0[2], y0[3]); w.z = cvt_pk_bf16(y1[0], y1[1]); w.w = cvt_pk_bf16(y1[2], y1[3]);
                        *(u32x4*)(XG + o_) = w;
                        u32x4 xw; xw.x = cvt_pk_bf16(xn0[0], xn0[1]); xw.y = cvt_pk_bf16(xn0[2], xn0[3]); xw.z = cvt_pk_bf16(xn1[0], xn1[1]); xw.w = cvt_pk_bf16(xn1[2], xn1[3]);
                        *(u32x4*)(X1 + o_) = xw; } }
                ssq += __shfl_xor(ssq, 16); ssq += __shfl_xor(ssq, 32);
                float o = 0.f;
                if (LAST) { if (fq == 0) o = __hip_atomic_fetch_add(rss + row, ssq, __ATOMIC_RELAXED, __HIP_MEMORY_SCOPE_AGENT); }
                else { if (fq == 0) (void)__hip_atomic_fetch_add(rss + row, ssq, __ATOMIC_RELAXED, __HIP_MEMORY_SCOPE_AGENT); }
                olds[ai * 3 + m] = o;
                asm volatile("" ::: "memory"); }
        if constexpr (LAST) {
            asm volatile("" :: "v"(olds[0]), "v"(olds[1]), "v"(olds[2]), "v"(olds[3]), "v"(olds[4]), "v"(olds[5]));
            asm volatile("s_waitcnt vmcnt(0)" ::: "memory");
            __syncthreads();
            if (fresh_tid() == 0) { unsigned* cnt = WSP(unsigned, WS_CTL) + CW_ROWBLK + u.pm * 16;
                (void)__hip_atomic_fetch_add(cnt, 1u, __ATOMIC_RELAXED, __HIP_MEMORY_SCOPE_AGENT);
                unsigned sp = 0; while (__hip_atomic_load(cnt, __ATOMIC_RELAXED, __HIP_MEMORY_SCOPE_AGENT) < 4u) { __builtin_amdgcn_s_sleep(1); if (++sp > (1u << 22)) break; } }
            __syncthreads();
            float* out = kout();
            float sq[6];
#pragma unroll
            for (int k = 0; k < 6; ++k) sq[k] = __hip_atomic_load(rss + row0 + (k / 3) * 96 + (k % 3) * 16, __ATOMIC_RELAXED, __HIP_MEMORY_SCOPE_AGENT);
#pragma unroll
            for (int ai = 0; ai < 2; ++ai)
#pragma unroll
                for (int m = 0; m < 3; ++m) { const int row = row0 + ai * 96 + m * 16; float* yr = out + (size_t)row * D + col0;
                    const float rstd = rsqrtf(sq[ai * 3 + m] * (1.f / D) + EPS);
#pragma unroll
                    for (int bj = 0; bj < 2; ++bj) { *(f32x4*)(yr + bj * 128) = acc[ai][bj][m][0] * rstd; *(f32x4*)(yr + bj * 128 + 4) = acc[ai][bj][m][1] * rstd; } }
        }
    }
};

#define XB_TMO      128
#define XB_XCNT(j)  (256  + 64 * (j))
#define XB_XSUB(j)  (1280 + 64 * (j))
#define XB_XGEN(j)  (2304 + 64 * (j))
#define XB_TOP      3328
#define XB_TOPGEN   3392
#define XCD_BAR_WORDS 3456
#define XB_SPIN_CAP (1u << 18)
__device__ __forceinline__ unsigned xb_ld(unsigned* p)              { return __hip_atomic_load(p, __ATOMIC_RELAXED, __HIP_MEMORY_SCOPE_AGENT); }
__device__ __forceinline__ unsigned xb_add(unsigned* p, unsigned v) { return __hip_atomic_fetch_add(p, v, __ATOMIC_RELAXED, __HIP_MEMORY_SCOPE_AGENT); }
__device__ __forceinline__ unsigned xb_xcc_id() { return (unsigned)__builtin_amdgcn_s_getreg((3 << 11) | 20) & 0xFu; }
#define XB_SPIN(cond, bar) do { unsigned _sp = 0; while (cond) { __builtin_amdgcn_s_sleep(1); \
    if ((++_sp & 255u) == 0u) { if (xb_ld(&(bar)[XB_TMO])) break; if (_sp > XB_SPIN_CAP) { atomicAdd(&(bar)[XB_TMO], 1u); break; } } } } while (0)
struct XcdBarrier { unsigned* bar; unsigned x; volatile LAS unsigned* st; };
__device__ __forceinline__ XcdBarrier xcd_barrier_post(unsigned* bar, volatile LAS unsigned* st) {
    XcdBarrier b; b.bar = bar; b.x = xb_xcc_id(); b.st = st;
    if (threadIdx.x == 0) (void)xb_add(&bar[XB_XCNT(b.x)], 1u);
    return b;
}
__device__ __forceinline__ void xcd_barrier_complete(unsigned* bar, unsigned x, unsigned& nloc, unsigned& nx) {
    const unsigned G = gridDim.x * gridDim.y * gridDim.z;
    unsigned sum, cnt, mine, sp = 0u;
    for (;;) {
        sum = 0u; cnt = 0u; mine = 0u;
#pragma unroll
        for (unsigned j = 0; j < 16; ++j) { const unsigned c = xb_ld(&bar[XB_XCNT(j)]); sum += c; cnt += (c > 0u) ? 1u : 0u; mine = (j == x) ? c : mine; }
        if (sum == G) break;
        __builtin_amdgcn_s_sleep(1);
        if ((++sp & 255u) == 0u) { if (xb_ld(&bar[XB_TMO])) break; if (sp > XB_SPIN_CAP) { atomicAdd(&bar[XB_TMO], 1u); break; } }
    }
    nloc = mine > 0u ? mine : 1u; nx = cnt > 0u ? cnt : 1u;
}
__device__ __forceinline__ void xcd_barrier(const XcdBarrier& b) {
    asm volatile("s_waitcnt vmcnt(0)" ::: "memory");
    __syncthreads();
    if (fresh_tid() == 0) {
        unsigned* bar = b.bar;
        __builtin_amdgcn_s_waitcnt(0);
        unsigned nloc = b.st[0], nx = b.st[1];
        if (nloc == 0u) { xcd_barrier_complete(bar, b.x, nloc, nx); b.st[0] = nloc; b.st[1] = nx; }
        const unsigned old = xb_add(&bar[XB_XSUB(b.x)], 1u);
        const unsigned gen = old / nloc;
        if (old + 1u == (gen + 1u) * nloc) {
            __builtin_amdgcn_fence(__ATOMIC_RELEASE, "agent");
            asm volatile("s_waitcnt vmcnt(0)" ::: "memory");
            const unsigned og = xb_add(&bar[XB_TOP], 1u);
            const unsigned tg = og / nx;
            if (og + 1u == (tg + 1u) * nx) xb_add(&bar[XB_TOPGEN], 1u);
            else XB_SPIN(xb_ld(&bar[XB_TOPGEN]) == tg, bar);
            __builtin_amdgcn_fence(__ATOMIC_ACQUIRE, "agent");
            xb_add(&bar[XB_XGEN(b.x)], 1u);
            asm volatile("s_waitcnt vmcnt(0)" ::: "memory");
        } else {
            XB_SPIN(xb_ld(&bar[XB_XGEN(b.x)]) == gen, bar);
            __builtin_amdgcn_fence(__ATOMIC_ACQUIRE, "agent");
            asm volatile("s_waitcnt vmcnt(0)" ::: "memory");
        }
    }
    __syncthreads();
}

struct Frame {
    LAS unsigned char* lds;
    int tid, lane, wave, G, bx;
};


__device__ __forceinline__ int in_srccol(int n) {
    const int tile = n >> 8, r = n & 255;
    if (tile < 8 || tile == 12 || tile == 13) return n;
    if (tile < 12) { const int i = tile - 8; return (r < 128 ? 2048 : 2560) + 128 * i + (r & 127); }
    const int i = tile - 14; return (r < 128 ? 3584 : 4608) + 128 * i + (r & 127);
}

__device__ __forceinline__ void transpose_item(const float* W, int ldw, int srccol0, int k0, bf16_t* WT, int dstrow0, int dstk0, LAS float* scr, int lane) {
    float tv[32];
#pragma unroll
    for (int i = 0; i < 32; ++i) { const int kk = 2 * i + (lane >> 5); tv[i] = W[(size_t)(k0 + kk) * ldw + srccol0 + (lane & 31)]; }
#pragma unroll
    for (int i = 0; i < 32; ++i) { const int kk = 2 * i + (lane >> 5); scr[kk * 33 + (lane & 31)] = tv[i]; }
    LDS_WAIT(); asm volatile("" ::: "memory");
    const int c = lane & 7;
#pragma unroll
    for (int j = 0; j < 4; ++j) { const int n = (lane >> 3) + 8 * j; const LAS float* s = scr + (8 * c) * 33 + n;
        u32x4 o; o.x = pk2(s[0 * 33], s[1 * 33]); o.y = pk2(s[2 * 33], s[3 * 33]); o.z = pk2(s[4 * 33], s[5 * 33]); o.w = pk2(s[6 * 33], s[7 * 33]);
        *(GAS u32x4*)(WT + (size_t)(dstrow0 + n) * 1024 + dstk0 + 8 * c) = o; }
    LDS_WAIT(); asm volatile("" ::: "memory");
}

__device__ __forceinline__ void mod_task(Frame& F, int t) {
    const int l = t / 48, j0 = (t % 48) * 64;
    const float* c_ctx = kin(I_C_CTX); const float* cvec = kin(I_C); const float* w_ada = kin(I_W_ADA); const float* b_ada = kin(I_B_ADA); float* MOD = WSP(float, WS_MOD);
    LAS float* sv = (LAS float*)F.lds;
    LAS float* part = (LAS float*)(F.lds + 20480);
    for (int i = F.tid; i < 5 * 1024; i += 512) { const int g = i >> 10, k = i & 1023; const float c = (g == 0) ? c_ctx[k] : cvec[(g - 1) * 1024 + k]; sv[i] = silu_f(c); }
    __syncthreads();
    const float* W = w_ada + (size_t)l * 1024 * 3072 + (size_t)(128 * F.wave) * 3072 + j0 + F.lane;
    float a0 = 0.f, a1 = 0.f, a2 = 0.f, a3 = 0.f, a4 = 0.f;
#pragma unroll 32
    for (int kk = 0; kk < 128; ++kk) { const float wv = W[(size_t)kk * 3072]; const int k = 128 * F.wave + kk;
        a0 += sv[k] * wv; a1 += sv[1024 + k] * wv; a2 += sv[2048 + k] * wv; a3 += sv[3072 + k] * wv; a4 += sv[4096 + k] * wv; }
    part[(F.wave * 5 + 0) * 64 + F.lane] = a0; part[(F.wave * 5 + 1) * 64 + F.lane] = a1; part[(F.wave * 5 + 2) * 64 + F.lane] = a2;
    part[(F.wave * 5 + 3) * 64 + F.lane] = a3; part[(F.wave * 5 + 4) * 64 + F.lane] = a4;
    __syncthreads();
    if (F.tid < 320) { const int g = F.tid >> 6, ln = F.tid & 63; float s = 0.f;
#pragma unroll
        for (int w = 0; w < 8; ++w) s += part[(w * 5 + g) * 64 + ln];
        MOD[(l * 5 + g) * 3072 + j0 + ln] = s + b_ada[l * 3072 + j0 + ln]; }
    __syncthreads();
}

__device__ __forceinline__ void wt_items(Frame& F, int l, int w0, int nw);
__device__ __forceinline__ void p0_prologue(Frame& F) {
    if (F.bx < 96) mod_task(F, F.bx);
    const int gw = F.bx * 8 + F.wave, NGW = F.G * 8;
    const int gt = F.bx * 512 + F.tid, NGT = F.G * 512;
    { float* BIASP = WSP(float, WS_BIASP); const float* b_in = kin(I_B_IN);
      for (int i = gt; i < DEPTH * DIN; i += NGT) { const int l = i / DIN, n = i % DIN; BIASP[i] = b_in[l * DIN + in_srccol(n)]; } }
    const float* cache_k = kin(I_CACHE_K); const float* cache_v = kin(I_CACHE_V); bf16_t* CK = WSP(bf16_t, WS_CK); bf16_t* CV = WSP(bf16_t, WS_CV);
    for (int i0 = gt; i0 < 2 * 131072; i0 += 2 * NGT) { f32x4 a[2], b[2];
#pragma unroll
        for (int k = 0; k < 2; ++k) { const int i = i0 + k * NGT; if (i < 2 * 131072) { const int which = i >> 17, e = (i & 131071) * 8; const float* src = (which ? cache_v : cache_k) + e; a[k] = *(const f32x4*)src; b[k] = *(const f32x4*)(src + 4); } }
#pragma unroll
        for (int k = 0; k < 2; ++k) { const int i = i0 + k * NGT; if (i < 2 * 131072) { const int which = i >> 17, e = (i & 131071) * 8; bf16_t* dst = (which ? CV : CK) + e;
            u32x4 w; w.x = pk2(a[k][0], a[k][1]); w.y = pk2(a[k][2], a[k][3]); w.z = pk2(b[k][0], b[k][1]); w.w = pk2(b[k][2], b[k][3]); *(u32x4*)dst = w; } } }
    wt_items(F, 0, gw, NGW);
    { const int nidle = F.G - (M - 46 * 256) / 128 * (DIN / 256); if (nidle <= 0) wt_items(F, 1, gw, NGW); }
}

__device__ __forceinline__ void wt_items(Frame& F, int l, int w0, int nw) {
    LAS float* scr = (LAS float*)(F.lds + F.wave * 16384);
    const float* w_in = kin(I_W_IN); const float* w_proj_a = kin(I_W_PROJ_A); const float* w_proj_b = kin(I_W_PROJ_B); const float* w_out = kin(I_W_OUT);
    bf16_t* WTIN = WSP(bf16_t, WS_WTIN); bf16_t* WTPROJ = WSP(bf16_t, WS_WTPROJ); bf16_t* WTOUT = WSP(bf16_t, WS_WTOUT);
    constexpr int I_IN = 16 * 176, I_P = 8 * 32, I_O = 16 * 32, I_L = I_IN + 2 * I_P + I_O;
    for (int it = w0; it < I_L; it += nw) {
        int r = it;
        if (r < I_IN) { const int kb = r / 176, nb = r % 176; transpose_item(w_in + (size_t)l * D * DIN, DIN, in_srccol(32 * nb), 64 * kb, WTIN + (size_t)l * DIN * D, 32 * nb, 64 * kb, scr, F.lane); continue; } r -= I_IN;
        if (r < I_P) { const int kb = r / 32, nb = r % 32; transpose_item(w_proj_a + (size_t)l * 512 * D, D, 32 * nb, 64 * kb, WTPROJ + (size_t)l * D * D, 32 * nb, 64 * kb, scr, F.lane); continue; } r -= I_P;
        if (r < I_P) { const int kb = r / 32, nb = r % 32; transpose_item(w_proj_b + (size_t)l * 512 * D, D, 32 * nb, 64 * kb, WTPROJ + (size_t)l * D * D, 32 * nb, 512 + 64 * kb, scr, F.lane); continue; } r -= I_P;
        { const int kb = r / 32, nb = r % 32; transpose_item(w_out + (size_t)l * D * D, D, 32 * nb, 64 * kb, WTOUT + (size_t)l * D * D, 32 * nb, 64 * kb, scr, F.lane); }
    }
}

__device__ __forceinline__ void norm_phase(Frame& F, int layer) {
    const int gw = F.bx * 8 + F.wave, NGW = F.G * 8;
    const float* xa = layer == 0 ? kin(I_X_PROMPT) : kout(); const float* xb = layer == 0 ? kin(I_X_SAMPLE) : kout() + (size_t)NCTX * D;
    const float* MOD = WSP(float, WS_MOD); const float* rms_g = kin(I_RMS_G) + layer * D; bf16_t* H = WSP(bf16_t, WS_H);
    for (int rb = gw; rb < M; rb += 3 * NGW) {
        f32x4 v[3][4];
#pragma unroll
        for (int k = 0; k < 3; ++k) { const int r = rb + k * NGW; if (r < M) {
            const float* xrow = r < NCTX ? xa + (size_t)r * D : xb + (size_t)(r - NCTX) * D; const f32x4* xr = (const f32x4*)xrow + F.lane;
#pragma unroll
            for (int j = 0; j < 4; ++j) v[k][j] = xr[64 * j]; } }
#pragma unroll
        for (int k = 0; k < 3; ++k) { const int r = rb + k * NGW; if (r < M) {
            const int g = r < NCTX ? 0 : 1 + ((r - NCTX) >> 11);
            const float* mod = MOD + (layer * 5 + g) * 3072;
            float s = 0.f;
#pragma unroll
            for (int j = 0; j < 4; ++j) s += (v[k][j][0] * v[k][j][0] + v[k][j][1] * v[k][j][1]) + (v[k][j][2] * v[k][j][2] + v[k][j][3] * v[k][j][3]);
            const float rstd = rsqrtf(wave_sum(s) * (1.f / D) + EPS);
            unsigned long long* o8 = (unsigned long long*)(H + (size_t)r * D) + F.lane;
#pragma unroll
            for (int j = 0; j < 4; ++j) { const int c = 4 * F.lane + 256 * j;
                const f32x4 gg = *(const f32x4*)(rms_g + c), sh = *(const f32x4*)(mod + c), sc = *(const f32x4*)(mod + 1024 + c);
                const f32x4 y = v[k][j] * rstd * gg * (sc + 1.0f) + sh;
                o8[64 * j] = (unsigned long long)cvt_pk_bf16(y[0], y[1]) | ((unsigned long long)cvt_pk_bf16(y[2], y[3]) << 32); } } }
    }
}

struct AttnPre { u32x4 qrow[4], pa0, pc0, pa1, kreg, vreg, kreg2, vreg2; float bvv[8]; };
__device__ __forceinline__ void attn_prefetch(Frame& F, int layer, int task, const bool ctx, AttnPre& P);
__device__ __forceinline__ void conv_task(Frame& F, int layer, int tile, AttnPre& pre, int pre_task) {
    const int t0 = tile * 32;
    int s0, s1; if (t0 < NCTX) { s0 = t0 & ~255; s1 = s0 + 256; } else { s0 = NCTX + ((t0 - NCTX) & ~2047); s1 = s0 + 2048; }
    const bf16_t* Ub = WSP(bf16_t, WS_U); const bf16_t* SZB = WSP(bf16_t, WS_SZB); bf16_t* YAB = WSP(bf16_t, WS_YAB);
    const float* dw_w = kin(I_DW_W); const float* dw_b = kin(I_DW_B); const float* ln_g = kin(I_LN_G) + layer * 512; const float* ln_b = kin(I_LN_B) + layer * 512;
    LAS unsigned* Ul = (LAS unsigned*)F.lds;
    LAS float* Cl = (LAS float*)(F.lds + 62 * 1024);
    u32x4 xs[8];
#pragma unroll
    for (int k = 0; k < 8; ++k) { const int i = F.tid + 512 * k; const int lr = i >> 6, ch = i & 63; const int t = t0 - 15 + lr; xs[k] = (u32x4){0u, 0u, 0u, 0u};
        if (i < 62 * 64 && t >= s0 && t < s1) xs[k] = *(const u32x4*)(Ub + (size_t)t * 512 + ch * 8); }
    const int cp = F.tid & 255, th = F.tid >> 8;
    float w0[31], w1[31];
#pragma unroll
    for (int j = 0; j < 31; ++j) { const f32x2 w = *(const f32x2*)(dw_w + (size_t)(layer * 31 + j) * 512 + 2 * cp); w0[j] = w[0]; w1[j] = w[1]; }
    const f32x2 bb = *(const f32x2*)(dw_b + layer * 512 + 2 * cp);
    u32x2 zq[4][2];
#pragma unroll
    for (int k = 0; k < 4; ++k) { const int t = t0 + F.wave * 4 + k; zq[k][0] = *(const u32x2*)(SZB + (size_t)t * 512 + 4 * F.lane); zq[k][1] = *(const u32x2*)(SZB + (size_t)t * 512 + 256 + 4 * F.lane); }
#pragma unroll
    for (int k = 0; k < 8; ++k) { const int i = F.tid + 512 * k; if (i < 62 * 64) *(LAS u32x4*)(Ul + (i >> 6) * 256 + (i & 63) * 4) = xs[k]; }
    __syncthreads();
    {
        for (int blk = 0; blk < 4; ++blk) { const int tt0 = th * 16 + blk * 4;
            float a0[4], a1[4];
#pragma unroll
            for (int o = 0; o < 4; ++o) { a0[o] = bb[0]; a1[o] = bb[1]; }
#pragma unroll
            for (int i = 0; i < 34; ++i) { const unsigned x = Ul[(tt0 + i) * 256 + cp]; const float x0 = bflo(x), x1 = bfhi(x);
#pragma unroll
                for (int o = 0; o < 4; ++o) { const int j = i - o; if (j >= 0 && j < 31) { a0[o] += w0[j] * x0; a1[o] += w1[j] * x1; } } }
#pragma unroll
            for (int o = 0; o < 4; ++o) *(LAS f32x2*)(Cl + (tt0 + o) * 512 + 2 * cp) = (f32x2){a0[o], a1[o]};
        }
    }
    __syncthreads();
    const f32x4 g0 = *(const f32x4*)(ln_g + 4 * F.lane), g1 = *(const f32x4*)(ln_g + 256 + 4 * F.lane);
    const f32x4 b0 = *(const f32x4*)(ln_b + 4 * F.lane), b1 = *(const f32x4*)(ln_b + 256 + 4 * F.lane);
    asm volatile("" ::: "memory");
    if (pre_task >= 0) attn_prefetch(F, layer, pre_task, false, pre);
    asm volatile("" ::: "memory");
#pragma unroll
    for (int k = 0; k < 4; ++k) { const int tt = F.wave * 4 + k, t = t0 + tt;
        f32x4 v0 = *(LAS f32x4*)(Cl + tt * 512 + 4 * F.lane), v1 = *(LAS f32x4*)(Cl + tt * 512 + 256 + 4 * F.lane);
        const float mean = wave_sum((v0[0] + v0[1]) + (v0[2] + v0[3]) + (v1[0] + v1[1]) + (v1[2] + v1[3])) * (1.f / 512.f);
        v0 = v0 - mean; v1 = v1 - mean;
        const float var = wave_sum((v0[0] * v0[0] + v0[1] * v0[1]) + (v0[2] * v0[2] + v0[3] * v0[3]) + (v1[0] * v1[0] + v1[1] * v1[1]) + (v1[2] * v1[2] + v1[3] * v1[3])) * (1.f / 512.f);
        const float rstd = rsqrtf(var + EPS);
        f32x4 y0 = v0 * rstd * g0 + b0, y1 = v1 * rstd * g1 + b1;
        const u32x2 z0 = zq[k][0], z1 = zq[k][1];
        const f32x4 zz0 = (f32x4){bflo(z0.x), bfhi(z0.x), bflo(z0.y), bfhi(z0.y)}, zz1 = (f32x4){bflo(z1.x), bfhi(z1.x), bflo(z1.y), bfhi(z1.y)};
#pragma unroll
        for (int j = 0; j < 4; ++j) { y0[j] = silu_f(y0[j]) * zz0[j]; y1[j] = silu_f(y1[j]) * zz1[j]; }
        u32x2 o0, o1; o0.x = cvt_pk_bf16(y0[0], y0[1]); o0.y = cvt_pk_bf16(y0[2], y0[3]); o1.x = cvt_pk_bf16(y1[0], y1[1]); o1.y = cvt_pk_bf16(y1[2], y1[3]);
        *(u32x2*)(YAB + (size_t)t * 1024 + 512 + 4 * F.lane) = o0; *(u32x2*)(YAB + (size_t)t * 1024 + 768 + 4 * F.lane) = o1;
    }
    __syncthreads();
}

typedef float f32x16 __attribute__((ext_vector_type(16)));
typedef short s16x4 __attribute__((ext_vector_type(4)));
typedef __bf16 bf16x2_t __attribute__((ext_vector_type(2)));
__device__ __forceinline__ unsigned cvtpk_s(float lo, float hi) { f32x2 v = {lo, hi}; bf16x2_t b = __builtin_convertvector(v, bf16x2_t); return __builtin_bit_cast(unsigned, b); }
__device__ __forceinline__ s16x4 vtr(const LAS char* p) { return __builtin_bit_cast(s16x4, __builtin_amdgcn_ds_read_tr16_b64_v4i16((LAS s16x4*)p)); }
#define MFMA32(a, b, c) __builtin_amdgcn_mfma_f32_32x32x16_bf16((a), (b), (c), 0, 0, 0)
constexpr float LOG2E = 1.4426950408889634f;
constexpr float ATT_QSCALE = 0.125f * LOG2E;
constexpr int AT_SLOTB = 8192, AT_K = 0, AT_V = 3 * AT_SLOTB, AT_TBL = 6 * AT_SLOTB;
constexpr int AT_VSTRIDE = 68, AT_ROWF = 16 * AT_VSTRIDE + 52, AT_INF = AT_TBL + 15 * AT_ROWF * 4, AT_ZERO = AT_INF + 512, AT_END = AT_ZERO + 512;
static_assert(AT_END <= RING_BYTES, "attention LDS");
constexpr float ATT_THR = 8.0f;

#define ATT_DECODE() \
    int b, h, R0, r = 0, n_win = 0, lo = 0, qc = 0, r0 = 0; \
    if (!ctx) { const int R = 4 * (task & 7); h = (task >> 3) & 7; b = task >> 6; r = R + (wid >> 1); const int HALF = wid & 1; \
        R0 = NCTX + b * 2048 + r * 64 + HALF * 32; qc = HALF * 32 + r32; r0 = min(max(r - 4, 0), 24); \
        lo = min(max(R - 4, 0), 24); n_win = min(max(R - 1, 0), 24) + 8 - lo; \
    } else { h = task & 7; b = task >> 3; R0 = b * 256 + wid * 32; } \
    const int NT = n_win + 4; (void)qc; (void)r0; (void)r; (void)NT; \
    const unsigned ksoff = (unsigned)(lane * 512 + wid * 8), vsoff = (unsigned)((16 * (wid & 3) + (lane >> 2)) * 512 + (wid >> 2) * 32 + (lane & 3) * 8);
#define ATT_SRC(t, KP, VP) do { if ((t) < n_win) { const size_t o_ = (size_t)(NCTX + b * 2048 + (lo + (t)) * 64) * 512 + h * 64; KP = (const bf16_t*)(wsb + WS_K) + o_; VP = (const bf16_t*)(wsb + WS_V) + o_; } \
        else if (ctx) { const size_t o_ = (size_t)(b * 256 + ((t) - n_win) * 64) * 512 + h * 64; KP = (const bf16_t*)(wsb + WS_K) + o_; VP = (const bf16_t*)(wsb + WS_V) + o_; } \
        else { const size_t o_ = ((size_t)((b * 2 + layer) * 256 + ((t) - n_win) * 64)) * 512 + h * 64; KP = (const bf16_t*)(wsb + WS_CK) + o_; VP = (const bf16_t*)(wsb + WS_CV) + o_; } } while (0)
__device__ __forceinline__ void attn_prefetch(Frame& F, int layer, int task, const bool ctx, AttnPre& P) {
    const int tid = fresh_tid(), lane = tid & 63, r32 = lane & 31, wid = __builtin_amdgcn_readfirstlane(tid >> 6);
    unsigned char* wsb = kws();
    ATT_DECODE()
    { const bf16_t* qp = (const bf16_t*)(wsb + WS_Q) + (size_t)(R0 + (lane >> 3)) * 512 + h * 64 + (lane & 7) * 8;
#pragma unroll
      for (int i = 0; i < 4; ++i) P.qrow[i] = *(const u32x4*)(qp + (size_t)i * 8 * 512); }
    { const bf16_t *k0, *v0, *k1, *v1, *k2, *v2, *k3, *v3; ATT_SRC(0, k0, v0); ATT_SRC(1, k1, v1); ATT_SRC(2, k2, v2); ATT_SRC(3, k3, v3); (void)v3;
      P.pa0 = *(const u32x4*)(k0 + ksoff); P.pc0 = *(const u32x4*)(v0 + vsoff); P.pa1 = *(const u32x4*)(k1 + ksoff);
      P.kreg = *(const u32x4*)(k2 + ksoff); P.vreg = *(const u32x4*)(v1 + vsoff); P.kreg2 = *(const u32x4*)(k3 + ksoff); P.vreg2 = *(const u32x4*)(v2 + vsoff); }
    if (!ctx) { const float* rb = kin(I_REL_BIAS) + (size_t)(layer * 8 + h) * 465;
#pragma unroll
        for (int k = 0; k < 8; ++k) { const int i = tid + 512 * k, dr = i >> 8, v = (i >> 4) & 15, j = i & 15; P.bvv[k] = (i < 3840) ? rb[dr * 31 + v + j] : 0.f; } }
}

__device__ __forceinline__ void attn_wg(Frame& F, int layer, int task, const bool ctx, AttnPre& P, int next_ctx) {
    const int tid = fresh_tid(), lane = tid & 63, r32 = lane & 31, hi = lane >> 5, wid = __builtin_amdgcn_readfirstlane(tid >> 6);
    LAS char* L = (LAS char*)F.lds;
    unsigned char* wsb = kws();
    ATT_DECODE()
    const int kdst = AT_K + wid * 1024 + lane * 16, vdst = AT_V + wid * 1024 + lane * 16;
    u32x4 kreg = P.kreg, vreg = P.vreg, kreg2 = P.kreg2, vreg2 = P.vreg2;
    bf16x8 qr[4];
    { LAS char* stg = L + AT_TBL + wid * 4608; LAS char* srow = stg + (lane >> 3) * 144 + (lane & 7) * 16;
#pragma unroll
      for (int i = 0; i < 4; ++i) *(LAS u32x4*)(srow + i * 8 * 144) = P.qrow[i];
      asm volatile("s_waitcnt lgkmcnt(0)" ::: "memory");
#pragma unroll
      for (int s_ = 0; s_ < 4; ++s_) qr[s_] = *(const LAS bf16x8*)(stg + r32 * 144 + hi * 16 + s_ * 32);
      asm volatile("s_waitcnt lgkmcnt(0)" ::: "memory"); }
    { unsigned zz = 0u; asm volatile("" : "+v"(zz));
      if (tid < 32) *(LAS u32x4*)(L + AT_ZERO + 16 * tid) = (u32x4){zz, zz, zz, zz}; }
    if (!ctx) { unsigned ninf = 0xff800000u; asm volatile("" : "+v"(ninf));
        for (int i = lane; i < 4608 / 16; i += 64) *(LAS u32x4*)(L + AT_TBL + wid * 4608 + 16 * i) = (u32x4){ninf, ninf, ninf, ninf};
        for (int i = 8 * 4608 / 16 + tid; i < (AT_ZERO - AT_TBL) / 16; i += 512) *(LAS u32x4*)(L + AT_TBL + 16 * i) = (u32x4){ninf, ninf, ninf, ninf}; }
    *(LAS u32x4*)(L + kdst) = P.pa0; *(LAS u32x4*)(L + vdst) = P.pc0; *(LAS u32x4*)(L + AT_SLOTB + kdst) = P.pa1;
    if (!ctx) {
        asm volatile("s_waitcnt lgkmcnt(0)\n\ts_barrier" ::: "memory");
#pragma unroll
        for (int k = 0; k < 8; ++k) { const int i = tid + 512 * k, dr = i >> 8, v = (i >> 4) & 15, j = i & 15; if (i < 3840) *(LAS float*)(L + AT_TBL + (dr * AT_ROWF + v * AT_VSTRIDE + 48 + j) * 4) = P.bvv[k] * LOG2E; }
    }
    const int HALFW = ctx ? 0 : (wid & 1);
    const LAS char* kpA = L + AT_K + hi * 1024 + (32 * HALFW + r32) * 16;
    const LAS char* kpB = L + AT_K + hi * 1024 + (32 * (1 - HALFW) + ((r32 + 24 * HALFW) & 31)) * 16;
    const LAS char* vp0 = L + AT_V + ((lane >> 4) & 1) * 32 + (lane & 3) * 8 + (4 * hi + ((lane & 15) >> 2)) * 64;
    const int H2 = HALFW * 2048, O2 = (1 - HALFW) * 2048, rot = 3 * HALFW;
    const int vol0 = H2, voh0 = H2 + 512, vol1 = H2 + 1024, voh1 = H2 + 1536;
    const int vol2 = O2 + ((0 + rot) & 3) * 512, voh2 = O2 + ((1 + rot) & 3) * 512, vol3 = O2 + ((2 + rot) & 3) * 512, voh3 = O2 + ((3 + rot) & 3) * 512;
    const int vsh = (qc < 8 ? 8 - qc : (qc > 56 ? 56 - qc : 0)) + 7;
    const int tlane = AT_TBL + (67 * vsh + 4 * hi - qc + 63) * 4;
    const int offA = 128 * HALFW, offB = HALFW ? 96 : 128;
    const int NWP = n_win + ((n_win > 0 && ((n_win - 1) & 1)) ? 1 : 0), NTV = NWP + 4;
#define VT(t) ((t) < n_win ? (t) : ((t) < NWP ? n_win - 1 : (t) - (NWP - n_win)))
    float mhat = -INFINITY, l_reg = 0.f, fres = 1.f; bool resc = false;
    f32x16 o0, o1;
#pragma unroll
    for (int i = 0; i < 16; ++i) { o0[i] = 0.f; o1[i] = 0.f; }
    f32x16 pA0, pA1, pB0, pB1; bf16x8 kf[8]; s16x4 vlo[8], vhi[8]; u32x4 pw0, pw1, pw2, pw3;
#pragma unroll
    for (int i = 0; i < 16; ++i) { pA1[i] = 0.f; pB1[i] = 0.f; }
    int sl_prev = 0, sl_cur = 0, sl_next = AT_SLOTB;
#define SBAR() __builtin_amdgcn_sched_barrier(0)
#define PIN(x) asm volatile("" : "+v"(x))
#define WBAR() asm volatile("s_waitcnt lgkmcnt(0)\n\ts_barrier" ::: "memory")
#define ROT() do { sl_prev = sl_cur; sl_cur = sl_next; sl_next = (sl_next == 2 * AT_SLOTB) ? 0 : sl_next + AT_SLOTB; } while (0)
#define MX3(a, b, c) __builtin_fmaxf(__builtin_fmaxf((a), (b)), (c))
#define KLD2(so, j) do { kf[2 * (j)] = *(const LAS bf16x8*)(kpA + (so) + (j) * 2048); kf[2 * (j) + 1] = *(const LAS bf16x8*)(kpB + (so) + (j) * 2048); } while (0)
#define CADDR(tt) (((tt) < n_win && (unsigned)(lo + (tt) - r0) < 8u) ? tlane + (lo + (tt) - r + 7) * (AT_ROWF * 4) : AT_INF)
#define CLDA(X0, q) do { const int ro_ = (((2 * (q)) & 3) + 8 * ((2 * (q)) >> 2)) * 4; X0[2 * (q)] = *(const LAS float*)(L + cad + offA + ro_); X0[2 * (q) + 1] = *(const LAS float*)(L + cad + offA + ro_ + 4); } while (0)
#define CLDB(X1, q) do { X1[2 * (q)] = *(const LAS float*)(L + cad + offB + 8 * (q)); X1[2 * (q) + 1] = *(const LAS float*)(L + cad + offB + 8 * (q) + 4); } while (0)
#define DEC_TAIL() do { { auto rr_ = __builtin_amdgcn_permlane32_swap(__float_as_uint(rm_), __float_as_uint(rm_), false, false); rm_ = __builtin_fmaxf(__uint_as_float(rr_[0]), __uint_as_float(rr_[1])); } \
        resc = false; \
        if (__builtin_amdgcn_ballot_w64(rm_ > mhat + ATT_THR) != 0ull) { const float mn_ = __builtin_fmaxf(mhat, rm_); fres = __builtin_amdgcn_exp2f(mhat - mn_); l_reg *= fres; mhat = mn_; resc = true; } \
        nmh = (mhat == -INFINITY) ? 0.f : -mhat; } while (0)
#define DECIDE_D(C0, C1) do { float a_ = MX3(C0[0], C0[1], C1[0]), b_ = MX3(C0[2], C0[3], C1[1]); a_ = MX3(a_, C1[2], C1[3]); \
        _Pragma("unroll") for (int r_ = 4; r_ < 16; r_ += 4) { a_ = MX3(a_, C0[r_], C0[r_ + 1]); b_ = MX3(b_, C0[r_ + 2], C0[r_ + 3]); a_ = MX3(a_, C1[r_], C1[r_ + 1]); b_ = MX3(b_, C1[r_ + 2], C1[r_ + 3]); } \
        float rm_ = __builtin_fmaxf(a_, b_); DEC_TAIL(); } while (0)
#define DECIDE_W(C0, C1) do { float a_ = MX3(C0[0], C0[1], C1[0]), b_ = MX3(C0[2], C0[3], C1[1]); a_ = MX3(a_, C1[2], C1[3]); \
        _Pragma("unroll") for (int r_ = 4; r_ < 16; r_ += 4) { a_ = MX3(a_, C0[r_], C0[r_ + 1]); b_ = MX3(b_, C0[r_ + 2], C0[r_ + 3]); } \
        float rm_ = __builtin_fmaxf(a_, b_); DEC_TAIL(); } while (0)
#define RESC() do { if (resc) { _Pragma("unroll") for (int r_ = 0; r_ < 16; ++r_) { o0[r_] *= fres; o1[r_] *= fres; } } } while (0)
#define EX(v) __builtin_amdgcn_exp2f((v) + nmh)
#define PKW(P, i) cvtpk_s(P[i], P[(i) + 1])
#define PAF(k) __builtin_bit_cast(bf16x8, pw##k)
#define VFR(i) (bf16x8){vlo[i][0], vlo[i][1], vlo[i][2], vlo[i][3], vhi[i][0], vhi[i][1], vhi[i][2], vhi[i][3]}
#define VRD(i, s) do { vlo[i] = vtr(vp_ + (((i) >> 2) * 4096 + vol##s)); vhi[i] = vtr(vp_ + (((i) >> 2) * 4096 + voh##s)); } while (0)
#define GAPA(MF, a0, a1, a2, a3, W0, W1, PW) do { MF; sacc += a0; sacc += a1; sacc += a2; sacc += a3; PIN(sacc); W0; W1; PIN(PW); SBAR(); } while (0)
#define GAPM(MF) do { MF; SBAR(); } while (0)
#define GAPB(MF, X, i) do { MF; X[i] = EX(X[i]); X[(i) + 1] = EX(X[(i) + 1]); X[(i) + 2] = EX(X[(i) + 2]); X[(i) + 3] = EX(X[(i) + 3]); PIN(X); SBAR(); } while (0)
#define EXG(X, i) do { X[i] = EX(X[i]); X[(i) + 1] = EX(X[(i) + 1]); X[(i) + 2] = EX(X[(i) + 2]); X[(i) + 3] = EX(X[(i) + 3]); PIN(X); SBAR(); } while (0)
#define STAGE(t, KR, VR) do { *(LAS u32x4*)(L + sl_prev + kdst) = KR; *(LAS u32x4*)(L + sl_next + vdst) = VR; \
        { const int tk_ = VT(min((t) + 4, NTV - 1)), tv_ = VT(min((t) + 3, NTV - 1)); const bf16_t *kp_, *vq_, *kq_, *vv_; ATT_SRC(tk_, kp_, vq_); ATT_SRC(tv_, kq_, vv_); (void)vq_; (void)kq_; \
          KR = *(const u32x4*)(kp_ + ksoff); VR = *(const u32x4*)(vv_ + vsoff); } SBAR(); } while (0)
#define QK0(C0, CZ) C0 = (CZ) ? MFMA32(kf[0], qr[0], zero16) : MFMA32(kf[0], qr[0], C0)
#define QK1(C1, CZ) C1 = (CZ) ? MFMA32(kf[1], qr[0], zero16) : MFMA32(kf[1], qr[0], C1)
#define PHASEA_PW(C0, C1, P0, P1, CZ) do { \
    VRD(0, 0); SBAR(); float sacc = P0[0] + P0[1]; \
                       GAPA(QK0(C0, CZ), P0[2], P0[3], P0[4], P0[5],     pw0[0] = PKW(P0, 0),  pw0[1] = PKW(P0, 2),  pw0); \
    VRD(4, 0); SBAR(); GAPA(QK1(C1, CZ), P0[6], P0[7], P0[8], P0[9],     pw0[2] = PKW(P0, 4),  pw0[3] = PKW(P0, 6),  pw0); \
    VRD(1, 1); SBAR(); GAPA(C0 = MFMA32(kf[2], qr[1], C0), P0[10], P0[11], P0[12], P0[13], pw1[0] = PKW(P0, 8),  pw1[1] = PKW(P0, 10), pw1); \
    VRD(5, 1); SBAR(); GAPA(C1 = MFMA32(kf[3], qr[1], C1), P0[14], P0[15], P1[0], P1[1],   pw1[2] = PKW(P0, 12), pw1[3] = PKW(P0, 14), pw1); \
    VRD(2, 2); SBAR(); GAPA(C0 = MFMA32(kf[4], qr[2], C0), P1[2], P1[3], 0.f, 0.f,         pw2[0] = PKW(P1, 0),  pw2[1] = PKW(P1, 2),  pw2); \
    VRD(6, 2); SBAR(); GAPM(C1 = MFMA32(kf[5], qr[2], C1)); pw2[2] = 0u; pw2[3] = 0u; \
                       GAPM(C0 = MFMA32(kf[6], qr[3], C0)); GAPM(C1 = MFMA32(kf[7], qr[3], C1)); \
    l_reg += sacc; } while (0)
#define PHASEA_PD(C0, C1, P0, P1, CZ) do { \
    VRD(0, 0); SBAR(); float sacc = P0[0] + P0[1]; \
                       GAPA(QK0(C0, CZ), P0[2], P0[3], P0[4], P0[5],     pw0[0] = PKW(P0, 0),  pw0[1] = PKW(P0, 2),  pw0); \
    VRD(4, 0); SBAR(); GAPA(QK1(C1, CZ), P0[6], P0[7], P0[8], P0[9],     pw0[2] = PKW(P0, 4),  pw0[3] = PKW(P0, 6),  pw0); \
    VRD(1, 1); SBAR(); GAPA(C0 = MFMA32(kf[2], qr[1], C0), P0[10], P0[11], P0[12], P0[13], pw1[0] = PKW(P0, 8),  pw1[1] = PKW(P0, 10), pw1); \
    VRD(5, 1); SBAR(); GAPA(C1 = MFMA32(kf[3], qr[1], C1), P0[14], P0[15], P1[0], P1[1],   pw1[2] = PKW(P0, 12), pw1[3] = PKW(P0, 14), pw1); \
    VRD(2, 2); SBAR(); GAPA(C0 = MFMA32(kf[4], qr[2], C0), P1[2], P1[3], P1[4], P1[5],     pw2[0] = PKW(P1, 0),  pw2[1] = PKW(P1, 2),  pw2); \
    VRD(6, 2); SBAR(); GAPA(C1 = MFMA32(kf[5], qr[2], C1), P1[6], P1[7], P1[8], P1[9],     pw2[2] = PKW(P1, 4),  pw2[3] = PKW(P1, 6),  pw2); \
    VRD(3, 3); SBAR(); GAPA(C0 = MFMA32(kf[6], qr[3], C0), P1[10], P1[11], P1[12], P1[13], pw3[0] = PKW(P1, 8),  pw3[1] = PKW(P1, 10), pw3); \
    VRD(7, 3); SBAR(); GAPA(C1 = MFMA32(kf[7], qr[3], C1), P1[14], P1[15], 0.f, 0.f,       pw3[2] = PKW(P1, 12), pw3[3] = PKW(P1, 14), pw3); \
    l_reg += sacc; } while (0)
#define STEP_WW(C0, C1, P0, P1, t, KR, VR) do { SBAR(); const LAS char* vp_ = vp0 + sl_prev; const int cad = CADDR((t) + 1); \
    PHASEA_PW(C0, C1, P0, P1, false); STAGE(t, KR, VR); float nmh; DECIDE_W(C0, C1); SBAR(); \
                               GAPB(o0 = MFMA32(VFR(0), PAF(0), o0), C0, 0);  CLDA(P0, 0); CLDA(P0, 1); SBAR(); \
                               GAPB(o1 = MFMA32(VFR(4), PAF(0), o1), C0, 4);  CLDA(P0, 2); CLDA(P0, 3); SBAR(); \
    KLD2(sl_next, 0); SBAR();  GAPB(o0 = MFMA32(VFR(1), PAF(1), o0), C0, 8);  CLDA(P0, 4); CLDA(P0, 5); SBAR(); \
    KLD2(sl_next, 1); SBAR();  GAPB(o1 = MFMA32(VFR(5), PAF(1), o1), C0, 12); CLDA(P0, 6); CLDA(P0, 7); SBAR(); \
    KLD2(sl_next, 2); SBAR();  GAPB(o0 = MFMA32(VFR(2), PAF(2), o0), C1, 0);  CLDB(P1, 0); CLDB(P1, 1); SBAR(); \
    KLD2(sl_next, 3); SBAR();  GAPM(o1 = MFMA32(VFR(6), PAF(2), o1)); } while (0)
#define STEP_DW(C0, C1, P0, P1, t, KR, VR) do { SBAR(); const LAS char* vp_ = vp0 + sl_prev; \
    PHASEA_PW(C0, C1, P0, P1, true); STAGE(t, KR, VR); float nmh; DECIDE_D(C0, C1); SBAR(); \
                               GAPB(o0 = MFMA32(VFR(0), PAF(0), o0), C0, 0); \
                               GAPB(o1 = MFMA32(VFR(4), PAF(0), o1), C0, 4); \
    KLD2(sl_next, 0); SBAR();  GAPB(o0 = MFMA32(VFR(1), PAF(1), o0), C0, 8); \
    KLD2(sl_next, 1); SBAR();  GAPB(o1 = MFMA32(VFR(5), PAF(1), o1), C0, 12); \
    KLD2(sl_next, 2); SBAR();  GAPB(o0 = MFMA32(VFR(2), PAF(2), o0), C1, 0); \
    KLD2(sl_next, 3); SBAR();  GAPB(o1 = MFMA32(VFR(6), PAF(2), o1), C1, 4); \
                               EXG(C1, 8); EXG(C1, 12); } while (0)
#define STEP_DD(C0, C1, P0, P1, t, KR, VR) do { SBAR(); const LAS char* vp_ = vp0 + sl_prev; \
    PHASEA_PD(C0, C1, P0, P1, true); STAGE(t, KR, VR); float nmh; DECIDE_D(C0, C1); SBAR(); \
                               GAPB(o0 = MFMA32(VFR(0), PAF(0), o0), C0, 0); \
                               GAPB(o1 = MFMA32(VFR(4), PAF(0), o1), C0, 4); \
    KLD2(sl_next, 0); SBAR();  GAPB(o0 = MFMA32(VFR(1), PAF(1), o0), C0, 8); \
    KLD2(sl_next, 1); SBAR();  GAPB(o1 = MFMA32(VFR(5), PAF(1), o1), C0, 12); \
    KLD2(sl_next, 2); SBAR();  GAPB(o0 = MFMA32(VFR(2), PAF(2), o0), C1, 0); \
    KLD2(sl_next, 3); SBAR();  GAPB(o1 = MFMA32(VFR(6), PAF(2), o1), C1, 4); \
                               GAPB(o0 = MFMA32(VFR(3), PAF(3), o0), C1, 8); \
                               GAPB(o1 = MFMA32(VFR(7), PAF(3), o1), C1, 12); } while (0)
    f32x16 zero16;
#pragma unroll
    for (int i = 0; i < 16; ++i) zero16[i] = 0.f;
    WBAR();
    sl_prev = 2 * AT_SLOTB; sl_cur = 0; sl_next = AT_SLOTB;
    if (!ctx) {
        { const int cad = CADDR(0);
#pragma unroll
          for (int q = 0; q < 8; ++q) CLDA(pA0, q);
          CLDB(pA1, 0); CLDB(pA1, 1); }
#pragma unroll
        for (int j = 0; j < 4; ++j) KLD2(0, j);
#pragma unroll
        for (int j = 0; j < 4; ++j) { pA0 = MFMA32(kf[2 * j], qr[j], pA0); pA1 = MFMA32(kf[2 * j + 1], qr[j], pA1); }
        STAGE(0, kreg, vreg);
        { float nmh; DECIDE_W(pA0, pA1);
#pragma unroll
          for (int r_ = 0; r_ < 16; ++r_) pA0[r_] = EX(pA0[r_]);
#pragma unroll
          for (int r_ = 0; r_ < 4; ++r_) pA1[r_] = EX(pA1[r_]); }
        { const int cad = CADDR(1);
#pragma unroll
          for (int q = 0; q < 8; ++q) CLDA(pB0, q);
          CLDB(pB1, 0); CLDB(pB1, 1); }
#pragma unroll
        for (int j = 0; j < 4; ++j) KLD2(AT_SLOTB, j);
        WBAR(); ROT();
#pragma unroll 1
        for (int t = 1; t < NWP; t += 2) {
            STEP_WW(pB0, pB1, pA0, pA1, t, kreg2, vreg2);     WBAR(); RESC(); ROT();
            STEP_WW(pA0, pA1, pB0, pB1, t + 1, kreg, vreg); WBAR(); RESC(); ROT();
        }
        STEP_DW(pB0, pB1, pA0, pA1, NWP, kreg2, vreg2); WBAR(); RESC(); ROT();
    } else {
#pragma unroll
        for (int j = 0; j < 4; ++j) KLD2(0, j);
        pB0 = MFMA32(kf[0], qr[0], zero16); pB1 = MFMA32(kf[1], qr[0], zero16);
#pragma unroll
        for (int j = 1; j < 4; ++j) { pB0 = MFMA32(kf[2 * j], qr[j], pB0); pB1 = MFMA32(kf[2 * j + 1], qr[j], pB1); }
        STAGE(0, kreg, vreg);
        { float nmh; DECIDE_D(pB0, pB1);
#pragma unroll
          for (int r_ = 0; r_ < 16; ++r_) { pB0[r_] = EX(pB0[r_]); pB1[r_] = EX(pB1[r_]); } }
#pragma unroll
        for (int j = 0; j < 4; ++j) KLD2(AT_SLOTB, j);
        WBAR(); ROT();
    }
    if (ctx) {
      STEP_DD(pA0, pA1, pB0, pB1, 1, kreg2, vreg2); WBAR(); RESC(); ROT();
      STEP_DD(pB0, pB1, pA0, pA1, 2, kreg, vreg);   WBAR(); RESC(); ROT();
      STEP_DD(pA0, pA1, pB0, pB1, 3, kreg2, vreg2); WBAR(); RESC(); ROT();
    } else {
      STEP_DD(pA0, pA1, pB0, pB1, NWP + 1, kreg, vreg);   WBAR(); RESC(); ROT();
      STEP_DD(pB0, pB1, pA0, pA1, NWP + 2, kreg2, vreg2); WBAR(); RESC(); ROT();
      STEP_DD(pA0, pA1, pB0, pB1, NWP + 3, kreg, vreg);   WBAR(); RESC(); ROT(); }
#define DRAIN(P0, P1) do { float sacc = P0[0] + P0[1]; \
      _Pragma("unroll") for (int r_ = 2; r_ < 16; ++r_) sacc += P0[r_]; \
      _Pragma("unroll") for (int r_ = 0; r_ < 16; ++r_) sacc += P1[r_]; \
      l_reg += sacc; \
      pw0 = (u32x4){PKW(P0, 0), PKW(P0, 2), PKW(P0, 4), PKW(P0, 6)}; pw1 = (u32x4){PKW(P0, 8), PKW(P0, 10), PKW(P0, 12), PKW(P0, 14)}; \
      pw2 = (u32x4){PKW(P1, 0), PKW(P1, 2), PKW(P1, 4), PKW(P1, 6)}; pw3 = (u32x4){PKW(P1, 8), PKW(P1, 10), PKW(P1, 12), PKW(P1, 14)}; \
      PIN(pw0); PIN(pw1); PIN(pw2); PIN(pw3); SBAR(); \
      _Pragma("unroll") for (int i_ = 0; i_ < 4; ++i_) zr[i_] = *(const u32x4*)(zp + (size_t)i_ * 8 * 512); \
      asm volatile("" ::: "memory"); if (next_ctx >= 0) attn_prefetch(F, layer, next_ctx, true, P); asm volatile("" ::: "memory");     \
      const LAS char* vp_ = vp0 + sl_prev; VRD(0, 0); VRD(4, 0); VRD(1, 1); VRD(5, 1); VRD(2, 2); VRD(6, 2); VRD(3, 3); VRD(7, 3); \
      o0 = MFMA32(VFR(0), PAF(0), o0); o1 = MFMA32(VFR(4), PAF(0), o1); o0 = MFMA32(VFR(1), PAF(1), o0); o1 = MFMA32(VFR(5), PAF(1), o1); \
      o0 = MFMA32(VFR(2), PAF(2), o0); o1 = MFMA32(VFR(6), PAF(2), o1); o0 = MFMA32(VFR(3), PAF(3), o0); o1 = MFMA32(VFR(7), PAF(3), o1); } while (0)
    int le = lane; asm volatile("" : "+v"(le));
    unsigned char* wse = kws();
    const bf16_t* zp = (const bf16_t*)(wse + WS_SZA) + (size_t)(R0 + (le >> 3)) * 512 + h * 64 + (le & 7) * 8;
    u32x4 zr[4];
    DRAIN(pA0, pA1);
#undef DRAIN
#undef STEP_DD
#undef STEP_DW
#undef STEP_WW
#undef PHASEA_PD
#undef PHASEA_PW
#undef QK0
#undef QK1
#undef STAGE
#undef EXG
#undef GAPB
#undef GAPM
#undef GAPA
#undef VRD
#undef VFR
#undef PAF
#undef PKW
#undef EX
#undef RESC
#undef DECIDE_W
#undef DECIDE_D
#undef DEC_TAIL
#undef CLDA
#undef CLDB
#undef CADDR
#undef KLD2
#undef MX3
#undef ROT
#undef VT
    { auto rr = __builtin_amdgcn_permlane32_swap(__float_as_uint(l_reg), __float_as_uint(l_reg), false, false); l_reg = __uint_as_float(rr[0]) + __uint_as_float(rr[1]); }
    const float inv = 1.0f / l_reg;
    { LAS char* stg = L + AT_TBL + wid * 4608; LAS char* srow = stg + (le >> 3) * 144 + (le & 7) * 16; LAS char* sfrag = stg + (le & 31) * 144 + (le >> 5) * 8;
#pragma unroll
      for (int i = 0; i < 4; ++i) *(LAS u32x4*)(srow + i * 8 * 144) = zr[i];
      asm volatile("s_waitcnt lgkmcnt(0)" ::: "memory");
      u32x2 zg0[4], zg1[4];
#pragma unroll
      for (int g = 0; g < 4; ++g) { zg0[g] = *(const LAS u32x2*)(sfrag + 16 * g); zg1[g] = *(const LAS u32x2*)(sfrag + 64 + 16 * g); }
      asm volatile("s_waitcnt lgkmcnt(0)" ::: "memory");
#pragma unroll
      for (int g = 0; g < 4; ++g) {
          const u32x2 z0 = zg0[g], z1 = zg1[g];
          u32x2 w0, w1;
          w0.x = cvtpk_s(o0[4 * g + 0] * inv * bflo(z0.x), o0[4 * g + 1] * inv * bfhi(z0.x)); w0.y = cvtpk_s(o0[4 * g + 2] * inv * bflo(z0.y), o0[4 * g + 3] * inv * bfhi(z0.y));
          w1.x = cvtpk_s(o1[4 * g + 0] * inv * bflo(z1.x), o1[4 * g + 1] * inv * bfhi(z1.x)); w1.y = cvtpk_s(o1[4 * g + 2] * inv * bflo(z1.y), o1[4 * g + 3] * inv * bfhi(z1.y));
          *(LAS u32x2*)(sfrag + 16 * g) = w0; *(LAS u32x2*)(sfrag + 64 + 16 * g) = w1; }
      asm volatile("s_waitcnt lgkmcnt(0)" ::: "memory");
      bf16_t* yp = (bf16_t*)(wse + WS_YAB) + (size_t)(R0 + (le >> 3)) * 1024 + h * 64 + (le & 7) * 8;
#pragma unroll
      for (int i = 0; i < 4; ++i) { const u32x4 v = *(const LAS u32x4*)(srow + i * 8 * 144); *(u32x4*)(yp + (size_t)i * 8 * 1024) = v; } }
    WBAR();
#undef WBAR
#undef PIN
#undef SBAR
}
#undef ATT_SRC
#undef ATT_DECODE

__device__ __forceinline__ void mix_phase(Frame& F, int layer) {
    AttnPre P;
    const int t_ctx = 255 - F.bx;
    for (int t = F.bx; t < M / 32; t += 256) conv_task(F, layer, t, P, t + 256 >= M / 32 ? F.bx : -1);
    attn_wg(F, layer, F.bx, false, P, t_ctx < 128 ? t_ctx : -1);
    if (t_ctx < 128) attn_wg(F, layer, t_ctx, true, P, -1);
}

__device__ __forceinline__ void cvec_phase(Frame& F) {
    const int gw = F.bx * 8 + F.wave, NGW = F.G * 8;
    const float* md = WSP(float, WS_MOD) + 5 * 3072;
    f32x4 sh[5][4];
#pragma unroll
    for (int g = 0; g < 5; ++g)
#pragma unroll
        for (int i = 0; i < 4; ++i) sh[g][i] = *(const f32x4*)(md + g * 3072 + 16 * F.lane + 4 * i);
    const bf16_t* W = WSP(bf16_t, WS_WTIN) + (size_t)DIN * D; const float* bp = WSP(float, WS_BIASP) + DIN; float* cv = WSP(float, WS_CVEC);
    for (int n = gw; n < DIN; n += NGW) {
        const u32x4 wa = *(const u32x4*)(W + (size_t)n * D + 16 * F.lane), wb = *(const u32x4*)(W + (size_t)n * D + 16 * F.lane + 8);
        const f32x4 w0 = {bflo(wa.x), bfhi(wa.x), bflo(wa.y), bfhi(wa.y)}, w1 = {bflo(wa.z), bfhi(wa.z), bflo(wa.w), bfhi(wa.w)};
        const f32x4 w2 = {bflo(wb.x), bfhi(wb.x), bflo(wb.y), bfhi(wb.y)}, w3 = {bflo(wb.z), bfhi(wb.z), bflo(wb.w), bfhi(wb.w)};
        const float bias = bp[n];
#pragma unroll
        for (int g = 0; g < 5; ++g) { const f32x4 p = sh[g][0] * w0 + sh[g][1] * w1 + sh[g][2] * w2 + sh[g][3] * w3;
            const float sm = wave_sum((p[0] + p[1]) + (p[2] + p[3])); if (F.lane == 0) cv[g * DIN + n] = sm + bias; }
    }
}

struct Args { const float* in[20]; float* out; unsigned char* ws; int ph_lo, ph_hi; };

__global__ void __launch_bounds__(512, 2) mk_fwd(Args args) {
    extern __shared__ __attribute__((aligned(16))) unsigned char lds_raw[];
    Frame F;
    F.lds = (LAS unsigned char*)lds_raw;
    F.tid = threadIdx.x; F.lane = F.tid & 63; F.wave = __builtin_amdgcn_readfirstlane(F.tid >> 6); F.G = gridDim.x; F.bx = blockIdx.x;
    for (int u = F.tid; u < (LDS_BYTES - LDSCTL_OFF) / 4; u += 512) ((LAS unsigned*)(F.lds + LDSCTL_OFF))[u] = 0u;
    __syncthreads();
    XcdBarrier bar; bar.bar = WSP(unsigned, WS_CTL) + CW_BAR; bar.x = 0; bar.st = nullptr;
#define lo (kint(176))
#define hi (kint(180))
    if (hi - lo > 1) bar = xcd_barrier_post(WSP(unsigned, WS_CTL) + CW_BAR, (volatile LAS unsigned*)(F.lds + MISC_OFF) + 8);
#ifndef PH_MASK
#define PH_MASK 0x7f
#endif
#define PHK(kind) ((PH_MASK >> (kind)) & 1)
#define IN(k) (lo <= (k) && (k) < hi)
#define SEAM(k) do { if (IN(k) && IN((k) + 1)) { XcdBarrier bb_; bb_.bar = WSP(unsigned, WS_CTL) + CW_BAR; bb_.x = xb_xcc_id(); bb_.st = (volatile LAS unsigned*)((LAS unsigned char*)lds_raw + MISC_OFF) + 8; xcd_barrier(bb_); } } while (0)
#define FRESH() do { F.tid = fresh_tid(); F.lane = F.tid & 63; F.wave = __builtin_amdgcn_readfirstlane(F.tid >> 6); } while (0)

    if (PHK(0) && IN(0)) { FRESH(); p0_prologue(F); SEAM(0); }
    for (int layer = 0; layer < DEPTH; ++layer) {
        const int pb = 1 + 5 * layer;
        if (PHK(1) && IN(pb) && layer == 0) { FRESH();
            if (layer == 0 && F.bx == F.G - 1) { const float* rg = kin(I_RMS_G) + D; const float* md = WSP(float, WS_MOD) + 5 * 3072; float* gm = WSP(float, WS_GM);
                for (int i = F.tid; i < 5 * 1024; i += 512) { const int g = i >> 10, c = i & 1023; gm[i] = rg[c] * (1.0f + md[g * 3072 + 1024 + c]); } }
            norm_phase(F, layer); SEAM(pb); }
        if (PHK(2) && IN(pb + 1)) {
            constexpr int M1 = 46 * 256;
            const bf16_t* Ain = layer == 0 ? WSP(bf16_t, WS_H) : WSP(bf16_t, WS_YAB);
            { pg8::Gemm g{Ain + (size_t)M1 * D, WSP(bf16_t, WS_WTIN) + (size_t)layer * DIN * D, M - M1, DIN, D, D}; pg8::StaticOrder S; S.init(M - M1, DIN, F.G, F.G - 1 - F.bx, 0, 128);
              if (layer == 0) { EpiInT<2> E{layer, M1}; pg8::gemm_phase<EpiInT<2>>(F.lds, g, S, E); } else { EpiInT<2, true> E{layer, M1}; pg8::gemm_phase<EpiInT<2, true>>(F.lds, g, S, E); } }
            { pg8::Gemm g{Ain, WSP(bf16_t, WS_WTIN) + (size_t)layer * DIN * D, M1, DIN, D, D}; pg8::StaticOrder S; S.init(M1, DIN, F.G, F.bx);
              if (layer == 0) { EpiInT<4> E{layer, 0}; pg8::gemm_phase<EpiInT<4>>(F.lds, g, S, E); } else { EpiInT<4, true> E{layer, 0}; pg8::gemm_phase<EpiInT<4, true>>(F.lds, g, S, E); } }
            if (layer == 0) { const int nidle = F.G - (M - M1) / 128 * (DIN / 256);
                if (nidle > 0 && F.bx < nidle) { FRESH(); __syncthreads(); wt_items(F, 1, F.bx * 8 + F.wave, nidle * 8); } }
            SEAM(pb + 1);
        }
        if (PHK(3) && IN(pb + 2)) { FRESH(); mix_phase(F, layer); SEAM(pb + 2); }
        if (PHK(4) && IN(pb + 3)) {
            if (layer == 0) { FRESH(); cvec_phase(F); }
            pg8::Gemm g{WSP(bf16_t, WS_YAB), WSP(bf16_t, WS_WTPROJ) + (size_t)layer * D * D, M, D, D, D}; pg8::StaticOrder S; S.init(M, D, F.G, F.bx, 0, 192);
            EpiProj E{};
            pg8::gemm_phase<EpiProj>(F.lds, g, S, E);
            SEAM(pb + 3);
        }
        if (PHK(5) && IN(pb + 4)) {
            pg8::Gemm g{WSP(bf16_t, WS_H), WSP(bf16_t, WS_WTOUT) + (size_t)layer * D * D, M, D, D, D}; pg8::StaticOrder S; S.init(M, D, F.G, F.bx, 0, 192);
            if (layer + 1 < DEPTH) { EpiOutT<false> E{layer}; pg8::gemm_phase<EpiOutT<false>>(F.lds, g, S, E); }
            else { EpiOutT<true> E{layer}; pg8::gemm_phase<EpiOutT<true>>(F.lds, g, S, E); }
            if (layer + 1 < DEPTH) SEAM(pb + 4);
        }
    }
#undef IN
#undef SEAM
#undef lo
#undef hi
}

extern "C" void kernel_launch(void* const* d_in, const int* in_sizes, int n_in, void* d_out, int out_size, void* d_ws, size_t ws_size, hipStream_t stream) {
    static int grid = 0;
    if (grid == 0) {
        if (n_in != 20 || ws_size < WS_END) { fprintf(stderr, "kernel_launch: unexpected inputs (n_in %d, ws %zu)\n", n_in, ws_size); grid = -1; return; }
        int dev = 0, cus = 0, per_cu = 0;
        if (hipGetDevice(&dev) != hipSuccess || hipDeviceGetAttribute(&cus, hipDeviceAttributeMultiprocessorCount, dev) != hipSuccess) { grid = -1; return; }
        if (hipFuncSetAttribute((const void*)mk_fwd, hipFuncAttributeMaxDynamicSharedMemorySize, LDS_BYTES) != hipSuccess) { fprintf(stderr, "kernel_launch: hipFuncSetAttribute failed\n"); grid = -1; return; }
        if (hipOccupancyMaxActiveBlocksPerMultiprocessor(&per_cu, (const void*)mk_fwd, 512, LDS_BYTES) != hipSuccess || per_cu < 1) { fprintf(stderr, "kernel_launch: occupancy query says %d\n", per_cu); per_cu = 1; }
        (void)hipGetLastError();
        if (cus < 256) { fprintf(stderr, "kernel_launch: %d CUs; the mixer's work split is written for a grid of 256 workgroups\n", cus); grid = -1; return; }
        grid = 256;
    }
    if (grid < 0) return;
    (void)hipMemsetAsync((char*)d_ws + WS_CTL, 0, CTL_ZERO_BYTES, stream);
    Args a{};
    for (int i = 0; i < 20; ++i) a.in[i] = (const float*)d_in[i];
    a.out = (float*)d_out; a.ws = (unsigned char*)d_ws;
    if (MK_N_LAUNCHES == 1) { a.ph_lo = 0; a.ph_hi = NPHASE; hipLaunchKernelGGL(mk_fwd, dim3(grid), dim3(512), LDS_BYTES, stream, a); }
    else for (int p = 0; p < NPHASE; ++p) { a.ph_lo = p; a.ph_hi = p + 1; hipLaunchKernelGGL(mk_fwd, dim3(grid), dim3(512), LDS_BYTES, stream, a); }
}
```

```cpp
#include <hip/hip_runtime.h>
#include <cstdio>
#include <cstdint>

#ifndef MK_N_LAUNCHES
#define MK_N_LAUNCHES 1
#endif

#define GAS __attribute__((address_space(1)))
#define LAS __attribute__((address_space(3)))
typedef unsigned short bf16_t;
typedef short bf16x8 __attribute__((ext_vector_type(8)));
typedef float f32x4 __attribute__((ext_vector_type(4)));
typedef float f32x2 __attribute__((ext_vector_type(2)));
typedef unsigned u32x4 __attribute__((ext_vector_type(4)));
typedef unsigned u32x2 __attribute__((ext_vector_type(2)));
typedef GAS unsigned gu32;
#define RLX_AGENT __ATOMIC_RELAXED, __HIP_MEMORY_SCOPE_AGENT
#define LDS_WAIT() asm volatile("s_waitcnt lgkmcnt(0)" ::: "memory")
#define VM_WAIT() asm volatile("s_waitcnt vmcnt(0)" ::: "memory")

constexpr int D = 1024, NCTX = 4096, NLAT = 8192, M = NCTX + NLAT, DIN = 5632, DEPTH = 2, NH = 8, HD = 64;
constexpr int NPHASE = 12;
constexpr float EPS = 1e-6f;

constexpr size_t MiB = 1u << 20;
constexpr size_t WS_CTL = 0, CTL_ZERO_BYTES = 192 * 1024;
constexpr size_t WS_RSS2 = 128 * 1024;
constexpr size_t WS_RSS = 64 * 1024;
constexpr size_t WS_GM = 1 * MiB + 192 * 1024;
constexpr size_t WS_CVEC = 1 * MiB + 256 * 1024;
constexpr size_t WS_MOD = 1 * MiB;
constexpr size_t WS_BIASP = 1 * MiB + 128 * 1024;
constexpr size_t WS_WTIN = 2 * MiB;
constexpr size_t WS_WTPROJ = 24 * MiB;
constexpr size_t WS_WTOUT = 28 * MiB;
constexpr size_t WS_CK = 32 * MiB, WS_CV = 34 * MiB;
constexpr size_t WS_H = 36 * MiB;
constexpr size_t WS_Q = 60 * MiB, WS_K = 72 * MiB, WS_V = 84 * MiB, WS_SZA = 96 * MiB, WS_U = 108 * MiB, WS_SZB = 120 * MiB;
constexpr size_t WS_GR = 132 * MiB, WS_GB = 156 * MiB;
constexpr size_t WS_YAB = 180 * MiB;
constexpr size_t WS_X1 = 204 * MiB;
constexpr size_t WS_END = 228 * MiB;
constexpr int CW_BAR = 4096;
constexpr int CW_ROWBLK = 8192;

constexpr int RING_BYTES = 131072;
constexpr int LDSCTL_OFF = RING_BYTES, MISC_OFF = LDSCTL_OFF + 320;
constexpr int LDS_BYTES = 147456;

__device__ __forceinline__ unsigned f2bf(float f) { unsigned u = __builtin_bit_cast(unsigned, f); return (u + 0x7fffu + ((u >> 16) & 1u)) >> 16; }
__device__ __forceinline__ unsigned pk2(float lo, float hi) { return f2bf(lo) | (f2bf(hi) << 16); }
typedef __bf16 bf16x2_cv __attribute__((ext_vector_type(2)));
__device__ __forceinline__ unsigned cvt_pk_bf16(float lo, float hi) { f32x2 v = {lo, hi}; bf16x2_cv b = __builtin_convertvector(v, bf16x2_cv); return __builtin_bit_cast(unsigned, b); }
__device__ __forceinline__ float bflo(unsigned w) { return __builtin_bit_cast(float, w << 16); }
__device__ __forceinline__ float bfhi(unsigned w) { return __builtin_bit_cast(float, w & 0xffff0000u); }
__device__ __forceinline__ float sigmoid_f(float x) { return __builtin_amdgcn_rcpf(1.0f + __expf(-x)); }
__device__ __forceinline__ float silu_f(float x) { return x * sigmoid_f(x); }
__device__ __forceinline__ float dpp_f(float v, float o) { return v + o; }
__device__ __forceinline__ float wave_sum(float v) {
#define DPP_ADD(ctrl, rm, bc) v += __builtin_bit_cast(float, __builtin_amdgcn_update_dpp(0, __builtin_bit_cast(int, v), ctrl, rm, 0xf, bc))
    DPP_ADD(0x111, 0xf, true); DPP_ADD(0x112, 0xf, true); DPP_ADD(0x114, 0xf, true); DPP_ADD(0x118, 0xf, true);
    DPP_ADD(0x142, 0xa, false); DPP_ADD(0x143, 0xc, false);
#undef DPP_ADD
    return __builtin_bit_cast(float, __builtin_amdgcn_readlane(__builtin_bit_cast(int, v), 63));
}

__device__ __forceinline__ int fresh_tid() { int t = threadIdx.x; asm volatile("" : "+v"(t)); return t; }

namespace pg8 {
constexpr int BM = 256, BK = 64, HALF = 128, HTB = HALF * BK * 2, STAGE_BYTES = 8 * HTB, NXCD = 8, WGM = 8;
__host__ __device__ __forceinline__ int lds_byte(int r, int c) { const int st = (r >> 4) * 2 + (c >> 5), rr = r & 15, cc = c & 31, ob = rr * 64 + cc * 2; return st * 1024 + (ob ^ (((ob >> 9) & 1) << 5)); }
__host__ __device__ __forceinline__ void stage_rc(int b, int& R, int& C) { const int st = b / 1024, sb = b % 1024, swz = sb ^ (((sb >> 9) & 1) << 5); R = (st >> 1) * 16 + swz / 64; C = (st & 1) * 32 + (swz % 64) / 2; }
__host__ __device__ __forceinline__ int perm32(int rho) { const int n = rho >> 4, i = rho & 15; return 8 * (i >> 2) + 4 * n + (i & 3); }

struct Unit { int pm, pn, kh; };
struct Gemm { const bf16_t* A; const bf16_t* Bt; int M, N, K, ld; };

struct StaticOrder {
    int nM, nN, nwg, G, c;
    __host__ __device__ void init(int M_, int N_, int G_, int c_, int split_ = 0, int bm_ = BM) { nM = M_ / bm_; nN = N_ / BM; nwg = nM * nN; G = G_; c = c_; split = split_; }
    int split;
    __host__ __device__ bool next(int i0, Unit& u) const {
        const int i = split ? (i0 >> 1) : i0; u.kh = split ? (i0 & 1) : 0;
        const long L = (long)i * G + c; if (L >= nwg) return false;
        int wgid = (int)L; { const int q = nwg / NXCD, r = nwg % NXCD, xcd = wgid % NXCD, off = wgid / NXCD; wgid = (xcd < r ? xcd * (q + 1) : r * (q + 1) + (xcd - r) * q) + off; }
        const int nig = WGM * nN, gid = wgid / nig, fm = gid * WGM, gsz = (nM - fm) < WGM ? (nM - fm) : WGM;
        u.pm = fm + ((wgid % nig) % gsz); u.pn = (wgid % nig) / gsz; return true;
    }
};

template <class Epi, bool ALIGN_EPI = true, bool SP2 = true>
__device__ __forceinline__ void gemm_phase(LAS unsigned char* lds, const Gemm g, const StaticOrder& S, const Epi& E) {
    const int tid = fresh_tid(), wid = __builtin_amdgcn_readfirstlane(tid >> 6), lane = tid & 63, wr = wid >> 2, wc = wid & 3, fr = lane & 15, fq = lane >> 4;
    static_assert(SP2 || Epi::MB == 4, "tiles lower than 256 rows use the SP2 loop");
    constexpr int MB = Epi::MB, HROWS = 32 * MB;
    const int K = g.ld, nt = g.K / BK;
    const size_t khstep = (size_t)g.K * 2;
    unsigned voffA[2], voffB[2];
#pragma unroll
    for (int i = 0; i < 2; ++i) { int R, C; stage_rc(tid * 16 + i * 8192, R, C); const int Rb = Epi::PERM ? ((R & ~31) + perm32(R & 31)) : R;
        voffA[i] = (unsigned)(R * K + C) * 2u; voffB[i] = (unsigned)(Rb * K + C) * 2u; }
    const size_t kstep = (size_t)(BK * 2);
    const size_t hstep = (size_t)HROWS * K * 2;
    const size_t hstepB = (size_t)HALF * K * 2;
    const size_t tstep = 2 * hstep, tstepB = 2 * hstepB;
    const unsigned ldsw = (unsigned)wid * 1024u;
    const int aoff = lds_byte(wr * (16 * MB) + fr, fq * 8), boff = lds_byte(wc * 32 + fr, fq * 8);
#define PG8_SA(b, h) (((b) * 2 + (h)) * HTB)
#define PG8_SB(b, h) ((4 + (b) * 2 + (h)) * HTB)
#define PG8_STAGE(bufoff, gbase, voff) do { _Pragma("unroll") for (int _i = 0; _i < 2; ++_i) \
        __builtin_amdgcn_global_load_lds((const unsigned*)((const char*)(gbase) + (voff)[_i]), (LAS unsigned*)(lds + (bufoff) + ldsw + _i * 8192), 16, 0, 0); } while (0)
#define PG8_LDA(dst, b, h) do { _Pragma("unroll") for (int m = 0; m < MB; ++m) _Pragma("unroll") for (int k = 0; k < 2; ++k) dst[m][k] = *(const LAS bf16x8*)(lds + PG8_SA(b, h) + aoff + m * 2048 + k * 1024); } while (0)
#define PG8_LDB(dst, b, h) do { _Pragma("unroll") for (int n = 0; n < 2; ++n) _Pragma("unroll") for (int k = 0; k < 2; ++k) dst[n][k] = *(const LAS bf16x8*)(lds + PG8_SB(b, h) + boff + n * 2048 + k * 1024); } while (0)
#define PG8_MMA(ai, bj, At, Bt) do { __builtin_amdgcn_s_setprio(1); _Pragma("unroll") for (int m = 0; m < MB; ++m) _Pragma("unroll") for (int n = 0; n < 2; ++n) _Pragma("unroll") for (int k = 0; k < 2; ++k) \
        acc[ai][bj][m][n] = __builtin_amdgcn_mfma_f32_16x16x32_bf16(Bt[n][k], At[m][k], acc[ai][bj][m][n], 0, 0, 0); __builtin_amdgcn_s_setprio(0); } while (0)
#define PG8_WAIT_V(n) asm volatile("s_waitcnt vmcnt(" #n ")" ::: "memory")
    const int aIss = (MB == 4) ? 2 : (MB == 3) ? (wid < 4 ? 2 : 1) : (MB == 2) ? 1 : (wid < 4 ? 1 : 0);
#define PG8_STAGE_A(bufoff, gbase, voff) do { _Pragma("unroll") for (int _i = 0; _i < 2; ++_i) if (MB == 4 || _i < aIss) \
        __builtin_amdgcn_global_load_lds((const unsigned*)((const char*)(gbase) + (voff)[_i]), (LAS unsigned*)(lds + (bufoff) + ldsw + _i * 8192), 16, 0, 0); } while (0)
#define PG8_WAIT_VN(n) do { switch (n) { case 0: PG8_WAIT_V(0); break; case 1: PG8_WAIT_V(1); break; case 2: PG8_WAIT_V(2); break; case 4: PG8_WAIT_V(4); break; case 5: PG8_WAIT_V(5); break; \
        case 6: PG8_WAIT_V(6); break; default: PG8_WAIT_V(8); break; } } while (0)
#define PG8_WAIT_LOOP() do { if constexpr (MB == 4) PG8_WAIT_V(8); else PG8_WAIT_VN(4 + 2 * aIss); } while (0)
#define PG8_WAIT_P1() do { if constexpr (MB == 4) PG8_WAIT_V(2); else PG8_WAIT_VN(aIss); } while (0)
#define PG8_WAIT_P2() do { if constexpr (MB == 4) PG8_WAIT_V(6); else PG8_WAIT_VN(4 + aIss); } while (0)
#define PG8_WAIT_L(n) asm volatile("s_waitcnt lgkmcnt(" #n ")" ::: "memory")
#define PG8_BAR __builtin_amdgcn_s_barrier()
#define PG8_SCHED __builtin_amdgcn_sched_barrier(0)
    Unit cur, nxt; int ui = 0;
    if (!S.next(0, cur)) return;
    f32x4 acc[2][2][MB][2];
#pragma unroll
    for (int a = 0; a < 2; ++a)
#pragma unroll
        for (int b = 0; b < 2; ++b)
#pragma unroll
            for (int m = 0; m < MB; ++m)
#pragma unroll
                for (int n = 0; n < 2; ++n) acc[a][b][m][n] = (f32x4){0.f, 0.f, 0.f, 0.f};
    bf16x8 At[MB][2], B0[2][2], B1[2][2];
    const char* cA = (const char*)g.A + (size_t)cur.pm * tstep + cur.kh * khstep; const char* cB = (const char*)g.Bt + (size_t)cur.pn * tstepB + cur.kh * khstep;
    if constexpr (SP2) {
        PG8_STAGE(PG8_SB(0, 0), cB, voffB); PG8_STAGE(PG8_SB(0, 1), cB + hstepB, voffB); PG8_STAGE_A(PG8_SA(0, 0), cA, voffA); PG8_STAGE_A(PG8_SA(0, 1), cA + hstep, voffA);
        if (wr == 1) PG8_BAR;
        PG8_WAIT_P1(); PG8_BAR;
        PG8_STAGE(PG8_SB(1, 0), cB + kstep, voffB); PG8_STAGE_A(PG8_SA(1, 0), cA + kstep, voffA); PG8_STAGE(PG8_SB(1, 1), cB + hstepB + kstep, voffB);
        PG8_WAIT_P2(); PG8_BAR;
    } else {
        PG8_STAGE(PG8_SB(0, 0), cB, voffB); PG8_STAGE(PG8_SA(0, 0), cA, voffA); PG8_STAGE(PG8_SB(0, 1), cB + hstepB, voffB); PG8_STAGE(PG8_SA(0, 1), cA + hstep, voffA);
        if (wr == 1) PG8_BAR;
        PG8_WAIT_V(4); PG8_BAR;
        PG8_STAGE(PG8_SB(1, 0), cB + kstep, voffB); PG8_STAGE(PG8_SA(1, 0), cA + kstep, voffA); PG8_STAGE(PG8_SB(1, 1), cB + hstepB + kstep, voffB);
        PG8_WAIT_V(6); PG8_BAR;
    }
    for (;;) {
        const bool has_next = S.next(ui + 1, nxt);
        const char* nA = has_next ? (const char*)g.A + (size_t)nxt.pm * tstep + nxt.kh * khstep : cA; const char* nB = has_next ? (const char*)g.Bt + (size_t)nxt.pn * tstepB + nxt.kh * khstep : cB;
        for (int t = 0; t < nt; t += 2) {
            const bool last = (t == nt - 2);
            const char* a1 = cA + (size_t)(t + 1) * kstep;
            const char* a2 = last ? nA : cA + (size_t)(t + 2) * kstep; const char* b2 = last ? nB : cB + (size_t)(t + 2) * kstep;
            const char* a3 = a2 + kstep; const char* b3 = b2 + kstep;
            if constexpr (SP2) {
            PG8_LDB(B0, 0, 0); PG8_LDB(B1, 0, 1); PG8_SCHED; PG8_LDA(At, 0, 0); PG8_STAGE_A(PG8_SA(1, 1), a1 + hstep, voffA);
            PG8_WAIT_LOOP(); PG8_WAIT_L(0); PG8_BAR; PG8_MMA(0, 0, At, B0); PG8_MMA(0, 1, At, B1); PG8_BAR; PG8_SCHED;
            PG8_LDA(At, 0, 1); PG8_STAGE(PG8_SB(0, 0), b2, voffB); PG8_STAGE(PG8_SB(0, 1), b2 + hstepB, voffB); PG8_STAGE_A(PG8_SA(0, 0), a2, voffA);
            PG8_WAIT_LOOP(); PG8_WAIT_L(0); PG8_BAR; PG8_MMA(1, 0, At, B0); PG8_MMA(1, 1, At, B1); PG8_BAR; PG8_SCHED;
            PG8_LDB(B0, 1, 0); PG8_LDB(B1, 1, 1); PG8_SCHED; PG8_LDA(At, 1, 0); PG8_STAGE_A(PG8_SA(0, 1), a2 + hstep, voffA);
            PG8_WAIT_LOOP(); PG8_WAIT_L(0); PG8_BAR; PG8_MMA(0, 0, At, B0); PG8_MMA(0, 1, At, B1); PG8_BAR; PG8_SCHED;
            PG8_LDA(At, 1, 1); PG8_STAGE(PG8_SB(1, 0), b3, voffB); PG8_STAGE(PG8_SB(1, 1), b3 + hstepB, voffB); PG8_STAGE_A(PG8_SA(1, 0), a3, voffA);
            PG8_WAIT_LOOP(); PG8_WAIT_L(0); PG8_BAR; PG8_MMA(1, 0, At, B0); PG8_MMA(1, 1, At, B1); PG8_BAR; PG8_SCHED;
            } else {
            PG8_LDB(B0, 0, 0); PG8_SCHED; PG8_LDA(At, 0, 0); PG8_STAGE(PG8_SA(1, 1), a1 + hstep, voffA);
            PG8_WAIT_L(8); PG8_BAR; PG8_WAIT_L(0); PG8_MMA(0, 0, At, B0); PG8_BAR; PG8_SCHED;
            PG8_LDB(B1, 0, 1); PG8_STAGE(PG8_SB(0, 0), b2, voffB);
            PG8_BAR; PG8_WAIT_L(0); PG8_MMA(0, 1, At, B1); PG8_BAR;
            PG8_LDA(At, 0, 1); PG8_STAGE(PG8_SA(0, 0), a2, voffA);
            PG8_BAR; PG8_WAIT_L(0); PG8_MMA(1, 0, At, B0); PG8_BAR; PG8_SCHED;
            PG8_STAGE(PG8_SB(0, 1), b2 + hstepB, voffB);
            PG8_WAIT_V(6); PG8_BAR; PG8_MMA(1, 1, At, B1); PG8_BAR;
            PG8_LDB(B0, 1, 0); PG8_SCHED; PG8_LDA(At, 1, 0); PG8_STAGE(PG8_SA(0, 1), a2 + hstep, voffA);
            PG8_WAIT_L(8); PG8_BAR; PG8_WAIT_L(0); PG8_MMA(0, 0, At, B0); PG8_BAR; PG8_SCHED;
            PG8_LDB(B1, 1, 1); PG8_STAGE(PG8_SB(1, 0), b3, voffB);
            PG8_BAR; PG8_WAIT_L(0); PG8_MMA(0, 1, At, B1); PG8_BAR;
            PG8_LDA(At, 1, 1); PG8_STAGE(PG8_SA(1, 0), a3, voffA);
            PG8_BAR; PG8_WAIT_L(0); PG8_MMA(1, 0, At, B0); PG8_BAR; PG8_SCHED;
            PG8_STAGE(PG8_SB(1, 1), b3 + hstepB, voffB);
            PG8_WAIT_V(6); PG8_BAR; PG8_MMA(1, 1, At, B1); PG8_BAR;
            }
            if constexpr (Epi::MIDHOOK) { if (t + 2 == nt / 2) { E.mid(acc, cur, wr, wc, fr, fq); PG8_SCHED; } }
        }
        if constexpr (ALIGN_EPI) { if (wr == 0) PG8_BAR; }
        E(acc, cur, wr, wc, fr, fq);
        if (!has_next) break;
        {
#pragma unroll
        for (int a = 0; a < 2; ++a)
#pragma unroll
            for (int b = 0; b < 2; ++b)
#pragma unroll
                for (int m = 0; m < MB; ++m)
#pragma unroll
                    for (int n = 0; n < 2; ++n) acc[a][b][m][n] = (f32x4){0.f, 0.f, 0.f, 0.f};
        }
        cur = nxt; cA = nA; cB = nB; ++ui;
        if constexpr (ALIGN_EPI) { if (wr == 1) PG8_BAR; }
    }
    PG8_WAIT_V(0);
    if constexpr (!ALIGN_EPI) { if (wr == 0) PG8_BAR; }
    PG8_BAR;
#undef PG8_SA
#undef PG8_SB
#undef PG8_STAGE
#undef PG8_STAGE_A
#undef PG8_WAIT_VN
#undef PG8_WAIT_LOOP
#undef PG8_WAIT_P1
#undef PG8_WAIT_P2
#undef PG8_LDA
#undef PG8_LDB
#undef PG8_MMA
#undef PG8_WAIT_V
#undef PG8_WAIT_L
#undef PG8_BAR
#undef PG8_SCHED
}
}

#define AS4 __attribute__((address_space(4)))
__device__ __forceinline__ const float* kin(int k) { const AS4 char* p = (const AS4 char*)__builtin_amdgcn_kernarg_segment_ptr(); asm volatile("" : "+s"(p)); return *(const float* const AS4*)(p + 8 * k); }
__device__ __forceinline__ float* kout() { const AS4 char* p = (const AS4 char*)__builtin_amdgcn_kernarg_segment_ptr(); asm volatile("" : "+s"(p)); return *(float* const AS4*)(p + 160); }
__device__ __forceinline__ int kint(int off) { const AS4 char* p = (const AS4 char*)__builtin_amdgcn_kernarg_segment_ptr(); asm volatile("" : "+s"(p)); return *(const int AS4*)(p + off); }
__device__ __forceinline__ unsigned char* kws() { const AS4 char* p = (const AS4 char*)__builtin_amdgcn_kernarg_segment_ptr(); asm volatile("" : "+s"(p)); return *(unsigned char* const AS4*)(p + 168); }
#define I_X_PROMPT 0
#define I_X_SAMPLE 1
#define I_CACHE_K 2
#define I_CACHE_V 3
#define I_C 4
#define I_C_CTX 5
#define I_RMS_G 6
#define I_W_ADA 7
#define I_B_ADA 8
#define I_W_IN 9
#define I_B_IN 10
#define I_REL_BIAS 11
#define I_DW_W 12
#define I_DW_B 13
#define I_LN_G 14
#define I_LN_B 15
#define I_W_PROJ_A 16
#define I_W_PROJ_B 17
#define I_W_OUT 18
#define I_FINAL_G 19
#define WSP(T, off) ((T*)(kws() + (off)))

constexpr float QSCALE = 0.125f * 1.4426950408889634f;
typedef f32x4 acc_t[2][2][4][2];
typedef f32x4 acc3_t[2][2][3][2];

template <int MB_, bool FU = false> struct EpiInT {
    static constexpr bool PERM = true, SPLIT2 = false, MIDHOOK = false; static constexpr int MB = MB_;
    typedef f32x4 accm_t[2][2][MB_][2];
    int layer, rowbase;
    template <bool ACT, bool ST, bool QS = false> __device__ __forceinline__ void plain(accm_t& acc, const f32x4 (&bv)[2][2], bf16_t* dst, float* st, int row0, int colbase) const {
#pragma unroll
        for (int ai = 0; ai < 2; ++ai)
#pragma unroll
            for (int m = 0; m < MB_; ++m) { const int row = row0 + ai * (32 * MB_) + m * 16;
#pragma unroll
                for (int bj = 0; bj < 2; ++bj) { f32x4 v0 = acc[ai][bj][m][0] + bv[bj][0], v1 = acc[ai][bj][m][1] + bv[bj][1];
                    if (QS) { v0 = v0 * QSCALE; v1 = v1 * QSCALE; }
                    if (ST) { float* sp = st + ((size_t)((row >> 8) * 512 + layer * 256 + (row & 255))) * 512 + colbase + bj * 128; *(f32x4*)sp = v0; *(f32x4*)(sp + 4) = v1; }
                    if (ACT) {
#pragma unroll
                        for (int j = 0; j < 4; ++j) { v0[j] = silu_f(v0[j]); v1[j] = silu_f(v1[j]); } }
                    u32x4 w; w.x = cvt_pk_bf16(v0[0], v0[1]); w.y = cvt_pk_bf16(v0[2], v0[3]); w.z = cvt_pk_bf16(v1[0], v1[1]); w.w = cvt_pk_bf16(v1[2], v1[3]);
                    *(u32x4*)(dst + (size_t)row * 512 + colbase + bj * 128) = w; } }
    }
    __device__ __forceinline__ void operator()(accm_t& acc, const pg8::Unit& u, int wr, int wc, int fr, int fq) const {
        asm volatile("" : "+v"(fr), "+v"(fq));
        const int row0 = rowbase + u.pm * (64 * MB_) + wr * (16 * MB_) + fr, c8 = wc * 32 + 8 * fq, pn = u.pn;
        const bool ctxrows = rowbase + u.pm * (64 * MB_) < NCTX;
        unsigned char* wsb = kws();
        bf16_t* Q = (bf16_t*)(wsb + WS_Q); bf16_t* K = (bf16_t*)(wsb + WS_K); bf16_t* V = (bf16_t*)(wsb + WS_V); bf16_t* SZA = (bf16_t*)(wsb + WS_SZA); bf16_t* U = (bf16_t*)(wsb + WS_U);
        bf16_t* SZB = (bf16_t*)(wsb + WS_SZB); bf16_t* GR = (bf16_t*)(wsb + WS_GR); bf16_t* GB = (bf16_t*)(wsb + WS_GB);
        const int tr0 = rowbase + u.pm * (64 * MB_), tg = tr0 < NCTX ? 0 : 1 + ((tr0 - NCTX) >> 11);
        const float* bp = FU ? (const float*)(wsb + WS_CVEC) + tg * DIN + pn * 256 + c8 : (const float*)(wsb + WS_BIASP) + layer * DIN + pn * 256 + c8;
        if (FU) { const float* rss = (const float*)(wsb + WS_RSS); float rq[2][MB_];
#pragma unroll
            for (int ai = 0; ai < 2; ++ai)
#pragma unroll
                for (int m = 0; m < MB_; ++m) rq[ai][m] = rss[row0 + ai * (32 * MB_) + m * 16];
#pragma unroll
            for (int ai = 0; ai < 2; ++ai)
#pragma unroll
                for (int m = 0; m < MB_; ++m) { const float rs = rsqrtf(rq[ai][m] * (1.0f / D) + EPS);
#pragma unroll
                    for (int bj = 0; bj < 2; ++bj) { acc[ai][bj][m][0] = acc[ai][bj][m][0] * rs; acc[ai][bj][m][1] = acc[ai][bj][m][1] * rs; } } }
        float* stk = kout() + (size_t)M * D; float* stv = stk + (size_t)16 * 2 * 256 * 512;
        f32x4 bv[2][2];
#pragma unroll
        for (int bj = 0; bj < 2; ++bj)
#pragma unroll
            for (int n = 0; n < 2; ++n) bv[bj][n] = *(const f32x4*)(bp + bj * 128 + 4 * n);
        const int colbase = (pn & 1) * 256 + c8;
        if (pn < 2) plain<false, false, true>(acc, bv, Q, nullptr, row0, colbase);
        else if (pn < 4) { if (ctxrows) plain<false, true>(acc, bv, K, stk, row0, colbase); else plain<false, false>(acc, bv, K, nullptr, row0, colbase); }
        else if (pn < 6) { if (ctxrows) plain<false, true>(acc, bv, V, stv, row0, colbase); else plain<false, false>(acc, bv, V, nullptr, row0, colbase); }
        else if (pn < 8) plain<true, false>(acc, bv, SZA, nullptr, row0, colbase);
        else if (pn == 12 || pn == 13) plain<true, false>(acc, bv, SZB, nullptr, row0, colbase);
        else if (pn < 12) {
            const int cb = (pn - 8) * 128 + c8;
#pragma unroll
            for (int ai = 0; ai < 2; ++ai)
#pragma unroll
                for (int m = 0; m < MB_; ++m) { const int row = row0 + ai * (32 * MB_) + m * 16;
                    f32x4 a0 = acc[ai][0][m][0] + bv[0][0], a1 = acc[ai][0][m][1] + bv[0][1], b0 = acc[ai][1][m][0] + bv[1][0], b1 = acc[ai][1][m][1] + bv[1][1];
#pragma unroll
                    for (int j = 0; j < 4; ++j) { a0[j] *= sigmoid_f(b0[j]); a1[j] *= sigmoid_f(b1[j]); }
                    u32x4 w; w.x = cvt_pk_bf16(a0[0], a0[1]); w.y = cvt_pk_bf16(a0[2], a0[3]); w.z = cvt_pk_bf16(a1[0], a1[1]); w.w = cvt_pk_bf16(a1[2], a1[3]);
                    *(u32x4*)(U + (size_t)row * 512 + cb) = w; }
        } else {
            const int cb = (pn - 14) * 128 + c8;
#pragma unroll
            for (int ai = 0; ai < 2; ++ai)
#pragma unroll
                for (int m = 0; m < MB_; ++m) { const int row = row0 + ai * (32 * MB_) + m * 16;
                    f32x4 a0 = acc[ai][0][m][0] + bv[0][0], a1 = acc[ai][0][m][1] + bv[0][1], b0 = acc[ai][1][m][0] + bv[1][0], b1 = acc[ai][1][m][1] + bv[1][1];
                    f32x4 r0, r1, g0, g1;
#pragma unroll
                    for (int j = 0; j < 4; ++j) {
                        const float ea0 = __expf(-a0[j]), ea1 = __expf(-a1[j]), eb0 = fminf(__expf(-b0[j]), 1e30f), eb1 = fminf(__expf(-b1[j]), 1e30f);
                        g0[j] = __builtin_amdgcn_rcpf(1.0f + eb0); g1[j] = __builtin_amdgcn_rcpf(1.0f + eb1);
                        r0[j] = (1.0f + eb0) * __builtin_amdgcn_rcpf(1.0f + ea0); r1[j] = (1.0f + eb1) * __builtin_amdgcn_rcpf(1.0f + ea1); }
                    u32x4 w; w.x = cvt_pk_bf16(r0[0], r0[1]); w.y = cvt_pk_bf16(r0[2], r0[3]); w.z = cvt_pk_bf16(r1[0], r1[1]); w.w = cvt_pk_bf16(r1[2], r1[3]);
                    *(u32x4*)(GR + (size_t)row * 1024 + cb) = w;
                    w.x = cvt_pk_bf16(g0[0], g0[1]); w.y = cvt_pk_bf16(g0[2], g0[3]); w.z = cvt_pk_bf16(g1[0], g1[1]); w.w = cvt_pk_bf16(g1[2], g1[3]);
                    *(u32x4*)(GB + (size_t)row * 1024 + cb) = w; }
        }
    }
};

struct EpiProj {
    static constexpr bool PERM = true, SPLIT2 = false, MIDHOOK = true; static constexpr int MB = 3;
    __device__ __forceinline__ void mid(acc3_t& acc, const pg8::Unit& u, int wr, int wc, int fr, int fq) const {
        asm volatile("" : "+v"(fr), "+v"(fq));
        const int row0 = u.pm * 192 + wr * 48 + fr, col0 = u.pn * 256 + wc * 32 + 8 * fq;
        const bf16_t* G = WSP(bf16_t, WS_GR);
#pragma unroll
        for (int ai = 0; ai < 2; ++ai)
#pragma unroll
            for (int m = 0; m < 3; ++m) { const size_t off = (size_t)(row0 + ai * 96 + m * 16) * 1024 + col0;
#pragma unroll
                for (int bj = 0; bj < 2; ++bj) { const u32x4 w = *(const u32x4*)(G + off + bj * 128);
                    acc[ai][bj][m][0] = acc[ai][bj][m][0] * (f32x4){bflo(w.x), bfhi(w.x), bflo(w.y), bfhi(w.y)}; acc[ai][bj][m][1] = acc[ai][bj][m][1] * (f32x4){bflo(w.z), bfhi(w.z), bflo(w.w), bfhi(w.w)}; } }
    }
    __device__ __forceinline__ void operator()(acc3_t& acc, const pg8::Unit& u, int wr, int wc, int fr, int fq) const {
        asm volatile("" : "+v"(fr), "+v"(fq));
        const int row0 = u.pm * 192 + wr * 48 + fr, col0 = u.pn * 256 + wc * 32 + 8 * fq;
        unsigned char* wsb = kws();
        const bf16_t* G = (const bf16_t*)(wsb + WS_GB); bf16_t* Mo = (bf16_t*)(wsb + WS_H);
#pragma unroll
        for (int ai = 0; ai < 2; ++ai)
#pragma unroll
            for (int m = 0; m < 3; ++m) { const size_t off = (size_t)(row0 + ai * 96 + m * 16) * 1024 + col0;
#pragma unroll
                for (int bj = 0; bj < 2; ++bj) { const u32x4 w = *(const u32x4*)(G + off + bj * 128);
                    const f32x4 v0 = acc[ai][bj][m][0] * (f32x4){bflo(w.x), bfhi(w.x), bflo(w.y), bfhi(w.y)}, v1 = acc[ai][bj][m][1] * (f32x4){bflo(w.z), bfhi(w.z), bflo(w.w), bfhi(w.w)};
                    u32x4 o; o.x = cvt_pk_bf16(v0[0], v0[1]); o.y = cvt_pk_bf16(v0[2], v0[3]); o.z = cvt_pk_bf16(v1[0], v1[1]); o.w = cvt_pk_bf16(v1[2], v1[3]);
                    *(u32x4*)(Mo + off + bj * 128) = o; }
                asm volatile("" ::: "memory"); }
    }
};

template <bool LAST> struct EpiOutT {
    static constexpr bool PERM = true, SPLIT2 = false, MIDHOOK = false; static constexpr int MB = 3;
    int layer;
    __device__ __forceinline__ void operator()(acc3_t& acc, const pg8::Unit& u, int wr, int wc, int fr, int fq) const {
        asm volatile("" : "+v"(fr), "+v"(fq));
        const int row0 = u.pm * 192 + wr * 48 + fr, col0 = u.pn * 256 + wc * 32 + 8 * fq;
        const float* modl = WSP(float, WS_MOD) + layer * 5 * 3072 + 2048 + col0;
        const float* xp = kin(I_X_PROMPT); const float* xs = kin(I_X_SAMPLE) - (size_t)NCTX * D;
        bf16_t* X1 = WSP(bf16_t, WS_X1); bf16_t* XG = WSP(bf16_t, WS_YAB);
        float* rss = WSP(float, LAST ? WS_RSS2 : WS_RSS);
        const float* gfin = kin(I_FINAL_G) + col0;
        float olds[6];
#pragma unroll
        for (int ai = 0; ai < 2; ++ai)
#pragma unroll
            for (int m = 0; m < 3; ++m) { const int row = row0 + ai * 96 + m * 16; const size_t off = (size_t)row * D + col0;
                const int g = row < NCTX ? 0 : 1 + ((row - NCTX) >> 11);
                const float* gate = modl + g * 3072; const float* xin = row < NCTX ? xp : xs;
                float ssq = 0.f;
#pragma unroll
                for (int bj = 0; bj < 2; ++bj) { const size_t o_ = off + bj * 128;
                    const f32x4 gv0 = *(const f32x4*)(gate + bj * 128), gv1 = *(const f32x4*)(gate + bj * 128 + 4);
                    f32x4 xi0, xi1;
                    if (LAST) { const u32x4 xw = *(const u32x4*)(X1 + o_); xi0 = (f32x4){bflo(xw.x), bfhi(xw.x), bflo(xw.y), bfhi(xw.y)}; xi1 = (f32x4){bflo(xw.z), bfhi(xw.z), bflo(xw.w), bfhi(xw.w)}; }
                    else { xi0 = *(const f32x4*)(xin + o_); xi1 = *(const f32x4*)(xin + o_ + 4); }
                    const f32x4 xn0 = xi0 + gv0 * acc[ai][bj][m][0], xn1 = xi1 + gv1 * acc[ai][bj][m][1];
                    ssq += ((xn0[0] * xn0[0] + xn0[1] * xn0[1]) + (xn0[2] * xn0[2] + xn0[3] * xn0[3])) + ((xn1[0] * xn1[0] + xn1[1] * xn1[1]) + (xn1[2] * xn1[2] + xn1[3] * xn1[3]));
                    const float* gmp = LAST ? gfin + bj * 128 : WSP(float, WS_GM) + g * 1024 + col0 + bj * 128;
                    const f32x4 y0 = xn0 * *(const f32x4*)gmp, y1 = xn1 * *(const f32x4*)(gmp + 4);
                    if (LAST) { acc[ai][bj][m][0] = y0; acc[ai][bj][m][1] = y1; }
                    else { u32x4 w; w.x = cvt_pk_bf16(y0[0], y0[1]); w.y = cvt_pk_bf16(y0[2], y0[3]); w.z = cvt_pk_bf16(y1[0], y1[1]); w.w = cvt_pk_bf16(y1[2], y1[3]);
                        *(u32x4*)(XG + o_) = w;
                        u32x4 xw; xw.x = cvt_pk_bf16(xn0[0], xn0[1]); xw.y = cvt_pk_bf16(xn0[2], xn0[3]); xw.z = cvt_pk_bf16(xn1[0], xn1[1]); xw.w = cvt_pk_bf16(xn1[2], xn1[3]);
                        *(u32x4*)(X1 + o_) = xw; } }
                ssq += __shfl_xor(ssq, 16); ssq += __shfl_xor(ssq, 32);
                float o = 0.f;
                if (LAST) { if (fq == 0) o = __hip_atomic_fetch_add(rss + row, ssq, __ATOMIC_RELAXED, __HIP_MEMORY_SCOPE_AGENT); }
                else { if (fq == 0) (void)__hip_atomic_fetch_add(rss + row, ssq, __ATOMIC_RELAXED, __HIP_MEMORY_SCOPE_AGENT); }
                olds[ai * 3 + m] = o;
                asm volatile("" ::: "memory"); }
        if constexpr (LAST) {
            asm volatile("" :: "v"(olds[0]), "v"(olds[1]), "v"(olds[2]), "v"(olds[3]), "v"(olds[4]), "v"(olds[5]));
            asm volatile("s_waitcnt vmcnt(0)" ::: "memory");
            __syncthreads();
            if (fresh_tid() == 0) { unsigned* cnt = WSP(unsigned, WS_CTL) + CW_ROWBLK + u.pm * 16;
                (void)__hip_atomic_fetch_add(cnt, 1u, __ATOMIC_RELAXED, __HIP_MEMORY_SCOPE_AGENT);
                unsigned sp = 0; while (__hip_atomic_load(cnt, __ATOMIC_RELAXED, __HIP_MEMORY_SCOPE_AGENT) < 4u) { __builtin_amdgcn_s_sleep(1); if (++sp > (1u << 22)) break; } }
            __syncthreads();
            float* out = kout();
            float sq[6];
#pragma unroll
            for (int k = 0; k < 6; ++k) sq[k] = __hip_atomic_load(rss + row0 + (k / 3) * 96 + (k % 3) * 16, __ATOMIC_RELAXED, __HIP_MEMORY_SCOPE_AGENT);
#pragma unroll
            for (int ai = 0; ai < 2; ++ai)
#pragma unroll
                for (int m = 0; m < 3; ++m) { const int row = row0 + ai * 96 + m * 16; float* yr = out + (size_t)row * D + col0;
                    const float rstd = rsqrtf(sq[ai * 3 + m] * (1.f / D) + EPS);
#pragma unroll
                    for (int bj = 0; bj < 2; ++bj) { *(f32x4*)(yr + bj * 128) = acc[ai][bj][m][0] * rstd; *(f32x4*)(yr + bj * 128 + 4) = acc[ai][bj][m][1] * rstd; } }
        }
    }
};

#define XB_TMO      128
#define XB_XCNT(j)  (256  + 64 * (j))
#define XB_XSUB(j)  (1280 + 64 * (j))
#define XB_XGEN(j)  (2304 + 64 * (j))
#define XB_TOP      3328
#define XB_TOPGEN   3392
#define XCD_BAR_WORDS 3456
#define XB_SPIN_CAP (1u << 18)
__device__ __forceinline__ unsigned xb_ld(unsigned* p)              { return __hip_atomic_load(p, __ATOMIC_RELAXED, __HIP_MEMORY_SCOPE_AGENT); }
__device__ __forceinline__ unsigned xb_add(unsigned* p, unsigned v) { return __hip_atomic_fetch_add(p, v, __ATOMIC_RELAXED, __HIP_MEMORY_SCOPE_AGENT); }
__device__ __forceinline__ unsigned xb_xcc_id() { return (unsigned)__builtin_amdgcn_s_getreg((3 << 11) | 20) & 0xFu; }
#define XB_SPIN(cond, bar) do { unsigned _sp = 0; while (cond) { __builtin_amdgcn_s_sleep(1); \
    if ((++_sp & 255u) == 0u) { if (xb_ld(&(bar)[XB_TMO])) break; if (_sp > XB_SPIN_CAP) { atomicAdd(&(bar)[XB_TMO], 1u); break; } } } } while (0)
struct XcdBarrier { unsigned* bar; unsigned x; volatile LAS unsigned* st; };
__device__ __forceinline__ XcdBarrier xcd_barrier_post(unsigned* bar, volatile LAS unsigned* st) {
    XcdBarrier b; b.bar = bar; b.x = xb_xcc_id(); b.st = st;
    if (threadIdx.x == 0) (void)xb_add(&bar[XB_XCNT(b.x)], 1u);
    return b;
}
__device__ __forceinline__ void xcd_barrier_complete(unsigned* bar, unsigned x, unsigned& nloc, unsigned& nx) {
    const unsigned G = gridDim.x * gridDim.y * gridDim.z;
    unsigned sum, cnt, mine, sp = 0u;
    for (;;) {
        sum = 0u; cnt = 0u; mine = 0u;
#pragma unroll
        for (unsigned j = 0; j < 16; ++j) { const unsigned c = xb_ld(&bar[XB_XCNT(j)]); sum += c; cnt += (c > 0u) ? 1u : 0u; mine = (j == x) ? c : mine; }
        if (sum == G) break;
        __builtin_amdgcn_s_sleep(1);
        if ((++sp & 255u) == 0u) { if (xb_ld(&bar[XB_TMO])) break; if (sp > XB_SPIN_CAP) { atomicAdd(&bar[XB_TMO], 1u); break; } }
    }
    nloc = mine > 0u ? mine : 1u; nx = cnt > 0u ? cnt : 1u;
}
__device__ __forceinline__ void xcd_barrier(const XcdBarrier& b) {
    asm volatile("s_waitcnt vmcnt(0)" ::: "memory");
    __syncthreads();
    if (fresh_tid() == 0) {
        unsigned* bar = b.bar;
        __builtin_amdgcn_s_waitcnt(0);
        unsigned nloc = b.st[0], nx = b.st[1];
        if (nloc == 0u) { xcd_barrier_complete(bar, b.x, nloc, nx); b.st[0] = nloc; b.st[1] = nx; }
        const unsigned old = xb_add(&bar[XB_XSUB(b.x)], 1u);
        const unsigned gen = old / nloc;
        if (old + 1u == (gen + 1u) * nloc) {
            __builtin_amdgcn_fence(__ATOMIC_RELEASE, "agent");
            asm volatile("s_waitcnt vmcnt(0)" ::: "memory");
            const unsigned og = xb_add(&bar[XB_TOP], 1u);
            const unsigned tg = og / nx;
            if (og + 1u == (tg + 1u) * nx) xb_add(&bar[XB_TOPGEN], 1u);
            else XB_SPIN(xb_ld(&bar[XB_TOPGEN]) == tg, bar);
            __builtin_amdgcn_fence(__ATOMIC_ACQUIRE, "agent");
            xb_add(&bar[XB_XGEN(b.x)], 1u);
            asm volatile("s_waitcnt vmcnt(0)" ::: "memory");
        } else {
            XB_SPIN(xb_ld(&bar[XB_XGEN(b.x)]) == gen, bar);
            __builtin_amdgcn_fence(__ATOMIC_ACQUIRE, "agent");
            asm volatile("s_waitcnt vmcnt(0)" ::: "memory");
        }
    }
    __syncthreads();
}

struct Frame {
    LAS unsigned char* lds;
    int tid, lane, wave, G, bx;
};


__device__ __forceinline__ int in_srccol(int n) {
    const int tile = n >> 8, r = n & 255;
    if (tile < 8 || tile == 12 || tile == 13) return n;
    if (tile < 12) { const int i = tile - 8; return (r < 128 ? 2048 : 2560) + 128 * i + (r & 127); }
    const int i = tile - 14; return (r < 128 ? 3584 : 4608) + 128 * i + (r & 127);
}

__device__ __forceinline__ void transpose_item(const float* W, int ldw, int srccol0, int k0, bf16_t* WT, int dstrow0, int dstk0, LAS float* scr, int lane) {
    float tv[32];
#pragma unroll
    for (int i = 0; i < 32; ++i) { const int kk = 2 * i + (lane >> 5); tv[i] = W[(size_t)(k0 + kk) * ldw + srccol0 + (lane & 31)]; }
#pragma unroll
    for (int i = 0; i < 32; ++i) { const int kk = 2 * i + (lane >> 5); scr[kk * 33 + (lane & 31)] = tv[i]; }
    LDS_WAIT(); asm volatile("" ::: "memory");
    const int c = lane & 7;
#pragma unroll
    for (int j = 0; j < 4; ++j) { const int n = (lane >> 3) + 8 * j; const LAS float* s = scr + (8 * c) * 33 + n;
        u32x4 o; o.x = pk2(s[0 * 33], s[1 * 33]); o.y = pk2(s[2 * 33], s[3 * 33]); o.z = pk2(s[4 * 33], s[5 * 33]); o.w = pk2(s[6 * 33], s[7 * 33]);
        *(GAS u32x4*)(WT + (size_t)(dstrow0 + n) * 1024 + dstk0 + 8 * c) = o; }
    LDS_WAIT(); asm volatile("" ::: "memory");
}

__device__ __forceinline__ void mod_task(Frame& F, int t) {
    const int l = t / 48, j0 = (t % 48) * 64;
    const float* c_ctx = kin(I_C_CTX); const float* cvec = kin(I_C); const float* w_ada = kin(I_W_ADA); const float* b_ada = kin(I_B_ADA); float* MOD = WSP(float, WS_MOD);
    LAS float* sv = (LAS float*)F.lds;
    LAS float* part = (LAS float*)(F.lds + 20480);
    for (int i = F.tid; i < 5 * 1024; i += 512) { const int g = i >> 10, k = i & 1023; const float c = (g == 0) ? c_ctx[k] : cvec[(g - 1) * 1024 + k]; sv[i] = silu_f(c); }
    __syncthreads();
    const float* W = w_ada + (size_t)l * 1024 * 3072 + (size_t)(128 * F.wave) * 3072 + j0 + F.lane;
    float a0 = 0.f, a1 = 0.f, a2 = 0.f, a3 = 0.f, a4 = 0.f;
#pragma unroll 32
    for (int kk = 0; kk < 128; ++kk) { const float wv = W[(size_t)kk * 3072]; const int k = 128 * F.wave + kk;
        a0 += sv[k] * wv; a1 += sv[1024 + k] * wv; a2 += sv[2048 + k] * wv; a3 += sv[3072 + k] * wv; a4 += sv[4096 + k] * wv; }
    part[(F.wave * 5 + 0) * 64 + F.lane] = a0; part[(F.wave * 5 + 1) * 64 + F.lane] = a1; part[(F.wave * 5 + 2) * 64 + F.lane] = a2;
    part[(F.wave * 5 + 3) * 64 + F.lane] = a3; part[(F.wave * 5 + 4) * 64 + F.lane] = a4;
    __syncthreads();
    if (F.tid < 320) { const int g = F.tid >> 6, ln = F.tid & 63; float s = 0.f;
#pragma unroll
        for (int w = 0; w < 8; ++w) s += part[(w * 5 + g) * 64 + ln];
        MOD[(l * 5 + g) * 3072 + j0 + ln] = s + b_ada[l * 3072 + j0 + ln]; }
    __syncthreads();
}

__device__ __forceinline__ void wt_items(Frame& F, int l, int w0, int nw);
__device__ __forceinline__ void p0_prologue(Frame& F) {
    if (F.bx < 96) mod_task(F, F.bx);
    const int gw = F.bx * 8 + F.wave, NGW = F.G * 8;
    const int gt = F.bx * 512 + F.tid, NGT = F.G * 512;
    { float* BIASP = WSP(float, WS_BIASP); const float* b_in = kin(I_B_IN);
      for (int i = gt; i < DEPTH * DIN; i += NGT) { const int l = i / DIN, n = i % DIN; BIASP[i] = b_in[l * DIN + in_srccol(n)]; } }
    const float* cache_k = kin(I_CACHE_K); const float* cache_v = kin(I_CACHE_V); bf16_t* CK = WSP(bf16_t, WS_CK); bf16_t* CV = WSP(bf16_t, WS_CV);
    for (int i0 = gt; i0 < 2 * 131072; i0 += 2 * NGT) { f32x4 a[2], b[2];
#pragma unroll
        for (int k = 0; k < 2; ++k) { const int i = i0 + k * NGT; if (i < 2 * 131072) { const int which = i >> 17, e = (i & 131071) * 8; const float* src = (which ? cache_v : cache_k) + e; a[k] = *(const f32x4*)src; b[k] = *(const f32x4*)(src + 4); } }
#pragma unroll
        for (int k = 0; k < 2; ++k) { const int i = i0 + k * NGT; if (i < 2 * 131072) { const int which = i >> 17, e = (i & 131071) * 8; bf16_t* dst = (which ? CV : CK) + e;
            u32x4 w; w.x = pk2(a[k][0], a[k][1]); w.y = pk2(a[k][2], a[k][3]); w.z = pk2(b[k][0], b[k][1]); w.w = pk2(b[k][2], b[k][3]); *(u32x4*)dst = w; } } }
    wt_items(F, 0, gw, NGW);
    { const int nidle = F.G - (M - 46 * 256) / 128 * (DIN / 256); if (nidle <= 0) wt_items(F, 1, gw, NGW); }
}

__device__ __forceinline__ void wt_items(Frame& F, int l, int w0, int nw) {
    LAS float* scr = (LAS float*)(F.lds + F.wave * 16384);
    const float* w_in = kin(I_W_IN); const float* w_proj_a = kin(I_W_PROJ_A); const float* w_proj_b = kin(I_W_PROJ_B); const float* w_out = kin(I_W_OUT);
    bf16_t* WTIN = WSP(bf16_t, WS_WTIN); bf16_t* WTPROJ = WSP(bf16_t, WS_WTPROJ); bf16_t* WTOUT = WSP(bf16_t, WS_WTOUT);
    constexpr int I_IN = 16 * 176, I_P = 8 * 32, I_O = 16 * 32, I_L = I_IN + 2 * I_P + I_O;
    for (int it = w0; it < I_L; it += nw) {
        int r = it;
        if (r < I_IN) { const int kb = r / 176, nb = r % 176; transpose_item(w_in + (size_t)l * D * DIN, DIN, in_srccol(32 * nb), 64 * kb, WTIN + (size_t)l * DIN * D, 32 * nb, 64 * kb, scr, F.lane); continue; } r -= I_IN;
        if (r < I_P) { const int kb = r / 32, nb = r % 32; transpose_item(w_proj_a + (size_t)l * 512 * D, D, 32 * nb, 64 * kb, WTPROJ + (size_t)l * D * D, 32 * nb, 64 * kb, scr, F.lane); continue; } r -= I_P;
        if (r < I_P) { const int kb = r / 32, nb = r % 32; transpose_item(w_proj_b + (size_t)l * 512 * D, D, 32 * nb, 64 * kb, WTPROJ + (size_t)l * D * D, 32 * nb, 512 + 64 * kb, scr, F.lane); continue; } r -= I_P;
        { const int kb = r / 32, nb = r % 32; transpose_item(w_out + (size_t)l * D * D, D, 32 * nb, 64 * kb, WTOUT + (size_t)l * D * D, 32 * nb, 64 * kb, scr, F.lane); }
    }
}

__device__ __forceinline__ void norm_phase(Frame& F, int layer) {
    const int gw = F.bx * 8 + F.wave, NGW = F.G * 8;
    const float* xa = layer == 0 ? kin(I_X_PROMPT) : kout(); const float* xb = layer == 0 ? kin(I_X_SAMPLE) : kout() + (size_t)NCTX * D;
    const float* MOD = WSP(float, WS_MOD); const float* rms_g = kin(I_RMS_G) + layer * D; bf16_t* H = WSP(bf16_t, WS_H);
    for (int rb = gw; rb < M; rb += 3 * NGW) {
        f32x4 v[3][4];
#pragma unroll
        for (int k = 0; k < 3; ++k) { const int r = rb + k * NGW; if (r < M) {
            const float* xrow = r < NCTX ? xa + (size_t)r * D : xb + (size_t)(r - NCTX) * D; const f32x4* xr = (const f32x4*)xrow + F.lane;
#pragma unroll
            for (int j = 0; j < 4; ++j) v[k][j] = xr[64 * j]; } }
#pragma unroll
        for (int k = 0; k < 3; ++k) { const int r = rb + k * NGW; if (r < M) {
            const int g = r < NCTX ? 0 : 1 + ((r - NCTX) >> 11);
            const float* mod = MOD + (layer * 5 + g) * 3072;
            float s = 0.f;
#pragma unroll
            for (int j = 0; j < 4; ++j) s += (v[k][j][0] * v[k][j][0] + v[k][j][1] * v[k][j][1]) + (v[k][j][2] * v[k][j][2] + v[k][j][3] * v[k][j][3]);
            const float rstd = rsqrtf(wave_sum(s) * (1.f / D) + EPS);
            unsigned long long* o8 = (unsigned long long*)(H + (size_t)r * D) + F.lane;
#pragma unroll
            for (int j = 0; j < 4; ++j) { const int c = 4 * F.lane + 256 * j;
                const f32x4 gg = *(const f32x4*)(rms_g + c), sh = *(const f32x4*)(mod + c), sc = *(const f32x4*)(mod + 1024 + c);
                const f32x4 y = v[k][j] * rstd * gg * (sc + 1.0f) + sh;
                o8[64 * j] = (unsigned long long)cvt_pk_bf16(y[0], y[1]) | ((unsigned long long)cvt_pk_bf16(y[2], y[3]) << 32); } } }
    }
}

struct AttnPre { u32x4 qrow[4], pa0, pc0, pa1, kreg, vreg, kreg2, vreg2; float bvv[8]; };
__device__ __forceinline__ void attn_prefetch(Frame& F, int layer, int task, const bool ctx, AttnPre& P);
__device__ __forceinline__ void conv_task(Frame& F, int layer, int tile, AttnPre& pre, int pre_task) {
    const int t0 = tile * 32;
    int s0, s1; if (t0 < NCTX) { s0 = t0 & ~255; s1 = s0 + 256; } else { s0 = NCTX + ((t0 - NCTX) & ~2047); s1 = s0 + 2048; }
    const bf16_t* Ub = WSP(bf16_t, WS_U); const bf16_t* SZB = WSP(bf16_t, WS_SZB); bf16_t* YAB = WSP(bf16_t, WS_YAB);
    const float* dw_w = kin(I_DW_W); const float* dw_b = kin(I_DW_B); const float* ln_g = kin(I_LN_G) + layer * 512; const float* ln_b = kin(I_LN_B) + layer * 512;
    LAS unsigned* Ul = (LAS unsigned*)F.lds;
    LAS float* Cl = (LAS float*)(F.lds + 62 * 1024);
    u32x4 xs[8];
#pragma unroll
    for (int k = 0; k < 8; ++k) { const int i = F.tid + 512 * k; const int lr = i >> 6, ch = i & 63; const int t = t0 - 15 + lr; xs[k] = (u32x4){0u, 0u, 0u, 0u};
        if (i < 62 * 64 && t >= s0 && t < s1) xs[k] = *(const u32x4*)(Ub + (size_t)t * 512 + ch * 8); }
    const int cp = F.tid & 255, th = F.tid >> 8;
    float w0[31], w1[31];
#pragma unroll
    for (int j = 0; j < 31; ++j) { const f32x2 w = *(const f32x2*)(dw_w + (size_t)(layer * 31 + j) * 512 + 2 * cp); w0[j] = w[0]; w1[j] = w[1]; }
    const f32x2 bb = *(const f32x2*)(dw_b + layer * 512 + 2 * cp);
    u32x2 zq[4][2];
#pragma unroll
    for (int k = 0; k < 4; ++k) { const int t = t0 + F.wave * 4 + k; zq[k][0] = *(const u32x2*)(SZB + (size_t)t * 512 + 4 * F.lane); zq[k][1] = *(const u32x2*)(SZB + (size_t)t * 512 + 256 + 4 * F.lane); }
#pragma unroll
    for (int k = 0; k < 8; ++k) { const int i = F.tid + 512 * k; if (i < 62 * 64) *(LAS u32x4*)(Ul + (i >> 6) * 256 + (i & 63) * 4) = xs[k]; }
    __syncthreads();
    {
        for (int blk = 0; blk < 4; ++blk) { const int tt0 = th * 16 + blk * 4;
            float a0[4], a1[4];
#pragma unroll
            for (int o = 0; o < 4; ++o) { a0[o] = bb[0]; a1[o] = bb[1]; }
#pragma unroll
            for (int i = 0; i < 34; ++i) { const unsigned x = Ul[(tt0 + i) * 256 + cp]; const float x0 = bflo(x), x1 = bfhi(x);
#pragma unroll
                for (int o = 0; o < 4; ++o) { const int j = i - o; if (j >= 0 && j < 31) { a0[o] += w0[j] * x0; a1[o] += w1[j] * x1; } } }
#pragma unroll
            for (int o = 0; o < 4; ++o) *(LAS f32x2*)(Cl + (tt0 + o) * 512 + 2 * cp) = (f32x2){a0[o], a1[o]};
        }
    }
    __syncthreads();
    const f32x4 g0 = *(const f32x4*)(ln_g + 4 * F.lane), g1 = *(const f32x4*)(ln_g + 256 + 4 * F.lane);
    const f32x4 b0 = *(const f32x4*)(ln_b + 4 * F.lane), b1 = *(const f32x4*)(ln_b + 256 + 4 * F.lane);
    asm volatile("" ::: "memory");
    if (pre_task >= 0) attn_prefetch(F, layer, pre_task, false, pre);
    asm volatile("" ::: "memory");
#pragma unroll
    for (int k = 0; k < 4; ++k) { const int tt = F.wave * 4 + k, t = t0 + tt;
        f32x4 v0 = *(LAS f32x4*)(Cl + tt * 512 + 4 * F.lane), v1 = *(LAS f32x4*)(Cl + tt * 512 + 256 + 4 * F.lane);
        const float mean = wave_sum((v0[0] + v0[1]) + (v0[2] + v0[3]) + (v1[0] + v1[1]) + (v1[2] + v1[3])) * (1.f / 512.f);
        v0 = v0 - mean; v1 = v1 - mean;
        const float var = wave_sum((v0[0] * v0[0] + v0[1] * v0[1]) + (v0[2] * v0[2] + v0[3] * v0[3]) + (v1[0] * v1[0] + v1[1] * v1[1]) + (v1[2] * v1[2] + v1[3] * v1[3])) * (1.f / 512.f);
        const float rstd = rsqrtf(var + EPS);
        f32x4 y0 = v0 * rstd * g0 + b0, y1 = v1 * rstd * g1 + b1;
        const u32x2 z0 = zq[k][0], z1 = zq[k][1];
        const f32x4 zz0 = (f32x4){bflo(z0.x), bfhi(z0.x), bflo(z0.y), bfhi(z0.y)}, zz1 = (f32x4){bflo(z1.x), bfhi(z1.x), bflo(z1.y), bfhi(z1.y)};
#pragma unroll
        for (int j = 0; j < 4; ++j) { y0[j] = silu_f(y0[j]) * zz0[j]; y1[j] = silu_f(y1[j]) * zz1[j]; }
        u32x2 o0, o1; o0.x = cvt_pk_bf16(y0[0], y0[1]); o0.y = cvt_pk_bf16(y0[2], y0[3]); o1.x = cvt_pk_bf16(y1[0], y1[1]); o1.y = cvt_pk_bf16(y1[2], y1[3]);
        *(u32x2*)(YAB + (size_t)t * 1024 + 512 + 4 * F.lane) = o0; *(u32x2*)(YAB + (size_t)t * 1024 + 768 + 4 * F.lane) = o1;
    }
    __syncthreads();
}

typedef float f32x16 __attribute__((ext_vector_type(16)));
typedef short s16x4 __attribute__((ext_vector_type(4)));
typedef __bf16 bf16x2_t __attribute__((ext_vector_type(2)));
__device__ __forceinline__ unsigned cvtpk_s(float lo, float hi) { f32x2 v = {lo, hi}; bf16x2_t b = __builtin_convertvector(v, bf16x2_t); return __builtin_bit_cast(unsigned, b); }
__device__ __forceinline__ s16x4 vtr(const LAS char* p) { return __builtin_bit_cast(s16x4, __builtin_amdgcn_ds_read_tr16_b64_v4i16((LAS s16x4*)p)); }
#define MFMA32(a, b, c) __builtin_amdgcn_mfma_f32_32x32x16_bf16((a), (b), (c), 0, 0, 0)
constexpr float LOG2E = 1.4426950408889634f;
constexpr float ATT_QSCALE = 0.125f * LOG2E;
constexpr int AT_SLOTB = 8192, AT_K = 0, AT_V = 3 * AT_SLOTB, AT_TBL = 6 * AT_SLOTB;
constexpr int AT_VSTRIDE = 68, AT_ROWF = 16 * AT_VSTRIDE + 52, AT_INF = AT_TBL + 15 * AT_ROWF * 4, AT_ZERO = AT_INF + 512, AT_END = AT_ZERO + 512;
static_assert(AT_END <= RING_BYTES, "attention LDS");
constexpr float ATT_THR = 8.0f;

#define ATT_DECODE() \
    int b, h, R0, r = 0, n_win = 0, lo = 0, qc = 0, r0 = 0; \
    if (!ctx) { const int R = 4 * (task & 7); h = (task >> 3) & 7; b = task >> 6; r = R + (wid >> 1); const int HALF = wid & 1; \
        R0 = NCTX + b * 2048 + r * 64 + HALF * 32; qc = HALF * 32 + r32; r0 = min(max(r - 4, 0), 24); \
        lo = min(max(R - 4, 0), 24); n_win = min(max(R - 1, 0), 24) + 8 - lo; \
    } else { h = task & 7; b = task >> 3; R0 = b * 256 + wid * 32; } \
    const int NT = n_win + 4; (void)qc; (void)r0; (void)r; (void)NT; \
    const unsigned ksoff = (unsigned)(lane * 512 + wid * 8), vsoff = (unsigned)((16 * (wid & 3) + (lane >> 2)) * 512 + (wid >> 2) * 32 + (lane & 3) * 8);
#define ATT_SRC(t, KP, VP) do { if ((t) < n_win) { const size_t o_ = (size_t)(NCTX + b * 2048 + (lo + (t)) * 64) * 512 + h * 64; KP = (const bf16_t*)(wsb + WS_K) + o_; VP = (const bf16_t*)(wsb + WS_V) + o_; } \
        else if (ctx) { const size_t o_ = (size_t)(b * 256 + ((t) - n_win) * 64) * 512 + h * 64; KP = (const bf16_t*)(wsb + WS_K) + o_; VP = (const bf16_t*)(wsb + WS_V) + o_; } \
        else { const size_t o_ = ((size_t)((b * 2 + layer) * 256 + ((t) - n_win) * 64)) * 512 + h * 64; KP = (const bf16_t*)(wsb + WS_CK) + o_; VP = (const bf16_t*)(wsb + WS_CV) + o_; } } while (0)
__device__ __forceinline__ void attn_prefetch(Frame& F, int layer, int task, const bool ctx, AttnPre& P) {
    const int tid = fresh_tid(), lane = tid & 63, r32 = lane & 31, wid = __builtin_amdgcn_readfirstlane(tid >> 6);
    unsigned char* wsb = kws();
    ATT_DECODE()
    { const bf16_t* qp = (const bf16_t*)(wsb + WS_Q) + (size_t)(R0 + (lane >> 3)) * 512 + h * 64 + (lane & 7) * 8;
#pragma unroll
      for (int i = 0; i < 4; ++i) P.qrow[i] = *(const u32x4*)(qp + (size_t)i * 8 * 512); }
    { const bf16_t *k0, *v0, *k1, *v1, *k2, *v2, *k3, *v3; ATT_SRC(0, k0, v0); ATT_SRC(1, k1, v1); ATT_SRC(2, k2, v2); ATT_SRC(3, k3, v3); (void)v3;
      P.pa0 = *(const u32x4*)(k0 + ksoff); P.pc0 = *(const u32x4*)(v0 + vsoff); P.pa1 = *(const u32x4*)(k1 + ksoff);
      P.kreg = *(const u32x4*)(k2 + ksoff); P.vreg = *(const u32x4*)(v1 + vsoff); P.kreg2 = *(const u32x4*)(k3 + ksoff); P.vreg2 = *(const u32x4*)(v2 + vsoff); }
    if (!ctx) { const float* rb = kin(I_REL_BIAS) + (size_t)(layer * 8 + h) * 465;
#pragma unroll
        for (int k = 0; k < 8; ++k) { const int i = tid + 512 * k, dr = i >> 8, v = (i >> 4) & 15, j = i & 15; P.bvv[k] = (i < 3840) ? rb[dr * 31 + v + j] : 0.f; } }
}

__device__ __forceinline__ void attn_wg(Frame& F, int layer, int task, const bool ctx, AttnPre& P, int next_ctx) {
    const int tid = fresh_tid(), lane = tid & 63, r32 = lane & 31, hi = lane >> 5, wid = __builtin_amdgcn_readfirstlane(tid >> 6);
    LAS char* L = (LAS char*)F.lds;
    unsigned char* wsb = kws();
    ATT_DECODE()
    const int kdst = AT_K + wid * 1024 + lane * 16, vdst = AT_V + wid * 1024 + lane * 16;
    u32x4 kreg = P.kreg, vreg = P.vreg, kreg2 = P.kreg2, vreg2 = P.vreg2;
    bf16x8 qr[4];
    { LAS char* stg = L + AT_TBL + wid * 4608; LAS char* srow = stg + (lane >> 3) * 144 + (lane & 7) * 16;
#pragma unroll
      for (int i = 0; i < 4; ++i) *(LAS u32x4*)(srow + i * 8 * 144) = P.qrow[i];
      asm volatile("s_waitcnt lgkmcnt(0)" ::: "memory");
#pragma unroll
      for (int s_ = 0; s_ < 4; ++s_) qr[s_] = *(const LAS bf16x8*)(stg + r32 * 144 + hi * 16 + s_ * 32);
      asm volatile("s_waitcnt lgkmcnt(0)" ::: "memory"); }
    { unsigned zz = 0u; asm volatile("" : "+v"(zz));
      if (tid < 32) *(LAS u32x4*)(L + AT_ZERO + 16 * tid) = (u32x4){zz, zz, zz, zz}; }
    if (!ctx) { unsigned ninf = 0xff800000u; asm volatile("" : "+v"(ninf));
        for (int i = lane; i < 4608 / 16; i += 64) *(LAS u32x4*)(L + AT_TBL + wid * 4608 + 16 * i) = (u32x4){ninf, ninf, ninf, ninf};
        for (int i = 8 * 4608 / 16 + tid; i < (AT_ZERO - AT_TBL) / 16; i += 512) *(LAS u32x4*)(L + AT_TBL + 16 * i) = (u32x4){ninf, ninf, ninf, ninf}; }
    *(LAS u32x4*)(L + kdst) = P.pa0; *(LAS u32x4*)(L + vdst) = P.pc0; *(LAS u32x4*)(L + AT_SLOTB + kdst) = P.pa1;
    if (!ctx) {
        asm volatile("s_waitcnt lgkmcnt(0)\n\ts_barrier" ::: "memory");
#pragma unroll
        for (int k = 0; k < 8; ++k) { const int i = tid + 512 * k, dr = i >> 8, v = (i >> 4) & 15, j = i & 15; if (i < 3840) *(LAS float*)(L + AT_TBL + (dr * AT_ROWF + v * AT_VSTRIDE + 48 + j) * 4) = P.bvv[k] * LOG2E; }
    }
    const int HALFW = ctx ? 0 : (wid & 1);
    const LAS char* kpA = L + AT_K + hi * 1024 + (32 * HALFW + r32) * 16;
    const LAS char* kpB = L + AT_K + hi * 1024 + (32 * (1 - HALFW) + ((r32 + 24 * HALFW) & 31)) * 16;
    const LAS char* vp0 = L + AT_V + ((lane >> 4) & 1) * 32 + (lane & 3) * 8 + (4 * hi + ((lane & 15) >> 2)) * 64;
    const int H2 = HALFW * 2048, O2 = (1 - HALFW) * 2048, rot = 3 * HALFW;
    const int vol0 = H2, voh0 = H2 + 512, vol1 = H2 + 1024, voh1 = H2 + 1536;
    const int vol2 = O2 + ((0 + rot) & 3) * 512, voh2 = O2 + ((1 + rot) & 3) * 512, vol3 = O2 + ((2 + rot) & 3) * 512, voh3 = O2 + ((3 + rot) & 3) * 512;
    const int vsh = (qc < 8 ? 8 - qc : (qc > 56 ? 56 - qc : 0)) + 7;
    const int tlane = AT_TBL + (67 * vsh + 4 * hi - qc + 63) * 4;
    const int offA = 128 * HALFW, offB = HALFW ? 96 : 128;
    const int NWP = n_win + ((n_win > 0 && ((n_win - 1) & 1)) ? 1 : 0), NTV = NWP + 4;
#define VT(t) ((t) < n_win ? (t) : ((t) < NWP ? n_win - 1 : (t) - (NWP - n_win)))
    float mhat = -INFINITY, l_reg = 0.f, fres = 1.f; bool resc = false;
    f32x16 o0, o1;
#pragma unroll
    for (int i = 0; i < 16; ++i) { o0[i] = 0.f; o1[i] = 0.f; }
    f32x16 pA0, pA1, pB0, pB1; bf16x8 kf[8]; s16x4 vlo[8], vhi[8]; u32x4 pw0, pw1, pw2, pw3;
#pragma unroll
    for (int i = 0; i < 16; ++i) { pA1[i] = 0.f; pB1[i] = 0.f; }
    int sl_prev = 0, sl_cur = 0, sl_next = AT_SLOTB;
#define SBAR() __builtin_amdgcn_sched_barrier(0)
#define PIN(x) asm volatile("" : "+v"(x))
#define WBAR() asm volatile("s_waitcnt lgkmcnt(0)\n\ts_barrier" ::: "memory")
#define ROT() do { sl_prev = sl_cur; sl_cur = sl_next; sl_next = (sl_next == 2 * AT_SLOTB) ? 0 : sl_next + AT_SLOTB; } while (0)
#define MX3(a, b, c) __builtin_fmaxf(__builtin_fmaxf((a), (b)), (c))
#define KLD2(so, j) do { kf[2 * (j)] = *(const LAS bf16x8*)(kpA + (so) + (j) * 2048); kf[2 * (j) + 1] = *(const LAS bf16x8*)(kpB + (so) + (j) * 2048); } while (0)
#define CADDR(tt) (((tt) < n_win && (unsigned)(lo + (tt) - r0) < 8u) ? tlane + (lo + (tt) - r + 7) * (AT_ROWF * 4) : AT_INF)
#define CLDA(X0, q) do { const int ro_ = (((2 * (q)) & 3) + 8 * ((2 * (q)) >> 2)) * 4; X0[2 * (q)] = *(const LAS float*)(L + cad + offA + ro_); X0[2 * (q) + 1] = *(const LAS float*)(L + cad + offA + ro_ + 4); } while (0)
#define CLDB(X1, q) do { X1[2 * (q)] = *(const LAS float*)(L + cad + offB + 8 * (q)); X1[2 * (q) + 1] = *(const LAS float*)(L + cad + offB + 8 * (q) + 4); } while (0)
#define DEC_TAIL() do { { auto rr_ = __builtin_amdgcn_permlane32_swap(__float_as_uint(rm_), __float_as_uint(rm_), false, false); rm_ = __builtin_fmaxf(__uint_as_float(rr_[0]), __uint_as_float(rr_[1])); } \
        resc = false; \
        if (__builtin_amdgcn_ballot_w64(rm_ > mhat + ATT_THR) != 0ull) { const float mn_ = __builtin_fmaxf(mhat, rm_); fres = __builtin_amdgcn_exp2f(mhat - mn_); l_reg *= fres; mhat = mn_; resc = true; } \
        nmh = (mhat == -INFINITY) ? 0.f : -mhat; } while (0)
#define DECIDE_D(C0, C1) do { float a_ = MX3(C0[0], C0[1], C1[0]), b_ = MX3(C0[2], C0[3], C1[1]); a_ = MX3(a_, C1[2], C1[3]); \
        _Pragma("unroll") for (int r_ = 4; r_ < 16; r_ += 4) { a_ = MX3(a_, C0[r_], C0[r_ + 1]); b_ = MX3(b_, C0[r_ + 2], C0[r_ + 3]); a_ = MX3(a_, C1[r_], C1[r_ + 1]); b_ = MX3(b_, C1[r_ + 2], C1[r_ + 3]); } \
        float rm_ = __builtin_fmaxf(a_, b_); DEC_TAIL(); } while (0)
#define DECIDE_W(C0, C1) do { float a_ = MX3(C0[0], C0[1], C1[0]), b_ = MX3(C0[2], C0[3], C1[1]); a_ = MX3(a_, C1[2], C1[3]); \
        _Pragma("unroll") for (int r_ = 4; r_ < 16; r_ += 4) { a_ = MX3(a_, C0[r_], C0[r_ + 1]); b_ = MX3(b_, C0[r_ + 2], C0[r_ + 3]); } \
        float rm_ = __builtin_fmaxf(a_, b_); DEC_TAIL(); } while (0)
#define RESC() do { if (resc) { _Pragma("unroll") for (int r_ = 0; r_ < 16; ++r_) { o0[r_] *= fres; o1[r_] *= fres; } } } while (0)
#define EX(v) __builtin_amdgcn_exp2f((v) + nmh)
#define PKW(P, i) cvtpk_s(P[i], P[(i) + 1])
#define PAF(k) __builtin_bit_cast(bf16x8, pw##k)
#define VFR(i) (bf16x8){vlo[i][0], vlo[i][1], vlo[i][2], vlo[i][3], vhi[i][0], vhi[i][1], vhi[i][2], vhi[i][3]}
#define VRD(i, s) do { vlo[i] = vtr(vp_ + (((i) >> 2) * 4096 + vol##s)); vhi[i] = vtr(vp_ + (((i) >> 2) * 4096 + voh##s)); } while (0)
#define GAPA(MF, a0, a1, a2, a3, W0, W1, PW) do { MF; sacc += a0; sacc += a1; sacc += a2; sacc += a3; PIN(sacc); W0; W1; PIN(PW); SBAR(); } while (0)
#define GAPM(MF) do { MF; SBAR(); } while (0)
#define GAPB(MF, X, i) do { MF; X[i] = EX(X[i]); X[(i) + 1] = EX(X[(i) + 1]); X[(i) + 2] = EX(X[(i) + 2]); X[(i) + 3] = EX(X[(i) + 3]); PIN(X); SBAR(); } while (0)
#define EXG(X, i) do { X[i] = EX(X[i]); X[(i) + 1] = EX(X[(i) + 1]); X[(i) + 2] = EX(X[(i) + 2]); X[(i) + 3] = EX(X[(i) + 3]); PIN(X); SBAR(); } while (0)
#define STAGE(t, KR, VR) do { *(LAS u32x4*)(L + sl_prev + kdst) = KR; *(LAS u32x4*)(L + sl_next + vdst) = VR; \
        { const int tk_ = VT(min((t) + 4, NTV - 1)), tv_ = VT(min((t) + 3, NTV - 1)); const bf16_t *kp_, *vq_, *kq_, *vv_; ATT_SRC(tk_, kp_, vq_); ATT_SRC(tv_, kq_, vv_); (void)vq_; (void)kq_; \
          KR = *(const u32x4*)(kp_ + ksoff); VR = *(const u32x4*)(vv_ + vsoff); } SBAR(); } while (0)
#define QK0(C0, CZ) C0 = (CZ) ? MFMA32(kf[0], qr[0], zero16) : MFMA32(kf[0], qr[0], C0)
#define QK1(C1, CZ) C1 = (CZ) ? MFMA32(kf[1], qr[0], zero16) : MFMA32(kf[1], qr[0], C1)
#define PHASEA_PW(C0, C1, P0, P1, CZ) do { \
    VRD(0, 0); SBAR(); float sacc = P0[0] + P0[1]; \
                       GAPA(QK0(C0, CZ), P0[2], P0[3], P0[4], P0[5],     pw0[0] = PKW(P0, 0),  pw0[1] = PKW(P0, 2),  pw0); \
    VRD(4, 0); SBAR(); GAPA(QK1(C1, CZ), P0[6], P0[7], P0[8], P0[9],     pw0[2] = PKW(P0, 4),  pw0[3] = PKW(P0, 6),  pw0); \
    VRD(1, 1); SBAR(); GAPA(C0 = MFMA32(kf[2], qr[1], C0), P0[10], P0[11], P0[12], P0[13], pw1[0] = PKW(P0, 8),  pw1[1] = PKW(P0, 10), pw1); \
    VRD(5, 1); SBAR(); GAPA(C1 = MFMA32(kf[3], qr[1], C1), P0[14], P0[15], P1[0], P1[1],   pw1[2] = PKW(P0, 12), pw1[3] = PKW(P0, 14), pw1); \
    VRD(2, 2); SBAR(); GAPA(C0 = MFMA32(kf[4], qr[2], C0), P1[2], P1[3], 0.f, 0.f,         pw2[0] = PKW(P1, 0),  pw2[1] = PKW(P1, 2),  pw2); \
    VRD(6, 2); SBAR(); GAPM(C1 = MFMA32(kf[5], qr[2], C1)); pw2[2] = 0u; pw2[3] = 0u; \
                       GAPM(C0 = MFMA32(kf[6], qr[3], C0)); GAPM(C1 = MFMA32(kf[7], qr[3], C1)); \
    l_reg += sacc; } while (0)
#define PHASEA_PD(C0, C1, P0, P1, CZ) do { \
    VRD(0, 0); SBAR(); float sacc = P0[0] + P0[1]; \
                       GAPA(QK0(C0, CZ), P0[2], P0[3], P0[4], P0[5],     pw0[0] = PKW(P0, 0),  pw0[1] = PKW(P0, 2),  pw0); \
    VRD(4, 0); SBAR(); GAPA(QK1(C1, CZ), P0[6], P0[7], P0[8], P0[9],     pw0[2] = PKW(P0, 4),  pw0[3] = PKW(P0, 6),  pw0); \
    VRD(1, 1); SBAR(); GAPA(C0 = MFMA32(kf[2], qr[1], C0), P0[10], P0[11], P0[12], P0[13], pw1[0] = PKW(P0, 8),  pw1[1] = PKW(P0, 10), pw1); \
    VRD(5, 1); SBAR(); GAPA(C1 = MFMA32(kf[3], qr[1], C1), P0[14], P0[15], P1[0], P1[1],   pw1[2] = PKW(P0, 12), pw1[3] = PKW(P0, 14), pw1); \
    VRD(2, 2); SBAR(); GAPA(C0 = MFMA32(kf[4], qr[2], C0), P1[2], P1[3], P1[4], P1[5],     pw2[0] = PKW(P1, 0),  pw2[1] = PKW(P1, 2),  pw2); \
    VRD(6, 2); SBAR(); GAPA(C1 = MFMA32(kf[5], qr[2], C1), P1[6], P1[7], P1[8], P1[9],     pw2[2] = PKW(P1, 4),  pw2[3] = PKW(P1, 6),  pw2); \
    VRD(3, 3); SBAR(); GAPA(C0 = MFMA32(kf[6], qr[3], C0), P1[10], P1[11], P1[12], P1[13], pw3[0] = PKW(P1, 8),  pw3[1] = PKW(P1, 10), pw3); \
    VRD(7, 3); SBAR(); GAPA(C1 = MFMA32(kf[7], qr[3], C1), P1[14], P1[15], 0.f, 0.f,       pw3[2] = PKW(P1, 12), pw3[3] = PKW(P1, 14), pw3); \
    l_reg += sacc; } while (0)
#define STEP_WW(C0, C1, P0, P1, t, KR, VR) do { SBAR(); const LAS char* vp_ = vp0 + sl_prev; const int cad = CADDR((t) + 1); \
    PHASEA_PW(C0, C1, P0, P1, false); STAGE(t, KR, VR); float nmh; DECIDE_W(C0, C1); SBAR(); \
                               GAPB(o0 = MFMA32(VFR(0), PAF(0), o0), C0, 0);  CLDA(P0, 0); CLDA(P0, 1); SBAR(); \
                               GAPB(o1 = MFMA32(VFR(4), PAF(0), o1), C0, 4);  CLDA(P0, 2); CLDA(P0, 3); SBAR(); \
    KLD2(sl_next, 0); SBAR();  GAPB(o0 = MFMA32(VFR(1), PAF(1), o0), C0, 8);  CLDA(P0, 4); CLDA(P0, 5); SBAR(); \
    KLD2(sl_next, 1); SBAR();  GAPB(o1 = MFMA32(VFR(5), PAF(1), o1), C0, 12); CLDA(P0, 6); CLDA(P0, 7); SBAR(); \
    KLD2(sl_next, 2); SBAR();  GAPB(o0 = MFMA32(VFR(2), PAF(2), o0), C1, 0);  CLDB(P1, 0); CLDB(P1, 1); SBAR(); \
    KLD2(sl_next, 3); SBAR();  GAPM(o1 = MFMA32(VFR(6), PAF(2), o1)); } while (0)
#define STEP_DW(C0, C1, P0, P1, t, KR, VR) do { SBAR(); const LAS char* vp_ = vp0 + sl_prev; \
    PHASEA_PW(C0, C1, P0, P1, true); STAGE(t, KR, VR); float nmh; DECIDE_D(C0, C1); SBAR(); \
                               GAPB(o0 = MFMA32(VFR(0), PAF(0), o0), C0, 0); \
                               GAPB(o1 = MFMA32(VFR(4), PAF(0), o1), C0, 4); \
    KLD2(sl_next, 0); SBAR();  GAPB(o0 = MFMA32(VFR(1), PAF(1), o0), C0, 8); \
    KLD2(sl_next, 1); SBAR();  GAPB(o1 = MFMA32(VFR(5), PAF(1), o1), C0, 12); \
    KLD2(sl_next, 2); SBAR();  GAPB(o0 = MFMA32(VFR(2), PAF(2), o0), C1, 0); \
    KLD2(sl_next, 3); SBAR();  GAPB(o1 = MFMA32(VFR(6), PAF(2), o1), C1, 4); \
                               EXG(C1, 8); EXG(C1, 12); } while (0)
#define STEP_DD(C0, C1, P0, P1, t, KR, VR) do { SBAR(); const LAS char* vp_ = vp0 + sl_prev; \
    PHASEA_PD(C0, C1, P0, P1, true); STAGE(t, KR, VR); float nmh; DECIDE_D(C0, C1); SBAR(); \
                               GAPB(o0 = MFMA32(VFR(0), PAF(0), o0), C0, 0); \
                               GAPB(o1 = MFMA32(VFR(4), PAF(0), o1), C0, 4); \
    KLD2(sl_next, 0); SBAR();  GAPB(o0 = MFMA32(VFR(1), PAF(1), o0), C0, 8); \
    KLD2(sl_next, 1); SBAR();  GAPB(o1 = MFMA32(VFR(5), PAF(1), o1), C0, 12); \
    KLD2(sl_next, 2); SBAR();  GAPB(o0 = MFMA32(VFR(2), PAF(2), o0), C1, 0); \
    KLD2(sl_next, 3); SBAR();  GAPB(o1 = MFMA32(VFR(6), PAF(2), o1), C1, 4); \
                               GAPB(o0 = MFMA32(VFR(3), PAF(3), o0), C1, 8); \
                               GAPB(o1 = MFMA32(VFR(7), PAF(3), o1), C1, 12); } while (0)
    f32x16 zero16;
#pragma unroll
    for (int i = 0; i < 16; ++i) zero16[i] = 0.f;
    WBAR();
    sl_prev = 2 * AT_SLOTB; sl_cur = 0; sl_next = AT_SLOTB;
    if (!ctx) {
        { const int cad = CADDR(0);
#pragma unroll
          for (int q = 0; q < 8; ++q) CLDA(pA0, q);
          CLDB(pA1, 0); CLDB(pA1, 1); }
#pragma unroll
        for (int j = 0; j < 4; ++j) KLD2(0, j);
#pragma unroll
        for (int j = 0; j < 4; ++j) { pA0 = MFMA32(kf[2 * j], qr[j], pA0); pA1 = MFMA32(kf[2 * j + 1], qr[j], pA1); }
        STAGE(0, kreg, vreg);
        { float nmh; DECIDE_W(pA0, pA1);
#pragma unroll
          for (int r_ = 0; r_ < 16; ++r_) pA0[r_] = EX(pA0[r_]);
#pragma unroll
          for (int r_ = 0; r_ < 4; ++r_) pA1[r_] = EX(pA1[r_]); }
        { const int cad = CADDR(1);
#pragma unroll
          for (int q = 0; q < 8; ++q) CLDA(pB0, q);
          CLDB(pB1, 0); CLDB(pB1, 1); }
#pragma unroll
        for (int j = 0; j < 4; ++j) KLD2(AT_SLOTB, j);
        WBAR(); ROT();
#pragma unroll 1
        for (int t = 1; t < NWP; t += 2) {
            STEP_WW(pB0, pB1, pA0, pA1, t, kreg2, vreg2);     WBAR(); RESC(); ROT();
            STEP_WW(pA0, pA1, pB0, pB1, t + 1, kreg, vreg); WBAR(); RESC(); ROT();
        }
        STEP_DW(pB0, pB1, pA0, pA1, NWP, kreg2, vreg2); WBAR(); RESC(); ROT();
    } else {
#pragma unroll
        for (int j = 0; j < 4; ++j) KLD2(0, j);
        pB0 = MFMA32(kf[0], qr[0], zero16); pB1 = MFMA32(kf[1], qr[0], zero16);
#pragma unroll
        for (int j = 1; j < 4; ++j) { pB0 = MFMA32(kf[2 * j], qr[j], pB0); pB1 = MFMA32(kf[2 * j + 1], qr[j], pB1); }
        STAGE(0, kreg, vreg);
        { float nmh; DECIDE_D(pB0, pB1);
#pragma unroll
          for (int r_ = 0; r_ < 16; ++r_) { pB0[r_] = EX(pB0[r_]); pB1[r_] = EX(pB1[r_]); } }
#pragma unroll
        for (int j = 0; j < 4; ++j) KLD2(AT_SLOTB, j);
        WBAR(); ROT();
    }
    if (ctx) {
      STEP_DD(pA0, pA1, pB0, pB1, 1, kreg2, vreg2); WBAR(); RESC(); ROT();
      STEP_DD(pB0, pB1, pA0, pA1, 2, kreg, vreg);   WBAR(); RESC(); ROT();
      STEP_DD(pA0, pA1, pB0, pB1, 3, kreg2, vreg2); WBAR(); RESC(); ROT();
    } else {
      STEP_DD(pA0, pA1, pB0, pB1, NWP + 1, kreg, vreg);   WBAR(); RESC(); ROT();
      STEP_DD(pB0, pB1, pA0, pA1, NWP + 2, kreg2, vreg2); WBAR(); RESC(); ROT();
      STEP_DD(pA0, pA1, pB0, pB1, NWP + 3, kreg, vreg);   WBAR(); RESC(); ROT(); }
#define DRAIN(P0, P1) do { float sacc = P0[0] + P0[1]; \
      _Pragma("unroll") for (int r_ = 2; r_ < 16; ++r_) sacc += P0[r_]; \
      _Pragma("unroll") for (int r_ = 0; r_ < 16; ++r_) sacc += P1[r_]; \
      l_reg += sacc; \
      pw0 = (u32x4){PKW(P0, 0), PKW(P0, 2), PKW(P0, 4), PKW(P0, 6)}; pw1 = (u32x4){PKW(P0, 8), PKW(P0, 10), PKW(P0, 12), PKW(P0, 14)}; \
      pw2 = (u32x4){PKW(P1, 0), PKW(P1, 2), PKW(P1, 4), PKW(P1, 6)}; pw3 = (u32x4){PKW(P1, 8), PKW(P1, 10), PKW(P1, 12), PKW(P1, 14)}; \
      PIN(pw0); PIN(pw1); PIN(pw2); PIN(pw3); SBAR(); \
      _Pragma("unroll") for (int i_ = 0; i_ < 4; ++i_) zr[i_] = *(const u32x4*)(zp + (size_t)i_ * 8 * 512); \
      asm volatile("" ::: "memory"); if (next_ctx >= 0) attn_prefetch(F, layer, next_ctx, true, P); asm volatile("" ::: "memory");     \
      const LAS char* vp_ = vp0 + sl_prev; VRD(0, 0); VRD(4, 0); VRD(1, 1); VRD(5, 1); VRD(2, 2); VRD(6, 2); VRD(3, 3); VRD(7, 3); \
      o0 = MFMA32(VFR(0), PAF(0), o0); o1 = MFMA32(VFR(4), PAF(0), o1); o0 = MFMA32(VFR(1), PAF(1), o0); o1 = MFMA32(VFR(5), PAF(1), o1); \
      o0 = MFMA32(VFR(2), PAF(2), o0); o1 = MFMA32(VFR(6), PAF(2), o1); o0 = MFMA32(VFR(3), PAF(3), o0); o1 = MFMA32(VFR(7), PAF(3), o1); } while (0)
    int le = lane; asm volatile("" : "+v"(le));
    unsigned char* wse = kws();
    const bf16_t* zp = (const bf16_t*)(wse + WS_SZA) + (size_t)(R0 + (le >> 3)) * 512 + h * 64 + (le & 7) * 8;
    u32x4 zr[4];
    DRAIN(pA0, pA1);
#undef DRAIN
#undef STEP_DD
#undef STEP_DW
#undef STEP_WW
#undef PHASEA_PD
#undef PHASEA_PW
#undef QK0
#undef QK1
#undef STAGE
#undef EXG
#undef GAPB
#undef GAPM
#undef GAPA
#undef VRD
#undef VFR
#undef PAF
#undef PKW
#undef EX
#undef RESC
#undef DECIDE_W
#undef DECIDE_D
#undef DEC_TAIL
#undef CLDA
#undef CLDB
#undef CADDR
#undef KLD2
#undef MX3
#undef ROT
#undef VT
    { auto rr = __builtin_amdgcn_permlane32_swap(__float_as_uint(l_reg), __float_as_uint(l_reg), false, false); l_reg = __uint_as_float(rr[0]) + __uint_as_float(rr[1]); }
    const float inv = 1.0f / l_reg;
    { LAS char* stg = L + AT_TBL + wid * 4608; LAS char* srow = stg + (le >> 3) * 144 + (le & 7) * 16; LAS char* sfrag = stg + (le & 31) * 144 + (le >> 5) * 8;
#pragma unroll
      for (int i = 0; i < 4; ++i) *(LAS u32x4*)(srow + i * 8 * 144) = zr[i];
      asm volatile("s_waitcnt lgkmcnt(0)" ::: "memory");
      u32x2 zg0[4], zg1[4];
#pragma unroll
      for (int g = 0; g < 4; ++g) { zg0[g] = *(const LAS u32x2*)(sfrag + 16 * g); zg1[g] = *(const LAS u32x2*)(sfrag + 64 + 16 * g); }
      asm volatile("s_waitcnt lgkmcnt(0)" ::: "memory");
#pragma unroll
      for (int g = 0; g < 4; ++g) {
          const u32x2 z0 = zg0[g], z1 = zg1[g];
          u32x2 w0, w1;
          w0.x = cvtpk_s(o0[4 * g + 0] * inv * bflo(z0.x), o0[4 * g + 1] * inv * bfhi(z0.x)); w0.y = cvtpk_s(o0[4 * g + 2] * inv * bflo(z0.y), o0[4 * g + 3] * inv * bfhi(z0.y));
          w1.x = cvtpk_s(o1[4 * g + 0] * inv * bflo(z1.x), o1[4 * g + 1] * inv * bfhi(z1.x)); w1.y = cvtpk_s(o1[4 * g + 2] * inv * bflo(z1.y), o1[4 * g + 3] * inv * bfhi(z1.y));
          *(LAS u32x2*)(sfrag + 16 * g) = w0; *(LAS u32x2*)(sfrag + 64 + 16 * g) = w1; }
      asm volatile("s_waitcnt lgkmcnt(0)" ::: "memory");
      bf16_t* yp = (bf16_t*)(wse + WS_YAB) + (size_t)(R0 + (le >> 3)) * 1024 + h * 64 + (le & 7) * 8;
#pragma unroll
      for (int i = 0; i < 4; ++i) { const u32x4 v = *(const LAS u32x4*)(srow + i * 8 * 144); *(u32x4*)(yp + (size_t)i * 8 * 1024) = v; } }
    WBAR();
#undef WBAR
#undef PIN
#undef SBAR
}
#undef ATT_SRC
#undef ATT_DECODE

__device__ __forceinline__ void mix_phase(Frame& F, int layer) {
    AttnPre P;
    const int t_ctx = 255 - F.bx;
    for (int t = F.bx; t < M / 32; t += 256) conv_task(F, layer, t, P, t + 256 >= M / 32 ? F.bx : -1);
    attn_wg(F, layer, F.bx, false, P, t_ctx < 128 ? t_ctx : -1);
    if (t_ctx < 128) attn_wg(F, layer, t_ctx, true, P, -1);
}

__device__ __forceinline__ void cvec_phase(Frame& F) {
    const int gw = F.bx * 8 + F.wave, NGW = F.G * 8;
    const float* md = WSP(float, WS_MOD) + 5 * 3072;
    f32x4 sh[5][4];
#pragma unroll
    for (int g = 0; g < 5; ++g)
#pragma unroll
        for (int i = 0; i < 4; ++i) sh[g][i] = *(const f32x4*)(md + g * 3072 + 16 * F.lane + 4 * i);
    const bf16_t* W = WSP(bf16_t, WS_WTIN) + (size_t)DIN * D; const float* bp = WSP(float, WS_BIASP) + DIN; float* cv = WSP(float, WS_CVEC);
    for (int n = gw; n < DIN; n += NGW) {
        const u32x4 wa = *(const u32x4*)(W + (size_t)n * D + 16 * F.lane), wb = *(const u32x4*)(W + (size_t)n * D + 16 * F.lane + 8);
        const f32x4 w0 = {bflo(wa.x), bfhi(wa.x), bflo(wa.y), bfhi(wa.y)}, w1 = {bflo(wa.z), bfhi(wa.z), bflo(wa.w), bfhi(wa.w)};
        const f32x4 w2 = {bflo(wb.x), bfhi(wb.x), bflo(wb.y), bfhi(wb.y)}, w3 = {bflo(wb.z), bfhi(wb.z), bflo(wb.w), bfhi(wb.w)};
        const float bias = bp[n];
#pragma unroll
        for (int g = 0; g < 5; ++g) { const f32x4 p = sh[g][0] * w0 + sh[g][1] * w1 + sh[g][2] * w2 + sh[g][3] * w3;
            const float sm = wave_sum((p[0] + p[1]) + (p[2] + p[3])); if (F.lane == 0) cv[g * DIN + n] = sm + bias; }
    }
}

struct Args { const float* in[20]; float* out; unsigned char* ws; int ph_lo, ph_hi; };

__global__ void __launch_bounds__(512, 2) mk_fwd(Args args) {
    extern __shared__ __attribute__((aligned(16))) unsigned char lds_raw[];
    Frame F;
    F.lds = (LAS unsigned char*)lds_raw;
    F.tid = threadIdx.x; F.lane = F.tid & 63; F.wave = __builtin_amdgcn_readfirstlane(F.tid >> 6); F.G = gridDim.x; F.bx = blockIdx.x;
    for (int u = F.tid; u < (LDS_BYTES - LDSCTL_OFF) / 4; u += 512) ((LAS unsigned*)(F.lds + LDSCTL_OFF))[u] = 0u;
    __syncthreads();
    XcdBarrier bar; bar.bar = WSP(unsigned, WS_CTL) + CW_BAR; bar.x = 0; bar.st = nullptr;
#define lo (kint(176))
#define hi (kint(180))
    if (hi - lo > 1) bar = xcd_barrier_post(WSP(unsigned, WS_CTL) + CW_BAR, (volatile LAS unsigned*)(F.lds + MISC_OFF) + 8);
#ifndef PH_MASK
#define PH_MASK 0x7f
#endif
#define PHK(kind) ((PH_MASK >> (kind)) & 1)
#define IN(k) (lo <= (k) && (k) < hi)
#define SEAM(k) do { if (IN(k) && IN((k) + 1)) { XcdBarrier bb_; bb_.bar = WSP(unsigned, WS_CTL) + CW_BAR; bb_.x = xb_xcc_id(); bb_.st = (volatile LAS unsigned*)((LAS unsigned char*)lds_raw + MISC_OFF) + 8; xcd_barrier(bb_); } } while (0)
#define FRESH() do { F.tid = fresh_tid(); F.lane = F.tid & 63; F.wave = __builtin_amdgcn_readfirstlane(F.tid >> 6); } while (0)

    if (PHK(0) && IN(0)) { FRESH(); p0_prologue(F); SEAM(0); }
    for (int layer = 0; layer < DEPTH; ++layer) {
        const int pb = 1 + 5 * layer;
        if (PHK(1) && IN(pb) && layer == 0) { FRESH();
            if (layer == 0 && F.bx == F.G - 1) { const float* rg = kin(I_RMS_G) + D; const float* md = WSP(float, WS_MOD) + 5 * 3072; float* gm = WSP(float, WS_GM);
                for (int i = F.tid; i < 5 * 1024; i += 512) { const int g = i >> 10, c = i & 1023; gm[i] = rg[c] * (1.0f + md[g * 3072 + 1024 + c]); } }
            norm_phase(F, layer); SEAM(pb); }
        if (PHK(2) && IN(pb + 1)) {
            constexpr int M1 = 46 * 256;
            const bf16_t* Ain = layer == 0 ? WSP(bf16_t, WS_H) : WSP(bf16_t, WS_YAB);
            { pg8::Gemm g{Ain + (size_t)M1 * D, WSP(bf16_t, WS_WTIN) + (size_t)layer * DIN * D, M - M1, DIN, D, D}; pg8::StaticOrder S; S.init(M - M1, DIN, F.G, F.G - 1 - F.bx, 0, 128);
              if (layer == 0) { EpiInT<2> E{layer, M1}; pg8::gemm_phase<EpiInT<2>>(F.lds, g, S, E); } else { EpiInT<2, true> E{layer, M1}; pg8::gemm_phase<EpiInT<2, true>>(F.lds, g, S, E); } }
            const int nidle = F.G - (M - M1) / 128 * (DIN / 256);
            const bool slack = (int)blockIdx.x < nidle, early = slack && ((blockIdx.x >> 3) & 1) == 0;
            if (early) { if (layer == 0) { FRESH(); __syncthreads(); wt_items(F, 1, F.bx * 8 + F.wave, nidle * 8); __syncthreads(); } else { __builtin_amdgcn_s_sleep(100); __builtin_amdgcn_s_sleep(100); } }
            { pg8::Gemm g{Ain, WSP(bf16_t, WS_WTIN) + (size_t)layer * DIN * D, M1, DIN, D, D}; pg8::StaticOrder S; S.init(M1, DIN, F.G, F.bx);
              if (layer == 0) { EpiInT<4> E{layer, 0}; pg8::gemm_phase<EpiInT<4>>(F.lds, g, S, E); } else { EpiInT<4, true> E{layer, 0}; pg8::gemm_phase<EpiInT<4, true>>(F.lds, g, S, E); } }
            if (layer == 0 && slack && !early) { FRESH(); __syncthreads(); wt_items(F, 1, F.bx * 8 + F.wave, nidle * 8); }
            SEAM(pb + 1);
        }
        if (PHK(3) && IN(pb + 2)) { FRESH(); mix_phase(F, layer); SEAM(pb + 2); }
        if (PHK(4) && IN(pb + 3)) {
            if (layer == 0) { FRESH(); cvec_phase(F); }
            pg8::Gemm g{WSP(bf16_t, WS_YAB), WSP(bf16_t, WS_WTPROJ) + (size_t)layer * D * D, M, D, D, D}; pg8::StaticOrder S; S.init(M, D, F.G, F.bx, 0, 192);
            EpiProj E{};
            pg8::gemm_phase<EpiProj>(F.lds, g, S, E);
            SEAM(pb + 3);
        }
        if (PHK(5) && IN(pb + 4)) {
            pg8::Gemm g{WSP(bf16_t, WS_H), WSP(bf16_t, WS_WTOUT) + (size_t)layer * D * D, M, D, D, D}; pg8::StaticOrder S; S.init(M, D, F.G, F.bx, 0, 192);
            if (layer + 1 < DEPTH) { EpiOutT<false> E{layer}; pg8::gemm_phase<EpiOutT<false>>(F.lds, g, S, E); }
            else { EpiOutT<true> E{layer}; pg8::gemm_phase<EpiOutT<true>>(F.lds, g, S, E); }
            if (layer + 1 < DEPTH) SEAM(pb + 4);
        }
    }
#undef IN
#undef SEAM
#undef lo
#undef hi
}

extern "C" void kernel_launch(void* const* d_in, const int* in_sizes, int n_in, void* d_out, int out_size, void* d_ws, size_t ws_size, hipStream_t stream) {
    static int grid = 0;
    if (grid == 0) {
        if (n_in != 20 || ws_size < WS_END) { fprintf(stderr, "kernel_launch: unexpected inputs (n_in %d, ws %zu)\n", n_in, ws_size); grid = -1; return; }
        int dev = 0, cus = 0, per_cu = 0;
        if (hipGetDevice(&dev) != hipSuccess || hipDeviceGetAttribute(&cus, hipDeviceAttributeMultiprocessorCount, dev) != hipSuccess) { grid = -1; return; }
        if (hipFuncSetAttribute((const void*)mk_fwd, hipFuncAttributeMaxDynamicSharedMemorySize, LDS_BYTES) != hipSuccess) { fprintf(stderr, "kernel_launch: hipFuncSetAttribute failed\n"); grid = -1; return; }
        if (hipOccupancyMaxActiveBlocksPerMultiprocessor(&per_cu, (const void*)mk_fwd, 512, LDS_BYTES) != hipSuccess || per_cu < 1) { fprintf(stderr, "kernel_launch: occupancy query says %d\n", per_cu); per_cu = 1; }
        (void)hipGetLastError();
        if (cus < 256) { fprintf(stderr, "kernel_launch: %d CUs; the mixer's work split is written for a grid of 256 workgroups\n", cus); grid = -1; return; }
        grid = 256;
    }
    if (grid < 0) return;
    (void)hipMemsetAsync((char*)d_ws + WS_CTL, 0, CTL_ZERO_BYTES, stream);
    Args a{};
    for (int i = 0; i < 20; ++i) a.in[i] = (const float*)d_in[i];
    a.out = (float*)d_out; a.ws = (unsigned char*)d_ws;
    if (MK_N_LAUNCHES == 1) { a.ph_lo = 0; a.ph_hi = NPHASE; hipLaunchKernelGGL(mk_fwd, dim3(grid), dim3(512), LDS_BYTES, stream, a); }
    else for (int p = 0; p < NPHASE; ++p) { a.ph_lo = p; a.ph_hi = p + 1; hipLaunchKernelGGL(mk_fwd, dim3(grid), dim3(512), LDS_BYTES, stream, a); }
}
```

```cpp
#include <hip/hip_runtime.h>
#include <cstdio>
#include <cstdint>

#ifndef MK_N_LAUNCHES
#define MK_N_LAUNCHES 1
#endif

#define GAS __attribute__((address_space(1)))
#define LAS __attribute__((address_space(3)))
typedef unsigned short bf16_t;
typedef short bf16x8 __attribute__((ext_vector_type(8)));
typedef float f32x4 __attribute__((ext_vector_type(4)));
typedef float f32x2 __attribute__((ext_vector_type(2)));
typedef unsigned u32x4 __attribute__((ext_vector_type(4)));
typedef unsigned u32x2 __attribute__((ext_vector_type(2)));
typedef GAS unsigned gu32;
#define RLX_AGENT __ATOMIC_RELAXED, __HIP_MEMORY_SCOPE_AGENT
#define LDS_WAIT() asm volatile("s_waitcnt lgkmcnt(0)" ::: "memory")
#define VM_WAIT() asm volatile("s_waitcnt vmcnt(0)" ::: "memory")

constexpr int D = 1024, NCTX = 4096, NLAT = 8192, M = NCTX + NLAT, DIN = 5632, DEPTH = 2, NH = 8, HD = 64;
constexpr int NPHASE = 12;
constexpr float EPS = 1e-6f;

constexpr size_t MiB = 1u << 20;
constexpr size_t WS_CTL = 0, CTL_ZERO_BYTES = 192 * 1024;
constexpr size_t WS_RSS2 = 128 * 1024;
constexpr size_t WS_RSS = 64 * 1024;
constexpr size_t WS_GM = 1 * MiB + 192 * 1024;
constexpr size_t WS_CVEC = 1 * MiB + 256 * 1024;
constexpr size_t WS_MOD = 1 * MiB;
constexpr size_t WS_BIASP = 1 * MiB + 128 * 1024;
constexpr size_t WS_WTIN = 2 * MiB;
constexpr size_t WS_WTPROJ = 24 * MiB;
constexpr size_t WS_WTOUT = 28 * MiB;
constexpr size_t WS_CK = 32 * MiB, WS_CV = 34 * MiB;
constexpr size_t WS_H = 36 * MiB;
constexpr size_t WS_Q = 60 * MiB, WS_K = 72 * MiB, WS_V = 84 * MiB, WS_SZA = 96 * MiB, WS_U = 108 * MiB, WS_SZB = 120 * MiB;
constexpr size_t WS_GR = 132 * MiB, WS_GB = 156 * MiB;
constexpr size_t WS_YAB = 180 * MiB;
constexpr size_t WS_X1 = 204 * MiB;
constexpr size_t WS_END = 228 * MiB;
constexpr int CW_BAR = 4096;
constexpr int CW_ROWBLK = 8192;

constexpr int RING_BYTES = 131072;
constexpr int LDSCTL_OFF = RING_BYTES, MISC_OFF = LDSCTL_OFF + 320;
constexpr int LDS_BYTES = 147456;

__device__ __forceinline__ unsigned f2bf(float f) { unsigned u = __builtin_bit_cast(unsigned, f); return (u + 0x7fffu + ((u >> 16) & 1u)) >> 16; }
__device__ __forceinline__ unsigned pk2(float lo, float hi) { return f2bf(lo) | (f2bf(hi) << 16); }
typedef __bf16 bf16x2_cv __attribute__((ext_vector_type(2)));
__device__ __forceinline__ unsigned cvt_pk_bf16(float lo, float hi) { f32x2 v = {lo, hi}; bf16x2_cv b = __builtin_convertvector(v, bf16x2_cv); return __builtin_bit_cast(unsigned, b); }
__device__ __forceinline__ float bflo(unsigned w) { return __builtin_bit_cast(float, w << 16); }
__device__ __forceinline__ float bfhi(unsigned w) { return __builtin_bit_cast(float, w & 0xffff0000u); }
__device__ __forceinline__ float sigmoid_f(float x) { return __builtin_amdgcn_rcpf(1.0f + __expf(-x)); }
__device__ __forceinline__ float silu_f(float x) { return x * sigmoid_f(x); }
__device__ __forceinline__ float dpp_f(float v, float o) { return v + o; }
__device__ __forceinline__ float wave_sum(float v) {
#define DPP_ADD(ctrl, rm, bc) v += __builtin_bit_cast(float, __builtin_amdgcn_update_dpp(0, __builtin_bit_cast(int, v), ctrl, rm, 0xf, bc))
    DPP_ADD(0x111, 0xf, true); DPP_ADD(0x112, 0xf, true); DPP_ADD(0x114, 0xf, true); DPP_ADD(0x118, 0xf, true);
    DPP_ADD(0x142, 0xa, false); DPP_ADD(0x143, 0xc, false);
#undef DPP_ADD
    return __builtin_bit_cast(float, __builtin_amdgcn_readlane(__builtin_bit_cast(int, v), 63));
}

__device__ __forceinline__ int fresh_tid() { int t = threadIdx.x; asm volatile("" : "+v"(t)); return t; }

namespace pg8 {
constexpr int BM = 256, BK = 64, HALF = 128, HTB = HALF * BK * 2, STAGE_BYTES = 8 * HTB, NXCD = 8, WGM = 8;
__host__ __device__ __forceinline__ int lds_byte(int r, int c) { const int st = (r >> 4) * 2 + (c >> 5), rr = r & 15, cc = c & 31, ob = rr * 64 + cc * 2; return st * 1024 + (ob ^ (((ob >> 9) & 1) << 5)); }
__host__ __device__ __forceinline__ void stage_rc(int b, int& R, int& C) { const int st = b / 1024, sb = b % 1024, swz = sb ^ (((sb >> 9) & 1) << 5); R = (st >> 1) * 16 + swz / 64; C = (st & 1) * 32 + (swz % 64) / 2; }
__host__ __device__ __forceinline__ int perm32(int rho) { const int n = rho >> 4, i = rho & 15; return 8 * (i >> 2) + 4 * n + (i & 3); }

struct Unit { int pm, pn, kh; };
struct Gemm { const bf16_t* A; const bf16_t* Bt; int M, N, K, ld; };

struct StaticOrder {
    int nM, nN, nwg, G, c;
    __host__ __device__ void init(int M_, int N_, int G_, int c_, int split_ = 0, int bm_ = BM) { nM = M_ / bm_; nN = N_ / BM; nwg = nM * nN; G = G_; c = c_; split = split_; }
    int split;
    __host__ __device__ bool next(int i0, Unit& u) const {
        const int i = split ? (i0 >> 1) : i0; u.kh = split ? (i0 & 1) : 0;
        const long L = (long)i * G + c; if (L >= nwg) return false;
        int wgid = (int)L; { const int q = nwg / NXCD, r = nwg % NXCD, xcd = wgid % NXCD, off = wgid / NXCD; wgid = (xcd < r ? xcd * (q + 1) : r * (q + 1) + (xcd - r) * q) + off; }
        const int nig = WGM * nN, gid = wgid / nig, fm = gid * WGM, gsz = (nM - fm) < WGM ? (nM - fm) : WGM;
        u.pm = fm + ((wgid % nig) % gsz); u.pn = (wgid % nig) / gsz; return true;
    }
};

template <class Epi, bool ALIGN_EPI = true, bool SP2 = true>
__device__ __forceinline__ void gemm_phase(LAS unsigned char* lds, const Gemm g, const StaticOrder& S, const Epi& E) {
    const int tid = fresh_tid(), wid = __builtin_amdgcn_readfirstlane(tid >> 6), lane = tid & 63, wr = wid >> 2, wc = wid & 3, fr = lane & 15, fq = lane >> 4;
    static_assert(SP2 || Epi::MB == 4, "tiles lower than 256 rows use the SP2 loop");
    constexpr int MB = Epi::MB, HROWS = 32 * MB;
    const int K = g.ld, nt = g.K / BK;
    const size_t khstep = (size_t)g.K * 2;
    unsigned voffA[2], voffB[2];
#pragma unroll
    for (int i = 0; i < 2; ++i) { int R, C; stage_rc(tid * 16 + i * 8192, R, C); const int Rb = Epi::PERM ? ((R & ~31) + perm32(R & 31)) : R;
        voffA[i] = (unsigned)(R * K + C) * 2u; voffB[i] = (unsigned)(Rb * K + C) * 2u; }
    const size_t kstep = (size_t)(BK * 2);
    const size_t hstep = (size_t)HROWS * K * 2;
    const size_t hstepB = (size_t)HALF * K * 2;
    const size_t tstep = 2 * hstep, tstepB = 2 * hstepB;
    const unsigned ldsw = (unsigned)wid * 1024u;
    const int aoff = lds_byte(wr * (16 * MB) + fr, fq * 8), boff = lds_byte(wc * 32 + fr, fq * 8);
#define PG8_SA(b, h) (((b) * 2 + (h)) * HTB)
#define PG8_SB(b, h) ((4 + (b) * 2 + (h)) * HTB)
#define PG8_STAGE(bufoff, gbase, voff) do { _Pragma("unroll") for (int _i = 0; _i < 2; ++_i) \
        __builtin_amdgcn_global_load_lds((const unsigned*)((const char*)(gbase) + (voff)[_i]), (LAS unsigned*)(lds + (bufoff) + ldsw + _i * 8192), 16, 0, 0); } while (0)
#define PG8_LDA(dst, b, h) do { _Pragma("unroll") for (int m = 0; m < MB; ++m) _Pragma("unroll") for (int k = 0; k < 2; ++k) dst[m][k] = *(const LAS bf16x8*)(lds + PG8_SA(b, h) + aoff + m * 2048 + k * 1024); } while (0)
#define PG8_LDB(dst, b, h) do { _Pragma("unroll") for (int n = 0; n < 2; ++n) _Pragma("unroll") for (int k = 0; k < 2; ++k) dst[n][k] = *(const LAS bf16x8*)(lds + PG8_SB(b, h) + boff + n * 2048 + k * 1024); } while (0)
#define PG8_MMA(ai, bj, At, Bt) do { __builtin_amdgcn_s_setprio(1); _Pragma("unroll") for (int m = 0; m < MB; ++m) _Pragma("unroll") for (int n = 0; n < 2; ++n) _Pragma("unroll") for (int k = 0; k < 2; ++k) \
        acc[ai][bj][m][n] = __builtin_amdgcn_mfma_f32_16x16x32_bf16(Bt[n][k], At[m][k], acc[ai][bj][m][n], 0, 0, 0); __builtin_amdgcn_s_setprio(0); } while (0)
#define PG8_WAIT_V(n) asm volatile("s_waitcnt vmcnt(" #n ")" ::: "memory")
    const int aIss = (MB == 4) ? 2 : (MB == 3) ? (wid < 4 ? 2 : 1) : (MB == 2) ? 1 : (wid < 4 ? 1 : 0);
#define PG8_STAGE_A(bufoff, gbase, voff) do { _Pragma("unroll") for (int _i = 0; _i < 2; ++_i) if (MB == 4 || _i < aIss) \
        __builtin_amdgcn_global_load_lds((const unsigned*)((const char*)(gbase) + (voff)[_i]), (LAS unsigned*)(lds + (bufoff) + ldsw + _i * 8192), 16, 0, 0); } while (0)
#define PG8_WAIT_VN(n) do { switch (n) { case 0: PG8_WAIT_V(0); break; case 1: PG8_WAIT_V(1); break; case 2: PG8_WAIT_V(2); break; case 4: PG8_WAIT_V(4); break; case 5: PG8_WAIT_V(5); break; \
        case 6: PG8_WAIT_V(6); break; default: PG8_WAIT_V(8); break; } } while (0)
#define PG8_WAIT_LOOP() do { if constexpr (MB == 4) PG8_WAIT_V(8); else PG8_WAIT_VN(4 + 2 * aIss); } while (0)
#define PG8_WAIT_P1() do { if constexpr (MB == 4) PG8_WAIT_V(2); else PG8_WAIT_VN(aIss); } while (0)
#define PG8_WAIT_P2() do { if constexpr (MB == 4) PG8_WAIT_V(6); else PG8_WAIT_VN(4 + aIss); } while (0)
#define PG8_WAIT_L(n) asm volatile("s_waitcnt lgkmcnt(" #n ")" ::: "memory")
#define PG8_BAR __builtin_amdgcn_s_barrier()
#define PG8_SCHED __builtin_amdgcn_sched_barrier(0)
    Unit cur, nxt; int ui = 0;
    if (!S.next(0, cur)) return;
    f32x4 acc[2][2][MB][2];
#pragma unroll
    for (int a = 0; a < 2; ++a)
#pragma unroll
        for (int b = 0; b < 2; ++b)
#pragma unroll
            for (int m = 0; m < MB; ++m)
#pragma unroll
                for (int n = 0; n < 2; ++n) acc[a][b][m][n] = (f32x4){0.f, 0.f, 0.f, 0.f};
    bf16x8 At[MB][2], B0[2][2], B1[2][2];
    const char* cA = (const char*)g.A + (size_t)cur.pm * tstep + cur.kh * khstep; const char* cB = (const char*)g.Bt + (size_t)cur.pn * tstepB + cur.kh * khstep;
    const int ntm = nt - 1; const int xrot = (int)(blockIdx.x & 3u) * (nt >> 2);
    auto krot = [&](const Unit& u_) -> int { return Epi::KROT == 1 ? (u_.pm & 3) * (nt >> 2) : Epi::KROT == 2 ? xrot : Epi::KROT == 3 ? (u_.pm & 3) * (nt >> 3) : 0; };
    auto kidx = [&](int t_, int r_) -> int { return Epi::KROT == 3 ? ((t_ & (nt >> 1)) | ((t_ + r_) & ((nt >> 1) - 1))) : ((t_ + r_) & ntm); };
    int rot = krot(cur);
    if constexpr (SP2) {
        const char* pA = cA + (size_t)kidx(0, rot) * kstep; const char* pB = cB + (size_t)kidx(0, rot) * kstep;
        PG8_STAGE(PG8_SB(0, 0), pB, voffB); PG8_STAGE(PG8_SB(0, 1), pB + hstepB, voffB); PG8_STAGE_A(PG8_SA(0, 0), pA, voffA); PG8_STAGE_A(PG8_SA(0, 1), pA + hstep, voffA);
        if (wr == 1) PG8_BAR;
        PG8_WAIT_P1(); PG8_BAR;
        PG8_STAGE(PG8_SB(1, 0), pB + kstep, voffB); PG8_STAGE_A(PG8_SA(1, 0), pA + kstep, voffA); PG8_STAGE(PG8_SB(1, 1), pB + hstepB + kstep, voffB);
        PG8_WAIT_P2(); PG8_BAR;
    } else {
        PG8_STAGE(PG8_SB(0, 0), cB, voffB); PG8_STAGE(PG8_SA(0, 0), cA, voffA); PG8_STAGE(PG8_SB(0, 1), cB + hstepB, voffB); PG8_STAGE(PG8_SA(0, 1), cA + hstep, voffA);
        if (wr == 1) PG8_BAR;
        PG8_WAIT_V(4); PG8_BAR;
        PG8_STAGE(PG8_SB(1, 0), cB + kstep, voffB); PG8_STAGE(PG8_SA(1, 0), cA + kstep, voffA); PG8_STAGE(PG8_SB(1, 1), cB + hstepB + kstep, voffB);
        PG8_WAIT_V(6); PG8_BAR;
    }
    for (;;) {
        const bool has_next = S.next(ui + 1, nxt);
        const char* nA = has_next ? (const char*)g.A + (size_t)nxt.pm * tstep + nxt.kh * khstep : cA; const char* nB = has_next ? (const char*)g.Bt + (size_t)nxt.pn * tstepB + nxt.kh * khstep : cB;
        const int nrot = has_next ? krot(nxt) : rot;
        for (int t = 0; t < nt; t += 2) {
            const bool last = (t == nt - 2);
            const char* a1 = cA + (size_t)(kidx(t, rot) + 1) * kstep;
            const char* a2 = last ? nA + (size_t)kidx(0, nrot) * kstep : cA + (size_t)kidx(t + 2, rot) * kstep; const char* b2 = last ? nB + (size_t)kidx(0, nrot) * kstep : cB + (size_t)kidx(t + 2, rot) * kstep;
            const char* a3 = a2 + kstep; const char* b3 = b2 + kstep;
            if constexpr (SP2) {
            PG8_LDB(B0, 0, 0); PG8_LDB(B1, 0, 1); PG8_SCHED; PG8_LDA(At, 0, 0); PG8_STAGE_A(PG8_SA(1, 1), a1 + hstep, voffA);
            PG8_WAIT_LOOP(); PG8_WAIT_L(0); PG8_BAR; PG8_MMA(0, 0, At, B0); PG8_MMA(0, 1, At, B1); PG8_BAR; PG8_SCHED;
            PG8_LDA(At, 0, 1); PG8_STAGE(PG8_SB(0, 0), b2, voffB); PG8_STAGE(PG8_SB(0, 1), b2 + hstepB, voffB); PG8_STAGE_A(PG8_SA(0, 0), a2, voffA);
            PG8_WAIT_LOOP(); PG8_WAIT_L(0); PG8_BAR; PG8_MMA(1, 0, At, B0); PG8_MMA(1, 1, At, B1); PG8_BAR; PG8_SCHED;
            PG8_LDB(B0, 1, 0); PG8_LDB(B1, 1, 1); PG8_SCHED; PG8_LDA(At, 1, 0); PG8_STAGE_A(PG8_SA(0, 1), a2 + hstep, voffA);
            PG8_WAIT_LOOP(); PG8_WAIT_L(0); PG8_BAR; PG8_MMA(0, 0, At, B0); PG8_MMA(0, 1, At, B1); PG8_BAR; PG8_SCHED;
            PG8_LDA(At, 1, 1); PG8_STAGE(PG8_SB(1, 0), b3, voffB); PG8_STAGE(PG8_SB(1, 1), b3 + hstepB, voffB); PG8_STAGE_A(PG8_SA(1, 0), a3, voffA);
            PG8_WAIT_LOOP(); PG8_WAIT_L(0); PG8_BAR; PG8_MMA(1, 0, At, B0); PG8_MMA(1, 1, At, B1); PG8_BAR; PG8_SCHED;
            } else {
            PG8_LDB(B0, 0, 0); PG8_SCHED; PG8_LDA(At, 0, 0); PG8_STAGE(PG8_SA(1, 1), a1 + hstep, voffA);
            PG8_WAIT_L(8); PG8_BAR; PG8_WAIT_L(0); PG8_MMA(0, 0, At, B0); PG8_BAR; PG8_SCHED;
            PG8_LDB(B1, 0, 1); PG8_STAGE(PG8_SB(0, 0), b2, voffB);
            PG8_BAR; PG8_WAIT_L(0); PG8_MMA(0, 1, At, B1); PG8_BAR;
            PG8_LDA(At, 0, 1); PG8_STAGE(PG8_SA(0, 0), a2, voffA);
            PG8_BAR; PG8_WAIT_L(0); PG8_MMA(1, 0, At, B0); PG8_BAR; PG8_SCHED;
            PG8_STAGE(PG8_SB(0, 1), b2 + hstepB, voffB);
            PG8_WAIT_V(6); PG8_BAR; PG8_MMA(1, 1, At, B1); PG8_BAR;
            PG8_LDB(B0, 1, 0); PG8_SCHED; PG8_LDA(At, 1, 0); PG8_STAGE(PG8_SA(0, 1), a2 + hstep, voffA);
            PG8_WAIT_L(8); PG8_BAR; PG8_WAIT_L(0); PG8_MMA(0, 0, At, B0); PG8_BAR; PG8_SCHED;
            PG8_LDB(B1, 1, 1); PG8_STAGE(PG8_SB(1, 0), b3, voffB);
            PG8_BAR; PG8_WAIT_L(0); PG8_MMA(0, 1, At, B1); PG8_BAR;
            PG8_LDA(At, 1, 1); PG8_STAGE(PG8_SA(1, 0), a3, voffA);
            PG8_BAR; PG8_WAIT_L(0); PG8_MMA(1, 0, At, B0); PG8_BAR; PG8_SCHED;
            PG8_STAGE(PG8_SB(1, 1), b3 + hstepB, voffB);
            PG8_WAIT_V(6); PG8_BAR; PG8_MMA(1, 1, At, B1); PG8_BAR;
            }
            if constexpr (Epi::MIDHOOK) { if (t + 2 == nt / 2) { E.mid(acc, cur, wr, wc, fr, fq); PG8_SCHED; } }
        }
        if constexpr (ALIGN_EPI) { if (wr == 0) PG8_BAR; }
        E(acc, cur, wr, wc, fr, fq);
        if (!has_next) break;
        {
#pragma unroll
        for (int a = 0; a < 2; ++a)
#pragma unroll
            for (int b = 0; b < 2; ++b)
#pragma unroll
                for (int m = 0; m < MB; ++m)
#pragma unroll
                    for (int n = 0; n < 2; ++n) acc[a][b][m][n] = (f32x4){0.f, 0.f, 0.f, 0.f};
        }
        cur = nxt; cA = nA; cB = nB; rot = nrot; ++ui;
        if constexpr (ALIGN_EPI) { if (wr == 1) PG8_BAR; }
    }
    PG8_WAIT_V(0);
    if constexpr (!ALIGN_EPI) { if (wr == 0) PG8_BAR; }
    PG8_BAR;
#undef PG8_SA
#undef PG8_SB
#undef PG8_STAGE
#undef PG8_STAGE_A
#undef PG8_WAIT_VN
#undef PG8_WAIT_LOOP
#undef PG8_WAIT_P1
#undef PG8_WAIT_P2
#undef PG8_LDA
#undef PG8_LDB
#undef PG8_MMA
#undef PG8_WAIT_V
#undef PG8_WAIT_L
#undef PG8_BAR
#undef PG8_SCHED
}
}

#define AS4 __attribute__((address_space(4)))
__device__ __forceinline__ const float* kin(int k) { const AS4 char* p = (const AS4 char*)__builtin_amdgcn_kernarg_segment_ptr(); asm volatile("" : "+s"(p)); return *(const float* const AS4*)(p + 8 * k); }
__device__ __forceinline__ float* kout() { const AS4 char* p = (const AS4 char*)__builtin_amdgcn_kernarg_segment_ptr(); asm volatile("" : "+s"(p)); return *(float* const AS4*)(p + 160); }
__device__ __forceinline__ int kint(int off) { const AS4 char* p = (const AS4 char*)__builtin_amdgcn_kernarg_segment_ptr(); asm volatile("" : "+s"(p)); return *(const int AS4*)(p + off); }
__device__ __forceinline__ unsigned char* kws() { const AS4 char* p = (const AS4 char*)__builtin_amdgcn_kernarg_segment_ptr(); asm volatile("" : "+s"(p)); return *(unsigned char* const AS4*)(p + 168); }
#define I_X_PROMPT 0
#define I_X_SAMPLE 1
#define I_CACHE_K 2
#define I_CACHE_V 3
#define I_C 4
#define I_C_CTX 5
#define I_RMS_G 6
#define I_W_ADA 7
#define I_B_ADA 8
#define I_W_IN 9
#define I_B_IN 10
#define I_REL_BIAS 11
#define I_DW_W 12
#define I_DW_B 13
#define I_LN_G 14
#define I_LN_B 15
#define I_W_PROJ_A 16
#define I_W_PROJ_B 17
#define I_W_OUT 18
#define I_FINAL_G 19
#define WSP(T, off) ((T*)(kws() + (off)))

constexpr float QSCALE = 0.125f * 1.4426950408889634f;
typedef f32x4 acc_t[2][2][4][2];
typedef f32x4 acc3_t[2][2][3][2];

template <int MB_, bool FU = false> struct EpiInT {
    static constexpr bool PERM = true, SPLIT2 = false, MIDHOOK = false; static constexpr int KROT = 0; static constexpr int MB = MB_;
    typedef f32x4 accm_t[2][2][MB_][2];
    int layer, rowbase;
    template <bool ACT, bool ST, bool QS = false> __device__ __forceinline__ void plain(accm_t& acc, const f32x4 (&bv)[2][2], bf16_t* dst, float* st, int row0, int colbase) const {
#pragma unroll
        for (int ai = 0; ai < 2; ++ai)
#pragma unroll
            for (int m = 0; m < MB_; ++m) { const int row = row0 + ai * (32 * MB_) + m * 16;
#pragma unroll
                for (int bj = 0; bj < 2; ++bj) { f32x4 v0 = acc[ai][bj][m][0] + bv[bj][0], v1 = acc[ai][bj][m][1] + bv[bj][1];
                    if (QS) { v0 = v0 * QSCALE; v1 = v1 * QSCALE; }
                    if (ST) { float* sp = st + ((size_t)((row >> 8) * 512 + layer * 256 + (row & 255))) * 512 + colbase + bj * 128; *(f32x4*)sp = v0; *(f32x4*)(sp + 4) = v1; }
                    if (ACT) {
#pragma unroll
                        for (int j = 0; j < 4; ++j) { v0[j] = silu_f(v0[j]); v1[j] = silu_f(v1[j]); } }
                    u32x4 w; w.x = cvt_pk_bf16(v0[0], v0[1]); w.y = cvt_pk_bf16(v0[2], v0[3]); w.z = cvt_pk_bf16(v1[0], v1[1]); w.w = cvt_pk_bf16(v1[2], v1[3]);
                    *(u32x4*)(dst + (size_t)row * 512 + colbase + bj * 128) = w; } }
    }
    __device__ __forceinline__ void operator()(accm_t& acc, const pg8::Unit& u, int wr, int wc, int fr, int fq) const {
        asm volatile("" : "+v"(fr), "+v"(fq));
        const int row0 = rowbase + u.pm * (64 * MB_) + wr * (16 * MB_) + fr, c8 = wc * 32 + 8 * fq, pn = u.pn;
        const bool ctxrows = rowbase + u.pm * (64 * MB_) < NCTX;
        unsigned char* wsb = kws();
        bf16_t* Q = (bf16_t*)(wsb + WS_Q); bf16_t* K = (bf16_t*)(wsb + WS_K); bf16_t* V = (bf16_t*)(wsb + WS_V); bf16_t* SZA = (bf16_t*)(wsb + WS_SZA); bf16_t* U = (bf16_t*)(wsb + WS_U);
        bf16_t* SZB = (bf16_t*)(wsb + WS_SZB); bf16_t* GR = (bf16_t*)(wsb + WS_GR); bf16_t* GB = (bf16_t*)(wsb + WS_GB);
        const int tr0 = rowbase + u.pm * (64 * MB_), tg = tr0 < NCTX ? 0 : 1 + ((tr0 - NCTX) >> 11);
        const float* bp = FU ? (const float*)(wsb + WS_CVEC) + tg * DIN + pn * 256 + c8 : (const float*)(wsb + WS_BIASP) + layer * DIN + pn * 256 + c8;
        if (FU) { const float* rss = (const float*)(wsb + WS_RSS); float rq[2][MB_];
#pragma unroll
            for (int ai = 0; ai < 2; ++ai)
#pragma unroll
                for (int m = 0; m < MB_; ++m) rq[ai][m] = rss[row0 + ai * (32 * MB_) + m * 16];
#pragma unroll
            for (int ai = 0; ai < 2; ++ai)
#pragma unroll
                for (int m = 0; m < MB_; ++m) { const float rs = rsqrtf(rq[ai][m] * (1.0f / D) + EPS);
#pragma unroll
                    for (int bj = 0; bj < 2; ++bj) { acc[ai][bj][m][0] = acc[ai][bj][m][0] * rs; acc[ai][bj][m][1] = acc[ai][bj][m][1] * rs; } } }
        float* stk = kout() + (size_t)M * D; float* stv = stk + (size_t)16 * 2 * 256 * 512;
        f32x4 bv[2][2];
#pragma unroll
        for (int bj = 0; bj < 2; ++bj)
#pragma unroll
            for (int n = 0; n < 2; ++n) bv[bj][n] = *(const f32x4*)(bp + bj * 128 + 4 * n);
        const int colbase = (pn & 1) * 256 + c8;
        if (pn < 2) plain<false, false, true>(acc, bv, Q, nullptr, row0, colbase);
        else if (pn < 4) { if (ctxrows) plain<false, true>(acc, bv, K, stk, row0, colbase); else plain<false, false>(acc, bv, K, nullptr, row0, colbase); }
        else if (pn < 6) { if (ctxrows) plain<false, true>(acc, bv, V, stv, row0, colbase); else plain<false, false>(acc, bv, V, nullptr, row0, colbase); }
        else if (pn < 8) plain<true, false>(acc, bv, SZA, nullptr, row0, colbase);
        else if (pn == 12 || pn == 13) plain<true, false>(acc, bv, SZB, nullptr, row0, colbase);
        else if (pn < 12) {
            const int cb = (pn - 8) * 128 + c8;
#pragma unroll
            for (int ai = 0; ai < 2; ++ai)
#pragma unroll
                for (int m = 0; m < MB_; ++m) { const int row = row0 + ai * (32 * MB_) + m * 16;
                    f32x4 a0 = acc[ai][0][m][0] + bv[0][0], a1 = acc[ai][0][m][1] + bv[0][1], b0 = acc[ai][1][m][0] + bv[1][0], b1 = acc[ai][1][m][1] + bv[1][1];
#pragma unroll
                    for (int j = 0; j < 4; ++j) { a0[j] *= sigmoid_f(b0[j]); a1[j] *= sigmoid_f(b1[j]); }
                    u32x4 w; w.x = cvt_pk_bf16(a0[0], a0[1]); w.y = cvt_pk_bf16(a0[2], a0[3]); w.z = cvt_pk_bf16(a1[0], a1[1]); w.w = cvt_pk_bf16(a1[2], a1[3]);
                    *(u32x4*)(U + (size_t)row * 512 + cb) = w; }
        } else {
            const int cb = (pn - 14) * 128 + c8;
#pragma unroll
            for (int ai = 0; ai < 2; ++ai)
#pragma unroll
                for (int m = 0; m < MB_; ++m) { const int row = row0 + ai * (32 * MB_) + m * 16;
                    f32x4 a0 = acc[ai][0][m][0] + bv[0][0], a1 = acc[ai][0][m][1] + bv[0][1], b0 = acc[ai][1][m][0] + bv[1][0], b1 = acc[ai][1][m][1] + bv[1][1];
                    f32x4 r0, r1, g0, g1;
#pragma unroll
                    for (int j = 0; j < 4; ++j) {
                        const float ea0 = __expf(-a0[j]), ea1 = __expf(-a1[j]), eb0 = fminf(__expf(-b0[j]), 1e30f), eb1 = fminf(__expf(-b1[j]), 1e30f);
                        g0[j] = __builtin_amdgcn_rcpf(1.0f + eb0); g1[j] = __builtin_amdgcn_rcpf(1.0f + eb1);
                        r0[j] = (1.0f + eb0) * __builtin_amdgcn_rcpf(1.0f + ea0); r1[j] = (1.0f + eb1) * __builtin_amdgcn_rcpf(1.0f + ea1); }
                    u32x4 w; w.x = cvt_pk_bf16(r0[0], r0[1]); w.y = cvt_pk_bf16(r0[2], r0[3]); w.z = cvt_pk_bf16(r1[0], r1[1]); w.w = cvt_pk_bf16(r1[2], r1[3]);
                    *(u32x4*)(GR + (size_t)row * 1024 + cb) = w;
                    w.x = cvt_pk_bf16(g0[0], g0[1]); w.y = cvt_pk_bf16(g0[2], g0[3]); w.z = cvt_pk_bf16(g1[0], g1[1]); w.w = cvt_pk_bf16(g1[2], g1[3]);
                    *(u32x4*)(GB + (size_t)row * 1024 + cb) = w; }
        }
    }
};

struct EpiProj {
    static constexpr bool PERM = true, SPLIT2 = false, MIDHOOK = true; static constexpr int KROT = 3; static constexpr int MB = 3;
    __device__ __forceinline__ void mid(acc3_t& acc, const pg8::Unit& u, int wr, int wc, int fr, int fq) const {
        asm volatile("" : "+v"(fr), "+v"(fq));
        const int row0 = u.pm * 192 + wr * 48 + fr, col0 = u.pn * 256 + wc * 32 + 8 * fq;
        const bf16_t* G = WSP(bf16_t, WS_GR);
#pragma unroll
        for (int ai = 0; ai < 2; ++ai)
#pragma unroll
            for (int m = 0; m < 3; ++m) { const size_t off = (size_t)(row0 + ai * 96 + m * 16) * 1024 + col0;
#pragma unroll
                for (int bj = 0; bj < 2; ++bj) { const u32x4 w = *(const u32x4*)(G + off + bj * 128);
                    acc[ai][bj][m][0] = acc[ai][bj][m][0] * (f32x4){bflo(w.x), bfhi(w.x), bflo(w.y), bfhi(w.y)}; acc[ai][bj][m][1] = acc[ai][bj][m][1] * (f32x4){bflo(w.z), bfhi(w.z), bflo(w.w), bfhi(w.w)}; } }
    }
    __device__ __forceinline__ void operator()(acc3_t& acc, const pg8::Unit& u, int wr, int wc, int fr, int fq) const {
        asm volatile("" : "+v"(fr), "+v"(fq));
        const int row0 = u.pm * 192 + wr * 48 + fr, col0 = u.pn * 256 + wc * 32 + 8 * fq;
        unsigned char* wsb = kws();
        const bf16_t* G = (const bf16_t*)(wsb + WS_GB); bf16_t* Mo = (bf16_t*)(wsb + WS_H);
#pragma unroll
        for (int ai = 0; ai < 2; ++ai)
#pragma unroll
            for (int m = 0; m < 3; ++m) { const size_t off = (size_t)(row0 + ai * 96 + m * 16) * 1024 + col0;
#pragma unroll
                for (int bj = 0; bj < 2; ++bj) { const u32x4 w = *(const u32x4*)(G + off + bj * 128);
                    const f32x4 v0 = acc[ai][bj][m][0] * (f32x4){bflo(w.x), bfhi(w.x), bflo(w.y), bfhi(w.y)}, v1 = acc[ai][bj][m][1] * (f32x4){bflo(w.z), bfhi(w.z), bflo(w.w), bfhi(w.w)};
                    u32x4 o; o.x = cvt_pk_bf16(v0[0], v0[1]); o.y = cvt_pk_bf16(v0[2], v0[3]); o.z = cvt_pk_bf16(v1[0], v1[1]); o.w = cvt_pk_bf16(v1[2], v1[3]);
                    *(u32x4*)(Mo + off + bj * 128) = o; }
                asm volatile("" ::: "memory"); }
    }
};

template <bool LAST> struct EpiOutT {
    static constexpr bool PERM = true, SPLIT2 = false, MIDHOOK = false; static constexpr int KROT = 1; static constexpr int MB = 3;
    int layer;
    __device__ __forceinline__ void operator()(acc3_t& acc, const pg8::Unit& u, int wr, int wc, int fr, int fq) const {
        asm volatile("" : "+v"(fr), "+v"(fq));
        const int row0 = u.pm * 192 + wr * 48 + fr, col0 = u.pn * 256 + wc * 32 + 8 * fq;
        const float* modl = WSP(float, WS_MOD) + layer * 5 * 3072 + 2048 + col0;
        const float* xp = kin(I_X_PROMPT); const float* xs = kin(I_X_SAMPLE) - (size_t)NCTX * D;
        bf16_t* X1 = WSP(bf16_t, WS_X1); bf16_t* XG = WSP(bf16_t, WS_YAB);
        float* rss = WSP(float, LAST ? WS_RSS2 : WS_RSS);
        const float* gfin = kin(I_FINAL_G) + col0;
        float olds[6];
#pragma unroll
        for (int ai = 0; ai < 2; ++ai)
#pragma unroll
            for (int m = 0; m < 3; ++m) { const int row = row0 + ai * 96 + m * 16; const size_t off = (size_t)row * D + col0;
                const int g = row < NCTX ? 0 : 1 + ((row - NCTX) >> 11);
                const float* gate = modl + g * 3072; const float* xin = row < NCTX ? xp : xs;
                float ssq = 0.f;
#pragma unroll
                for (int bj = 0; bj < 2; ++bj) { const size_t o_ = off + bj * 128;
                    const f32x4 gv0 = *(const f32x4*)(gate + bj * 128), gv1 = *(const f32x4*)(gate + bj * 128 + 4);
                    f32x4 xi0, xi1;
                    if (LAST) { const u32x4 xw = *(const u32x4*)(X1 + o_); xi0 = (f32x4){bflo(xw.x), bfhi(xw.x), bflo(xw.y), bfhi(xw.y)}; xi1 = (f32x4){bflo(xw.z), bfhi(xw.z), bflo(xw.w), bfhi(xw.w)}; }
                    else { xi0 = *(const f32x4*)(xin + o_); xi1 = *(const f32x4*)(xin + o_ + 4); }
                    const f32x4 xn0 = xi0 + gv0 * acc[ai][bj][m][0], xn1 = xi1 + gv1 * acc[ai][bj][m][1];
                    ssq += ((xn0[0] * xn0[0] + xn0[1] * xn0[1]) + (xn0[2] * xn0[2] + xn0[3] * xn0[3])) + ((xn1[0] * xn1[0] + xn1[1] * xn1[1]) + (xn1[2] * xn1[2] + xn1[3] * xn1[3]));
                    const float* gmp = LAST ? gfin + bj * 128 : WSP(float, WS_GM) + g * 1024 + col0 + bj * 128;
                    const f32x4 y0 = xn0 * *(const f32x4*)gmp, y1 = xn1 * *(const f32x4*)(gmp + 4);
                    if (LAST) { acc[ai][bj][m][0] = y0; acc[ai][bj][m][1] = y1; }
                    else { u32x4 w; w.x = cvt_pk_bf16(y0[0], y0[1]); w.y = cvt_pk_bf16(y0[2], y0[3]); w.z = cvt_pk_bf16(y1[0], y1[1]); w.w = cvt_pk_bf16(y1[2], y1[3]);
                        *(u32x4*)(XG + o_) = w;
                        u32x4 xw; xw.x = cvt_pk_bf16(xn0[0], xn0[1]); xw.y = cvt_pk_bf16(xn0[2], xn0[3]); xw.z = cvt_pk_bf16(xn1[0], xn1[1]); xw.w = cvt_pk_bf16(xn1[2], xn1[3]);
                        *(u32x4*)(X1 + o_) = xw; } }
                ssq += __shfl_xor(ssq, 16); ssq += __shfl_xor(ssq, 32);
                float o = 0.f;
                if (LAST) { if (fq == 0) o = __hip_atomic_fetch_add(rss + row, ssq, __ATOMIC_RELAXED, __HIP_MEMORY_SCOPE_AGENT); }
                else { if (fq == 0) (void)__hip_atomic_fetch_add(rss + row, ssq, __ATOMIC_RELAXED, __HIP_MEMORY_SCOPE_AGENT); }
                olds[ai * 3 + m] = o;
                asm volatile("" ::: "memory"); }
        if constexpr (LAST) {
            asm volatile("" :: "v"(olds[0]), "v"(olds[1]), "v"(olds[2]), "v"(olds[3]), "v"(olds[4]), "v"(olds[5]));
            asm volatile("s_waitcnt vmcnt(0)" ::: "memory");
            __syncthreads();
            if (fresh_tid() == 0) { unsigned* cnt = WSP(unsigned, WS_CTL) + CW_ROWBLK + u.pm * 16;
                (void)__hip_atomic_fetch_add(cnt, 1u, __ATOMIC_RELAXED, __HIP_MEMORY_SCOPE_AGENT);
                unsigned sp = 0; while (__hip_atomic_load(cnt, __ATOMIC_RELAXED, __HIP_MEMORY_SCOPE_AGENT) < 4u) { __builtin_amdgcn_s_sleep(1); if (++sp > (1u << 22)) break; } }
            __syncthreads();
            float* out = kout();
            float sq[6];
#pragma unroll
            for (int k = 0; k < 6; ++k) sq[k] = __hip_atomic_load(rss + row0 + (k / 3) * 96 + (k % 3) * 16, __ATOMIC_RELAXED, __HIP_MEMORY_SCOPE_AGENT);
#pragma unroll
            for (int ai = 0; ai < 2; ++ai)
#pragma unroll
                for (int m = 0; m < 3; ++m) { const int row = row0 + ai * 96 + m * 16; float* yr = out + (size_t)row * D + col0;
                    const float rstd = rsqrtf(sq[ai * 3 + m] * (1.f / D) + EPS);
#pragma unroll
                    for (int bj = 0; bj < 2; ++bj) { *(f32x4*)(yr + bj * 128) = acc[ai][bj][m][0] * rstd; *(f32x4*)(yr + bj * 128 + 4) = acc[ai][bj][m][1] * rstd; } }
        }
    }
};

#define XB_TMO      128
#define XB_XCNT(j)  (256  + 64 * (j))
#define XB_XSUB(j)  (1280 + 64 * (j))
#define XB_XGEN(j)  (2304 + 64 * (j))
#define XB_TOP      3328
#define XB_TOPGEN   3392
#define XCD_BAR_WORDS 3456
#define XB_SPIN_CAP (1u << 18)
__device__ __forceinline__ unsigned xb_ld(unsigned* p)              { return __hip_atomic_load(p, __ATOMIC_RELAXED, __HIP_MEMORY_SCOPE_AGENT); }
__device__ __forceinline__ unsigned xb_add(unsigned* p, unsigned v) { return __hip_atomic_fetch_add(p, v, __ATOMIC_RELAXED, __HIP_MEMORY_SCOPE_AGENT); }
__device__ __forceinline__ unsigned xb_xcc_id() { return (unsigned)__builtin_amdgcn_s_getreg((3 << 11) | 20) & 0xFu; }
#define XB_SPIN(cond, bar) do { unsigned _sp = 0; while (cond) { __builtin_amdgcn_s_sleep(1); \
    if ((++_sp & 255u) == 0u) { if (xb_ld(&(bar)[XB_TMO])) break; if (_sp > XB_SPIN_CAP) { atomicAdd(&(bar)[XB_TMO], 1u); break; } } } } while (0)
struct XcdBarrier { unsigned* bar; unsigned x; volatile LAS unsigned* st; };
__device__ __forceinline__ XcdBarrier xcd_barrier_post(unsigned* bar, volatile LAS unsigned* st) {
    XcdBarrier b; b.bar = bar; b.x = xb_xcc_id(); b.st = st;
    if (threadIdx.x == 0) (void)xb_add(&bar[XB_XCNT(b.x)], 1u);
    return b;
}
__device__ __forceinline__ void xcd_barrier_complete(unsigned* bar, unsigned x, unsigned& nloc, unsigned& nx) {
    const unsigned G = gridDim.x * gridDim.y * gridDim.z;
    unsigned sum, cnt, mine, sp = 0u;
    for (;;) {
        sum = 0u; cnt = 0u; mine = 0u;
#pragma unroll
        for (unsigned j = 0; j < 16; ++j) { const unsigned c = xb_ld(&bar[XB_XCNT(j)]); sum += c; cnt += (c > 0u) ? 1u : 0u; mine = (j == x) ? c : mine; }
        if (sum == G) break;
        __builtin_amdgcn_s_sleep(1);
        if ((++sp & 255u) == 0u) { if (xb_ld(&bar[XB_TMO])) break; if (sp > XB_SPIN_CAP) { atomicAdd(&bar[XB_TMO], 1u); break; } }
    }
    nloc = mine > 0u ? mine : 1u; nx = cnt > 0u ? cnt : 1u;
}
__device__ __forceinline__ void xcd_barrier(const XcdBarrier& b) {
    asm volatile("s_waitcnt vmcnt(0)" ::: "memory");
    __syncthreads();
    if (fresh_tid() == 0) {
        unsigned* bar = b.bar;
        __builtin_amdgcn_s_waitcnt(0);
        unsigned nloc = b.st[0], nx = b.st[1];
        if (nloc == 0u) { xcd_barrier_complete(bar, b.x, nloc, nx); b.st[0] = nloc; b.st[1] = nx; }
        const unsigned old = xb_add(&bar[XB_XSUB(b.x)], 1u);
        const unsigned gen = old / nloc;
        if (old + 1u == (gen + 1u) * nloc) {
            __builtin_amdgcn_fence(__ATOMIC_RELEASE, "agent");
            asm volatile("s_waitcnt vmcnt(0)" ::: "memory");
            const unsigned og = xb_add(&bar[XB_TOP], 1u);
            const unsigned tg = og / nx;
            if (og + 1u == (tg + 1u) * nx) xb_add(&bar[XB_TOPGEN], 1u);
            else XB_SPIN(xb_ld(&bar[XB_TOPGEN]) == tg, bar);
            __builtin_amdgcn_fence(__ATOMIC_ACQUIRE, "agent");
            xb_add(&bar[XB_XGEN(b.x)], 1u);
            asm volatile("s_waitcnt vmcnt(0)" ::: "memory");
        } else {
            XB_SPIN(xb_ld(&bar[XB_XGEN(b.x)]) == gen, bar);
            __builtin_amdgcn_fence(__ATOMIC_ACQUIRE, "agent");
            asm volatile("s_waitcnt vmcnt(0)" ::: "memory");
        }
    }
    __syncthreads();
}

struct Frame {
    LAS unsigned char* lds;
    int tid, lane, wave, G, bx;
};


__device__ __forceinline__ int in_srccol(int n) {
    const int tile = n >> 8, r = n & 255;
    if (tile < 8 || tile == 12 || tile == 13) return n;
    if (tile < 12) { const int i = tile - 8; return (r < 128 ? 2048 : 2560) + 128 * i + (r & 127); }
    const int i = tile - 14; return (r < 128 ? 3584 : 4608) + 128 * i + (r & 127);
}

__device__ __forceinline__ void transpose_item(const float* W, int ldw, int srccol0, int k0, bf16_t* WT, int dstrow0, int dstk0, LAS float* scr, int lane) {
    float tv[32];
#pragma unroll
    for (int i = 0; i < 32; ++i) { const int kk = 2 * i + (lane >> 5); tv[i] = W[(size_t)(k0 + kk) * ldw + srccol0 + (lane & 31)]; }
#pragma unroll
    for (int i = 0; i < 32; ++i) { const int kk = 2 * i + (lane >> 5); scr[kk * 33 + (lane & 31)] = tv[i]; }
    LDS_WAIT(); asm volatile("" ::: "memory");
    const int c = lane & 7;
#pragma unroll
    for (int j = 0; j < 4; ++j) { const int n = (lane >> 3) + 8 * j; const LAS float* s = scr + (8 * c) * 33 + n;
        u32x4 o; o.x = pk2(s[0 * 33], s[1 * 33]); o.y = pk2(s[2 * 33], s[3 * 33]); o.z = pk2(s[4 * 33], s[5 * 33]); o.w = pk2(s[6 * 33], s[7 * 33]);
        *(GAS u32x4*)(WT + (size_t)(dstrow0 + n) * 1024 + dstk0 + 8 * c) = o; }
    LDS_WAIT(); asm volatile("" ::: "memory");
}

__device__ __forceinline__ void mod_task(Frame& F, int t) {
    const int l = t / 48, j0 = (t % 48) * 64;
    const float* c_ctx = kin(I_C_CTX); const float* cvec = kin(I_C); const float* w_ada = kin(I_W_ADA); const float* b_ada = kin(I_B_ADA); float* MOD = WSP(float, WS_MOD);
    LAS float* sv = (LAS float*)F.lds;
    LAS float* part = (LAS float*)(F.lds + 20480);
    for (int i = F.tid; i < 5 * 1024; i += 512) { const int g = i >> 10, k = i & 1023; const float c = (g == 0) ? c_ctx[k] : cvec[(g - 1) * 1024 + k]; sv[i] = silu_f(c); }
    __syncthreads();
    const float* W = w_ada + (size_t)l * 1024 * 3072 + (size_t)(128 * F.wave) * 3072 + j0 + F.lane;
    float a0 = 0.f, a1 = 0.f, a2 = 0.f, a3 = 0.f, a4 = 0.f;
#pragma unroll 32
    for (int kk = 0; kk < 128; ++kk) { const float wv = W[(size_t)kk * 3072]; const int k = 128 * F.wave + kk;
        a0 += sv[k] * wv; a1 += sv[1024 + k] * wv; a2 += sv[2048 + k] * wv; a3 += sv[3072 + k] * wv; a4 += sv[4096 + k] * wv; }
    part[(F.wave * 5 + 0) * 64 + F.lane] = a0; part[(F.wave * 5 + 1) * 64 + F.lane] = a1; part[(F.wave * 5 + 2) * 64 + F.lane] = a2;
    part[(F.wave * 5 + 3) * 64 + F.lane] = a3; part[(F.wave * 5 + 4) * 64 + F.lane] = a4;
    __syncthreads();
    if (F.tid < 320) { const int g = F.tid >> 6, ln = F.tid & 63; float s = 0.f;
#pragma unroll
        for (int w = 0; w < 8; ++w) s += part[(w * 5 + g) * 64 + ln];
        MOD[(l * 5 + g) * 3072 + j0 + ln] = s + b_ada[l * 3072 + j0 + ln]; }
    __syncthreads();
}

__device__ __forceinline__ void wt_items(Frame& F, int l, int w0, int nw);
__device__ __forceinline__ void p0_prologue(Frame& F) {
    if (F.bx < 96) mod_task(F, F.bx);
    const int gw = F.bx * 8 + F.wave, NGW = F.G * 8;
    const int gt = F.bx * 512 + F.tid, NGT = F.G * 512;
    { float* BIASP = WSP(float, WS_BIASP); const float* b_in = kin(I_B_IN);
      for (int i = gt; i < DEPTH * DIN; i += NGT) { const int l = i / DIN, n = i % DIN; BIASP[i] = b_in[l * DIN + in_srccol(n)]; } }
    const float* cache_k = kin(I_CACHE_K); const float* cache_v = kin(I_CACHE_V); bf16_t* CK = WSP(bf16_t, WS_CK); bf16_t* CV = WSP(bf16_t, WS_CV);
    for (int i0 = gt; i0 < 2 * 131072; i0 += 2 * NGT) { f32x4 a[2], b[2];
#pragma unroll
        for (int k = 0; k < 2; ++k) { const int i = i0 + k * NGT; if (i < 2 * 131072) { const int which = i >> 17, e = (i & 131071) * 8; const float* src = (which ? cache_v : cache_k) + e; a[k] = *(const f32x4*)src; b[k] = *(const f32x4*)(src + 4); } }
#pragma unroll
        for (int k = 0; k < 2; ++k) { const int i = i0 + k * NGT; if (i < 2 * 131072) { const int which = i >> 17, e = (i & 131071) * 8; bf16_t* dst = (which ? CV : CK) + e;
            u32x4 w; w.x = pk2(a[k][0], a[k][1]); w.y = pk2(a[k][2], a[k][3]); w.z = pk2(b[k][0], b[k][1]); w.w = pk2(b[k][2], b[k][3]); *(u32x4*)dst = w; } } }
    wt_items(F, 0, gw, NGW);
    { const int nidle = F.G - (M - 46 * 256) / 128 * (DIN / 256); if (nidle <= 0) wt_items(F, 1, gw, NGW); }
}

__device__ __forceinline__ void wt_items(Frame& F, int l, int w0, int nw) {
    LAS float* scr = (LAS float*)(F.lds + F.wave * 16384);
    const float* w_in = kin(I_W_IN); const float* w_proj_a = kin(I_W_PROJ_A); const float* w_proj_b = kin(I_W_PROJ_B); const float* w_out = kin(I_W_OUT);
    bf16_t* WTIN = WSP(bf16_t, WS_WTIN); bf16_t* WTPROJ = WSP(bf16_t, WS_WTPROJ); bf16_t* WTOUT = WSP(bf16_t, WS_WTOUT);
    constexpr int I_IN = 16 * 176, I_P = 8 * 32, I_O = 16 * 32, I_L = I_IN + 2 * I_P + I_O;
    for (int it = w0; it < I_L; it += nw) {
        int r = it;
        if (r < I_IN) { const int kb = r / 176, nb = r % 176; transpose_item(w_in + (size_t)l * D * DIN, DIN, in_srccol(32 * nb), 64 * kb, WTIN + (size_t)l * DIN * D, 32 * nb, 64 * kb, scr, F.lane); continue; } r -= I_IN;
        if (r < I_P) { const int kb = r / 32, nb = r % 32; transpose_item(w_proj_a + (size_t)l * 512 * D, D, 32 * nb, 64 * kb, WTPROJ + (size_t)l * D * D, 32 * nb, 64 * kb, scr, F.lane); continue; } r -= I_P;
        if (r < I_P) { const int kb = r / 32, nb = r % 32; transpose_item(w_proj_b + (size_t)l * 512 * D, D, 32 * nb, 64 * kb, WTPROJ + (size_t)l * D * D, 32 * nb, 512 + 64 * kb, scr, F.lane); continue; } r -= I_P;
        { const int kb = r / 32, nb = r % 32; transpose_item(w_out + (size_t)l * D * D, D, 32 * nb, 64 * kb, WTOUT + (size_t)l * D * D, 32 * nb, 64 * kb, scr, F.lane); }
    }
}

__device__ __forceinline__ void norm_phase(Frame& F, int layer) {
    const int gw = F.bx * 8 + F.wave, NGW = F.G * 8;
    const float* xa = layer == 0 ? kin(I_X_PROMPT) : kout(); const float* xb = layer == 0 ? kin(I_X_SAMPLE) : kout() + (size_t)NCTX * D;
    const float* MOD = WSP(float, WS_MOD); const float* rms_g = kin(I_RMS_G) + layer * D; bf16_t* H = WSP(bf16_t, WS_H);
    for (int rb = gw; rb < M; rb += 3 * NGW) {
        f32x4 v[3][4];
#pragma unroll
        for (int k = 0; k < 3; ++k) { const int r = rb + k * NGW; if (r < M) {
            const float* xrow = r < NCTX ? xa + (size_t)r * D : xb + (size_t)(r - NCTX) * D; const f32x4* xr = (const f32x4*)xrow + F.lane;
#pragma unroll
            for (int j = 0; j < 4; ++j) v[k][j] = xr[64 * j]; } }
#pragma unroll
        for (int k = 0; k < 3; ++k) { const int r = rb + k * NGW; if (r < M) {
            const int g = r < NCTX ? 0 : 1 + ((r - NCTX) >> 11);
            const float* mod = MOD + (layer * 5 + g) * 3072;
            float s = 0.f;
#pragma unroll
            for (int j = 0; j < 4; ++j) s += (v[k][j][0] * v[k][j][0] + v[k][j][1] * v[k][j][1]) + (v[k][j][2] * v[k][j][2] + v[k][j][3] * v[k][j][3]);
            const float rstd = rsqrtf(wave_sum(s) * (1.f / D) + EPS);
            unsigned long long* o8 = (unsigned long long*)(H + (size_t)r * D) + F.lane;
#pragma unroll
            for (int j = 0; j < 4; ++j) { const int c = 4 * F.lane + 256 * j;
                const f32x4 gg = *(const f32x4*)(rms_g + c), sh = *(const f32x4*)(mod + c), sc = *(const f32x4*)(mod + 1024 + c);
                const f32x4 y = v[k][j] * rstd * gg * (sc + 1.0f) + sh;
                o8[64 * j] = (unsigned long long)cvt_pk_bf16(y[0], y[1]) | ((unsigned long long)cvt_pk_bf16(y[2], y[3]) << 32); } } }
    }
}

struct AttnPre { u32x4 qrow[4], pa0, pc0, pa1, kreg, vreg, kreg2, vreg2; float bvv[8]; };
__device__ __forceinline__ void attn_prefetch(Frame& F, int layer, int task, const bool ctx, AttnPre& P);
__device__ __forceinline__ void conv_task(Frame& F, int layer, int tile, AttnPre& pre, int pre_task) {
    const int t0 = tile * 32;
    int s0, s1; if (t0 < NCTX) { s0 = t0 & ~255; s1 = s0 + 256; } else { s0 = NCTX + ((t0 - NCTX) & ~2047); s1 = s0 + 2048; }
    const bf16_t* Ub = WSP(bf16_t, WS_U); const bf16_t* SZB = WSP(bf16_t, WS_SZB); bf16_t* YAB = WSP(bf16_t, WS_YAB);
    const float* dw_w = kin(I_DW_W); const float* dw_b = kin(I_DW_B); const float* ln_g = kin(I_LN_G) + layer * 512; const float* ln_b = kin(I_LN_B) + layer * 512;
    LAS unsigned* Ul = (LAS unsigned*)F.lds;
    LAS float* Cl = (LAS float*)(F.lds + 62 * 1024);
    u32x4 xs[8];
#pragma unroll
    for (int k = 0; k < 8; ++k) { const int i = F.tid + 512 * k; const int lr = i >> 6, ch = i & 63; const int t = t0 - 15 + lr; xs[k] = (u32x4){0u, 0u, 0u, 0u};
        if (i < 62 * 64 && t >= s0 && t < s1) xs[k] = *(const u32x4*)(Ub + (size_t)t * 512 + ch * 8); }
    const int cp = F.tid & 255, th = F.tid >> 8;
    float w0[31], w1[31];
#pragma unroll
    for (int j = 0; j < 31; ++j) { const f32x2 w = *(const f32x2*)(dw_w + (size_t)(layer * 31 + j) * 512 + 2 * cp); w0[j] = w[0]; w1[j] = w[1]; }
    const f32x2 bb = *(const f32x2*)(dw_b + layer * 512 + 2 * cp);
    u32x2 zq[4][2];
#pragma unroll
    for (int k = 0; k < 4; ++k) { const int t = t0 + F.wave * 4 + k; zq[k][0] = *(const u32x2*)(SZB + (size_t)t * 512 + 4 * F.lane); zq[k][1] = *(const u32x2*)(SZB + (size_t)t * 512 + 256 + 4 * F.lane); }
#pragma unroll
    for (int k = 0; k < 8; ++k) { const int i = F.tid + 512 * k; if (i < 62 * 64) *(LAS u32x4*)(Ul + (i >> 6) * 256 + (i & 63) * 4) = xs[k]; }
    __syncthreads();
    {
        for (int blk = 0; blk < 4; ++blk) { const int tt0 = th * 16 + blk * 4;
            float a0[4], a1[4];
#pragma unroll
            for (int o = 0; o < 4; ++o) { a0[o] = bb[0]; a1[o] = bb[1]; }
#pragma unroll
            for (int i = 0; i < 34; ++i) { const unsigned x = Ul[(tt0 + i) * 256 + cp]; const float x0 = bflo(x), x1 = bfhi(x);
#pragma unroll
                for (int o = 0; o < 4; ++o) { const int j = i - o; if (j >= 0 && j < 31) { a0[o] += w0[j] * x0; a1[o] += w1[j] * x1; } } }
#pragma unroll
            for (int o = 0; o < 4; ++o) *(LAS f32x2*)(Cl + (tt0 + o) * 512 + 2 * cp) = (f32x2){a0[o], a1[o]};
        }
    }
    __syncthreads();
    const f32x4 g0 = *(const f32x4*)(ln_g + 4 * F.lane), g1 = *(const f32x4*)(ln_g + 256 + 4 * F.lane);
    const f32x4 b0 = *(const f32x4*)(ln_b + 4 * F.lane), b1 = *(const f32x4*)(ln_b + 256 + 4 * F.lane);
    asm volatile("" ::: "memory");
    if (pre_task >= 0) attn_prefetch(F, layer, pre_task, false, pre);
    asm volatile("" ::: "memory");
#pragma unroll
    for (int k = 0; k < 4; ++k) { const int tt = F.wave * 4 + k, t = t0 + tt;
        f32x4 v0 = *(LAS f32x4*)(Cl + tt * 512 + 4 * F.lane), v1 = *(LAS f32x4*)(Cl + tt * 512 + 256 + 4 * F.lane);
        const float mean = wave_sum((v0[0] + v0[1]) + (v0[2] + v0[3]) + (v1[0] + v1[1]) + (v1[2] + v1[3])) * (1.f / 512.f);
        v0 = v0 - mean; v1 = v1 - mean;
        const float var = wave_sum((v0[0] * v0[0] + v0[1] * v0[1]) + (v0[2] * v0[2] + v0[3] * v0[3]) + (v1[0] * v1[0] + v1[1] * v1[1]) + (v1[2] * v1[2] + v1[3] * v1[3])) * (1.f / 512.f);
        const float rstd = rsqrtf(var + EPS);
        f32x4 y0 = v0 * rstd * g0 + b0, y1 = v1 * rstd * g1 + b1;
        const u32x2 z0 = zq[k][0], z1 = zq[k][1];
        const f32x4 zz0 = (f32x4){bflo(z0.x), bfhi(z0.x), bflo(z0.y), bfhi(z0.y)}, zz1 = (f32x4){bflo(z1.x), bfhi(z1.x), bflo(z1.y), bfhi(z1.y)};
#pragma unroll
        for (int j = 0; j < 4; ++j) { y0[j] = silu_f(y0[j]) * zz0[j]; y1[j] = silu_f(y1[j]) * zz1[j]; }
        u32x2 o0, o1; o0.x = cvt_pk_bf16(y0[0], y0[1]); o0.y = cvt_pk_bf16(y0[2], y0[3]); o1.x = cvt_pk_bf16(y1[0], y1[1]); o1.y = cvt_pk_bf16(y1[2], y1[3]);
        *(u32x2*)(YAB + (size_t)t * 1024 + 512 + 4 * F.lane) = o0; *(u32x2*)(YAB + (size_t)t * 1024 + 768 + 4 * F.lane) = o1;
    }
    __syncthreads();
}

typedef float f32x16 __attribute__((ext_vector_type(16)));
typedef short s16x4 __attribute__((ext_vector_type(4)));
typedef __bf16 bf16x2_t __attribute__((ext_vector_type(2)));
__device__ __forceinline__ unsigned cvtpk_s(float lo, float hi) { f32x2 v = {lo, hi}; bf16x2_t b = __builtin_convertvector(v, bf16x2_t); return __builtin_bit_cast(unsigned, b); }
__device__ __forceinline__ s16x4 vtr(const LAS char* p) { return __builtin_bit_cast(s16x4, __builtin_amdgcn_ds_read_tr16_b64_v4i16((LAS s16x4*)p)); }
#define MFMA32(a, b, c) __builtin_amdgcn_mfma_f32_32x32x16_bf16((a), (b), (c), 0, 0, 0)
constexpr float LOG2E = 1.4426950408889634f;
constexpr float ATT_QSCALE = 0.125f * LOG2E;
constexpr int AT_SLOTB = 8192, AT_K = 0, AT_V = 3 * AT_SLOTB, AT_TBL = 6 * AT_SLOTB;
constexpr int AT_VSTRIDE = 68, AT_ROWF = 16 * AT_VSTRIDE + 52, AT_INF = AT_TBL + 15 * AT_ROWF * 4, AT_ZERO = AT_INF + 512, AT_END = AT_ZERO + 512;
static_assert(AT_END <= RING_BYTES, "attention LDS");
constexpr float ATT_THR = 8.0f;

#define ATT_DECODE() \
    int b, h, R0, r = 0, n_win = 0, lo = 0, qc = 0, r0 = 0; \
    if (!ctx) { const int R = 4 * (task & 7); h = (task >> 3) & 7; b = task >> 6; r = R + (wid >> 1); const int HALF = wid & 1; \
        R0 = NCTX + b * 2048 + r * 64 + HALF * 32; qc = HALF * 32 + r32; r0 = min(max(r - 4, 0), 24); \
        lo = min(max(R - 4, 0), 24); n_win = min(max(R - 1, 0), 24) + 8 - lo; \
    } else { h = task & 7; b = task >> 3; R0 = b * 256 + wid * 32; } \
    const int NT = n_win + 4; (void)qc; (void)r0; (void)r; (void)NT; \
    const unsigned ksoff = (unsigned)(lane * 512 + wid * 8), vsoff = (unsigned)((16 * (wid & 3) + (lane >> 2)) * 512 + (wid >> 2) * 32 + (lane & 3) * 8);
#define ATT_SRC(t, KP, VP) do { if ((t) < n_win) { const size_t o_ = (size_t)(NCTX + b * 2048 + (lo + (t)) * 64) * 512 + h * 64; KP = (const bf16_t*)(wsb + WS_K) + o_; VP = (const bf16_t*)(wsb + WS_V) + o_; } \
        else if (ctx) { const size_t o_ = (size_t)(b * 256 + ((t) - n_win) * 64) * 512 + h * 64; KP = (const bf16_t*)(wsb + WS_K) + o_; VP = (const bf16_t*)(wsb + WS_V) + o_; } \
        else { const size_t o_ = ((size_t)((b * 2 + layer) * 256 + ((t) - n_win) * 64)) * 512 + h * 64; KP = (const bf16_t*)(wsb + WS_CK) + o_; VP = (const bf16_t*)(wsb + WS_CV) + o_; } } while (0)
__device__ __forceinline__ void attn_prefetch(Frame& F, int layer, int task, const bool ctx, AttnPre& P) {
    const int tid = fresh_tid(), lane = tid & 63, r32 = lane & 31, wid = __builtin_amdgcn_readfirstlane(tid >> 6);
    unsigned char* wsb = kws();
    ATT_DECODE()
    { const bf16_t* qp = (const bf16_t*)(wsb + WS_Q) + (size_t)(R0 + (lane >> 3)) * 512 + h * 64 + (lane & 7) * 8;
#pragma unroll
      for (int i = 0; i < 4; ++i) P.qrow[i] = *(const u32x4*)(qp + (size_t)i * 8 * 512); }
    { const bf16_t *k0, *v0, *k1, *v1, *k2, *v2, *k3, *v3; ATT_SRC(0, k0, v0); ATT_SRC(1, k1, v1); ATT_SRC(2, k2, v2); ATT_SRC(3, k3, v3); (void)v3;
      P.pa0 = *(const u32x4*)(k0 + ksoff); P.pc0 = *(const u32x4*)(v0 + vsoff); P.pa1 = *(const u32x4*)(k1 + ksoff);
      P.kreg = *(const u32x4*)(k2 + ksoff); P.vreg = *(const u32x4*)(v1 + vsoff); P.kreg2 = *(const u32x4*)(k3 + ksoff); P.vreg2 = *(const u32x4*)(v2 + vsoff); }
    if (!ctx) { const float* rb = kin(I_REL_BIAS) + (size_t)(layer * 8 + h) * 465;
#pragma unroll
        for (int k = 0; k < 8; ++k) { const int i = tid + 512 * k, dr = i >> 8, v = (i >> 4) & 15, j = i & 15; P.bvv[k] = (i < 3840) ? rb[dr * 31 + v + j] : 0.f; } }
}

__device__ __forceinline__ void attn_wg(Frame& F, int layer, int task, const bool ctx, AttnPre& P, int next_ctx) {
    const int tid = fresh_tid(), lane = tid & 63, r32 = lane & 31, hi = lane >> 5, wid = __builtin_amdgcn_readfirstlane(tid >> 6);
    LAS char* L = (LAS char*)F.lds;
    unsigned char* wsb = kws();
    ATT_DECODE()
    const int kdst = AT_K + wid * 1024 + lane * 16, vdst = AT_V + wid * 1024 + lane * 16;
    u32x4 kreg = P.kreg, vreg = P.vreg, kreg2 = P.kreg2, vreg2 = P.vreg2;
    bf16x8 qr[4];
    { LAS char* stg = L + AT_TBL + wid * 4608; LAS char* srow = stg + (lane >> 3) * 144 + (lane & 7) * 16;
#pragma unroll
      for (int i = 0; i < 4; ++i) *(LAS u32x4*)(srow + i * 8 * 144) = P.qrow[i];
      asm volatile("s_waitcnt lgkmcnt(0)" ::: "memory");
#pragma unroll
      for (int s_ = 0; s_ < 4; ++s_) qr[s_] = *(const LAS bf16x8*)(stg + r32 * 144 + hi * 16 + s_ * 32);
      asm volatile("s_waitcnt lgkmcnt(0)" ::: "memory"); }
    { unsigned zz = 0u; asm volatile("" : "+v"(zz));
      if (tid < 32) *(LAS u32x4*)(L + AT_ZERO + 16 * tid) = (u32x4){zz, zz, zz, zz}; }
    if (!ctx) { unsigned ninf = 0xff800000u; asm volatile("" : "+v"(ninf));
        for (int i = lane; i < 4608 / 16; i += 64) *(LAS u32x4*)(L + AT_TBL + wid * 4608 + 16 * i) = (u32x4){ninf, ninf, ninf, ninf};
        for (int i = 8 * 4608 / 16 + tid; i < (AT_ZERO - AT_TBL) / 16; i += 512) *(LAS u32x4*)(L + AT_TBL + 16 * i) = (u32x4){ninf, ninf, ninf, ninf}; }
    *(LAS u32x4*)(L + kdst) = P.pa0; *(LAS u32x4*)(L + vdst) = P.pc0; *(LAS u32x4*)(L + AT_SLOTB + kdst) = P.pa1;
    if (!ctx) {
        asm volatile("s_waitcnt lgkmcnt(0)\n\ts_barrier" ::: "memory");
#pragma unroll
        for (int k = 0; k < 8; ++k) { const int i = tid + 512 * k, dr = i >> 8, v = (i >> 4) & 15, j = i & 15; if (i < 3840) *(LAS float*)(L + AT_TBL + (dr * AT_ROWF + v * AT_VSTRIDE + 48 + j) * 4) = P.bvv[k] * LOG2E; }
    }
    const int HALFW = ctx ? 0 : (wid & 1);
    const LAS char* kpA = L + AT_K + hi * 1024 + (32 * HALFW + r32) * 16;
    const LAS char* kpB = L + AT_K + hi * 1024 + (32 * (1 - HALFW) + ((r32 + 24 * HALFW) & 31)) * 16;
    const LAS char* vp0 = L + AT_V + ((lane >> 4) & 1) * 32 + (lane & 3) * 8 + (4 * hi + ((lane & 15) >> 2)) * 64;
    const int H2 = HALFW * 2048, O2 = (1 - HALFW) * 2048, rot = 3 * HALFW;
    const int vol0 = H2, voh0 = H2 + 512, vol1 = H2 + 1024, voh1 = H2 + 1536;
    const int vol2 = O2 + ((0 + rot) & 3) * 512, voh2 = O2 + ((1 + rot) & 3) * 512, vol3 = O2 + ((2 + rot) & 3) * 512, voh3 = O2 + ((3 + rot) & 3) * 512;
    const int vsh = (qc < 8 ? 8 - qc : (qc > 56 ? 56 - qc : 0)) + 7;
    const int tlane = AT_TBL + (67 * vsh + 4 * hi - qc + 63) * 4;
    const int offA = 128 * HALFW, offB = HALFW ? 96 : 128;
    const int NWP = n_win + ((n_win > 0 && ((n_win - 1) & 1)) ? 1 : 0), NTV = NWP + 4;
#define VT(t) ((t) < n_win ? (t) : ((t) < NWP ? n_win - 1 : (t) - (NWP - n_win)))
    float mhat = -INFINITY, l_reg = 0.f, fres = 1.f; bool resc = false;
    f32x16 o0, o1;
#pragma unroll
    for (int i = 0; i < 16; ++i) { o0[i] = 0.f; o1[i] = 0.f; }
    f32x16 pA0, pA1, pB0, pB1; bf16x8 kf[8]; s16x4 vlo[8], vhi[8]; u32x4 pw0, pw1, pw2, pw3;
#pragma unroll
    for (int i = 0; i < 16; ++i) { pA1[i] = 0.f; pB1[i] = 0.f; }
    int sl_prev = 0, sl_cur = 0, sl_next = AT_SLOTB;
#define SBAR() __builtin_amdgcn_sched_barrier(0)
#define PIN(x) asm volatile("" : "+v"(x))
#define WBAR() asm volatile("s_waitcnt lgkmcnt(0)\n\ts_barrier" ::: "memory")
#define ROT() do { sl_prev = sl_cur; sl_cur = sl_next; sl_next = (sl_next == 2 * AT_SLOTB) ? 0 : sl_next + AT_SLOTB; } while (0)
#define MX3(a, b, c) __builtin_fmaxf(__builtin_fmaxf((a), (b)), (c))
#define KLD2(so, j) do { kf[2 * (j)] = *(const LAS bf16x8*)(kpA + (so) + (j) * 2048); kf[2 * (j) + 1] = *(const LAS bf16x8*)(kpB + (so) + (j) * 2048); } while (0)
#define CADDR(tt) (((tt) < n_win && (unsigned)(lo + (tt) - r0) < 8u) ? tlane + (lo + (tt) - r + 7) * (AT_ROWF * 4) : AT_INF)
#define CLDA(X0, q) do { const int ro_ = (((2 * (q)) & 3) + 8 * ((2 * (q)) >> 2)) * 4; X0[2 * (q)] = *(const LAS float*)(L + cad + offA + ro_); X0[2 * (q) + 1] = *(const LAS float*)(L + cad + offA + ro_ + 4); } while (0)
#define CLDB(X1, q) do { X1[2 * (q)] = *(const LAS float*)(L + cad + offB + 8 * (q)); X1[2 * (q) + 1] = *(const LAS float*)(L + cad + offB + 8 * (q) + 4); } while (0)
#define DEC_TAIL() do { { auto rr_ = __builtin_amdgcn_permlane32_swap(__float_as_uint(rm_), __float_as_uint(rm_), false, false); rm_ = __builtin_fmaxf(__uint_as_float(rr_[0]), __uint_as_float(rr_[1])); } \
        resc = false; \
        if (__builtin_amdgcn_ballot_w64(rm_ > mhat + ATT_THR) != 0ull) { const float mn_ = __builtin_fmaxf(mhat, rm_); fres = __builtin_amdgcn_exp2f(mhat - mn_); l_reg *= fres; mhat = mn_; resc = true; } \
        nmh = (mhat == -INFINITY) ? 0.f : -mhat; } while (0)
#define DECIDE_D(C0, C1) do { float a_ = MX3(C0[0], C0[1], C1[0]), b_ = MX3(C0[2], C0[3], C1[1]); a_ = MX3(a_, C1[2], C1[3]); \
        _Pragma("unroll") for (int r_ = 4; r_ < 16; r_ += 4) { a_ = MX3(a_, C0[r_], C0[r_ + 1]); b_ = MX3(b_, C0[r_ + 2], C0[r_ + 3]); a_ = MX3(a_, C1[r_], C1[r_ + 1]); b_ = MX3(b_, C1[r_ + 2], C1[r_ + 3]); } \
        float rm_ = __builtin_fmaxf(a_, b_); DEC_TAIL(); } while (0)
#define DECIDE_W(C0, C1) do { float a_ = MX3(C0[0], C0[1], C1[0]), b_ = MX3(C0[2], C0[3], C1[1]); a_ = MX3(a_, C1[2], C1[3]); \
        _Pragma("unroll") for (int r_ = 4; r_ < 16; r_ += 4) { a_ = MX3(a_, C0[r_], C0[r_ + 1]); b_ = MX3(b_, C0[r_ + 2], C0[r_ + 3]); } \
        float rm_ = __builtin_fmaxf(a_, b_); DEC_TAIL(); } while (0)
#define RESC() do { if (resc) { _Pragma("unroll") for (int r_ = 0; r_ < 16; ++r_) { o0[r_] *= fres; o1[r_] *= fres; } } } while (0)
#define EX(v) __builtin_amdgcn_exp2f((v) + nmh)
#define PKW(P, i) cvtpk_s(P[i], P[(i) + 1])
#define PAF(k) __builtin_bit_cast(bf16x8, pw##k)
#define VFR(i) (bf16x8){vlo[i][0], vlo[i][1], vlo[i][2], vlo[i][3], vhi[i][0], vhi[i][1], vhi[i][2], vhi[i][3]}
#define VRD(i, s) do { vlo[i] = vtr(vp_ + (((i) >> 2) * 4096 + vol##s)); vhi[i] = vtr(vp_ + (((i) >> 2) * 4096 + voh##s)); } while (0)
#define GAPA(MF, a0, a1, a2, a3, W0, W1, PW) do { MF; sacc += a0; sacc += a1; sacc += a2; sacc += a3; PIN(sacc); W0; W1; PIN(PW); SBAR(); } while (0)
#define GAPM(MF) do { MF; SBAR(); } while (0)
#define GAPB(MF, X, i) do { MF; X[i] = EX(X[i]); X[(i) + 1] = EX(X[(i) + 1]); X[(i) + 2] = EX(X[(i) + 2]); X[(i) + 3] = EX(X[(i) + 3]); PIN(X); SBAR(); } while (0)
#define EXG(X, i) do { X[i] = EX(X[i]); X[(i) + 1] = EX(X[(i) + 1]); X[(i) + 2] = EX(X[(i) + 2]); X[(i) + 3] = EX(X[(i) + 3]); PIN(X); SBAR(); } while (0)
#define STAGE(t, KR, VR) do { *(LAS u32x4*)(L + sl_prev + kdst) = KR; *(LAS u32x4*)(L + sl_next + vdst) = VR; \
        { const int tk_ = VT(min((t) + 4, NTV - 1)), tv_ = VT(min((t) + 3, NTV - 1)); const bf16_t *kp_, *vq_, *kq_, *vv_; ATT_SRC(tk_, kp_, vq_); ATT_SRC(tv_, kq_, vv_); (void)vq_; (void)kq_; \
          KR = *(const u32x4*)(kp_ + ksoff); VR = *(const u32x4*)(vv_ + vsoff); } SBAR(); } while (0)
#define QK0(C0, CZ) C0 = (CZ) ? MFMA32(kf[0], qr[0], zero16) : MFMA32(kf[0], qr[0], C0)
#define QK1(C1, CZ) C1 = (CZ) ? MFMA32(kf[1], qr[0], zero16) : MFMA32(kf[1], qr[0], C1)
#define PHASEA_PW(C0, C1, P0, P1, CZ) do { \
    VRD(0, 0); SBAR(); float sacc = P0[0] + P0[1]; \
                       GAPA(QK0(C0, CZ), P0[2], P0[3], P0[4], P0[5],     pw0[0] = PKW(P0, 0),  pw0[1] = PKW(P0, 2),  pw0); \
    VRD(4, 0); SBAR(); GAPA(QK1(C1, CZ), P0[6], P0[7], P0[8], P0[9],     pw0[2] = PKW(P0, 4),  pw0[3] = PKW(P0, 6),  pw0); \
    VRD(1, 1); SBAR(); GAPA(C0 = MFMA32(kf[2], qr[1], C0), P0[10], P0[11], P0[12], P0[13], pw1[0] = PKW(P0, 8),  pw1[1] = PKW(P0, 10), pw1); \
    VRD(5, 1); SBAR(); GAPA(C1 = MFMA32(kf[3], qr[1], C1), P0[14], P0[15], P1[0], P1[1],   pw1[2] = PKW(P0, 12), pw1[3] = PKW(P0, 14), pw1); \
    VRD(2, 2); SBAR(); GAPA(C0 = MFMA32(kf[4], qr[2], C0), P1[2], P1[3], 0.f, 0.f,         pw2[0] = PKW(P1, 0),  pw2[1] = PKW(P1, 2),  pw2); \
    VRD(6, 2); SBAR(); GAPM(C1 = MFMA32(kf[5], qr[2], C1)); pw2[2] = 0u; pw2[3] = 0u; \
                       GAPM(C0 = MFMA32(kf[6], qr[3], C0)); GAPM(C1 = MFMA32(kf[7], qr[3], C1)); \
    l_reg += sacc; } while (0)
#define PHASEA_PD(C0, C1, P0, P1, CZ) do { \
    VRD(0, 0); SBAR(); float sacc = P0[0] + P0[1]; \
                       GAPA(QK0(C0, CZ), P0[2], P0[3], P0[4], P0[5],     pw0[0] = PKW(P0, 0),  pw0[1] = PKW(P0, 2),  pw0); \
    VRD(4, 0); SBAR(); GAPA(QK1(C1, CZ), P0[6], P0[7], P0[8], P0[9],     pw0[2] = PKW(P0, 4),  pw0[3] = PKW(P0, 6),  pw0); \
    VRD(1, 1); SBAR(); GAPA(C0 = MFMA32(kf[2], qr[1], C0), P0[10], P0[11], P0[12], P0[13], pw1[0] = PKW(P0, 8),  pw1[1] = PKW(P0, 10), pw1); \
    VRD(5, 1); SBAR(); GAPA(C1 = MFMA32(kf[3], qr[1], C1), P0[14], P0[15], P1[0], P1[1],   pw1[2] = PKW(P0, 12), pw1[3] = PKW(P0, 14), pw1); \
    VRD(2, 2); SBAR(); GAPA(C0 = MFMA32(kf[4], qr[2], C0), P1[2], P1[3], P1[4], P1[5],     pw2[0] = PKW(P1, 0),  pw2[1] = PKW(P1, 2),  pw2); \
    VRD(6, 2); SBAR(); GAPA(C1 = MFMA32(kf[5], qr[2], C1), P1[6], P1[7], P1[8], P1[9],     pw2[2] = PKW(P1, 4),  pw2[3] = PKW(P1, 6),  pw2); \
    VRD(3, 3); SBAR(); GAPA(C0 = MFMA32(kf[6], qr[3], C0), P1[10], P1[11], P1[12], P1[13], pw3[0] = PKW(P1, 8),  pw3[1] = PKW(P1, 10), pw3); \
    VRD(7, 3); SBAR(); GAPA(C1 = MFMA32(kf[7], qr[3], C1), P1[14], P1[15], 0.f, 0.f,       pw3[2] = PKW(P1, 12), pw3[3] = PKW(P1, 14), pw3); \
    l_reg += sacc; } while (0)
#define STEP_WW(C0, C1, P0, P1, t, KR, VR) do { SBAR(); const LAS char* vp_ = vp0 + sl_prev; const int cad = CADDR((t) + 1); \
    PHASEA_PW(C0, C1, P0, P1, false); STAGE(t, KR, VR); float nmh; DECIDE_W(C0, C1); SBAR(); \
                               GAPB(o0 = MFMA32(VFR(0), PAF(0), o0), C0, 0);  CLDA(P0, 0); CLDA(P0, 1); SBAR(); \
                               GAPB(o1 = MFMA32(VFR(4), PAF(0), o1), C0, 4);  CLDA(P0, 2); CLDA(P0, 3); SBAR(); \
    KLD2(sl_next, 0); SBAR();  GAPB(o0 = MFMA32(VFR(1), PAF(1), o0), C0, 8);  CLDA(P0, 4); CLDA(P0, 5); SBAR(); \
    KLD2(sl_next, 1); SBAR();  GAPB(o1 = MFMA32(VFR(5), PAF(1), o1), C0, 12); CLDA(P0, 6); CLDA(P0, 7); SBAR(); \
    KLD2(sl_next, 2); SBAR();  GAPB(o0 = MFMA32(VFR(2), PAF(2), o0), C1, 0);  CLDB(P1, 0); CLDB(P1, 1); SBAR(); \
    KLD2(sl_next, 3); SBAR();  GAPM(o1 = MFMA32(VFR(6), PAF(2), o1)); } while (0)
#define STEP_DW(C0, C1, P0, P1, t, KR, VR) do { SBAR(); const LAS char* vp_ = vp0 + sl_prev; \
    PHASEA_PW(C0, C1, P0, P1, true); STAGE(t, KR, VR); float nmh; DECIDE_D(C0, C1); SBAR(); \
                               GAPB(o0 = MFMA32(VFR(0), PAF(0), o0), C0, 0); \
                               GAPB(o1 = MFMA32(VFR(4), PAF(0), o1), C0, 4); \
    KLD2(sl_next, 0); SBAR();  GAPB(o0 = MFMA32(VFR(1), PAF(1), o0), C0, 8); \
    KLD2(sl_next, 1); SBAR();  GAPB(o1 = MFMA32(VFR(5), PAF(1), o1), C0, 12); \
    KLD2(sl_next, 2); SBAR();  GAPB(o0 = MFMA32(VFR(2), PAF(2), o0), C1, 0); \
    KLD2(sl_next, 3); SBAR();  GAPB(o1 = MFMA32(VFR(6), PAF(2), o1), C1, 4); \
                               EXG(C1, 8); EXG(C1, 12); } while (0)
#define STEP_DD(C0, C1, P0, P1, t, KR, VR) do { SBAR(); const LAS char* vp_ = vp0 + sl_prev; \
    PHASEA_PD(C0, C1, P0, P1, true); STAGE(t, KR, VR); float nmh; DECIDE_D(C0, C1); SBAR(); \
                               GAPB(o0 = MFMA32(VFR(0), PAF(0), o0), C0, 0); \
                               GAPB(o1 = MFMA32(VFR(4), PAF(0), o1), C0, 4); \
    KLD2(sl_next, 0); SBAR();  GAPB(o0 = MFMA32(VFR(1), PAF(1), o0), C0, 8); \
    KLD2(sl_next, 1); SBAR();  GAPB(o1 = MFMA32(VFR(5), PAF(1), o1), C0, 12); \
    KLD2(sl_next, 2); SBAR();  GAPB(o0 = MFMA32(VFR(2), PAF(2), o0), C1, 0); \
    KLD2(sl_next, 3); SBAR();  GAPB(o1 = MFMA32(VFR(6), PAF(2), o1), C1, 4); \
                               GAPB(o0 = MFMA32(VFR(3), PAF(3), o0), C1, 8); \
                               GAPB(o1 = MFMA32(VFR(7), PAF(3), o1), C1, 12); } while (0)
    f32x16 zero16;
#pragma unroll
    for (int i = 0; i < 16; ++i) zero16[i] = 0.f;
    WBAR();
    sl_prev = 2 * AT_SLOTB; sl_cur = 0; sl_next = AT_SLOTB;
    if (!ctx) {
        { const int cad = CADDR(0);
#pragma unroll
          for (int q = 0; q < 8; ++q) CLDA(pA0, q);
          CLDB(pA1, 0); CLDB(pA1, 1); }
#pragma unroll
        for (int j = 0; j < 4; ++j) KLD2(0, j);
#pragma unroll
        for (int j = 0; j < 4; ++j) { pA0 = MFMA32(kf[2 * j], qr[j], pA0); pA1 = MFMA32(kf[2 * j + 1], qr[j], pA1); }
        STAGE(0, kreg, vreg);
        { float nmh; DECIDE_W(pA0, pA1);
#pragma unroll
          for (int r_ = 0; r_ < 16; ++r_) pA0[r_] = EX(pA0[r_]);
#pragma unroll
          for (int r_ = 0; r_ < 4; ++r_) pA1[r_] = EX(pA1[r_]); }
        { const int cad = CADDR(1);
#pragma unroll
          for (int q = 0; q < 8; ++q) CLDA(pB0, q);
          CLDB(pB1, 0); CLDB(pB1, 1); }
#pragma unroll
        for (int j = 0; j < 4; ++j) KLD2(AT_SLOTB, j);
        WBAR(); ROT();
#pragma unroll 1
        for (int t = 1; t < NWP; t += 2) {
            STEP_WW(pB0, pB1, pA0, pA1, t, kreg2, vreg2);     WBAR(); RESC(); ROT();
            STEP_WW(pA0, pA1, pB0, pB1, t + 1, kreg, vreg); WBAR(); RESC(); ROT();
        }
        STEP_DW(pB0, pB1, pA0, pA1, NWP, kreg2, vreg2); WBAR(); RESC(); ROT();
    } else {
#pragma unroll
        for (int j = 0; j < 4; ++j) KLD2(0, j);
        pB0 = MFMA32(kf[0], qr[0], zero16); pB1 = MFMA32(kf[1], qr[0], zero16);
#pragma unroll
        for (int j = 1; j < 4; ++j) { pB0 = MFMA32(kf[2 * j], qr[j], pB0); pB1 = MFMA32(kf[2 * j + 1], qr[j], pB1); }
        STAGE(0, kreg, vreg);
        { float nmh; DECIDE_D(pB0, pB1);
#pragma unroll
          for (int r_ = 0; r_ < 16; ++r_) { pB0[r_] = EX(pB0[r_]); pB1[r_] = EX(pB1[r_]); } }
#pragma unroll
        for (int j = 0; j < 4; ++j) KLD2(AT_SLOTB, j);
        WBAR(); ROT();
    }
    if (ctx) {
      STEP_DD(pA0, pA1, pB0, pB1, 1, kreg2, vreg2); WBAR(); RESC(); ROT();
      STEP_DD(pB0, pB1, pA0, pA1, 2, kreg, vreg);   WBAR(); RESC(); ROT();
      STEP_DD(pA0, pA1, pB0, pB1, 3, kreg2, vreg2); WBAR(); RESC(); ROT();
    } else {
      STEP_DD(pA0, pA1, pB0, pB1, NWP + 1, kreg, vreg);   WBAR(); RESC(); ROT();
      STEP_DD(pB0, pB1, pA0, pA1, NWP + 2, kreg2, vreg2); WBAR(); RESC(); ROT();
      STEP_DD(pA0, pA1, pB0, pB1, NWP + 3, kreg, vreg);   WBAR(); RESC(); ROT(); }
#define DRAIN(P0, P1) do { float sacc = P0[0] + P0[1]; \
      _Pragma("unroll") for (int r_ = 2; r_ < 16; ++r_) sacc += P0[r_]; \
      _Pragma("unroll") for (int r_ = 0; r_ < 16; ++r_) sacc += P1[r_]; \
      l_reg += sacc; \
      pw0 = (u32x4){PKW(P0, 0), PKW(P0, 2), PKW(P0, 4), PKW(P0, 6)}; pw1 = (u32x4){PKW(P0, 8), PKW(P0, 10), PKW(P0, 12), PKW(P0, 14)}; \
      pw2 = (u32x4){PKW(P1, 0), PKW(P1, 2), PKW(P1, 4), PKW(P1, 6)}; pw3 = (u32x4){PKW(P1, 8), PKW(P1, 10), PKW(P1, 12), PKW(P1, 14)}; \
      PIN(pw0); PIN(pw1); PIN(pw2); PIN(pw3); SBAR(); \
      _Pragma("unroll") for (int i_ = 0; i_ < 4; ++i_) zr[i_] = *(const u32x4*)(zp + (size_t)i_ * 8 * 512); \
      asm volatile("" ::: "memory"); if (next_ctx >= 0) attn_prefetch(F, layer, next_ctx, true, P); asm volatile("" ::: "memory");     \
      const LAS char* vp_ = vp0 + sl_prev; VRD(0, 0); VRD(4, 0); VRD(1, 1); VRD(5, 1); VRD(2, 2); VRD(6, 2); VRD(3, 3); VRD(7, 3); \
      o0 = MFMA32(VFR(0), PAF(0), o0); o1 = MFMA32(VFR(4), PAF(0), o1); o0 = MFMA32(VFR(1), PAF(1), o0); o1 = MFMA32(VFR(5), PAF(1), o1); \
      o0 = MFMA32(VFR(2), PAF(2), o0); o1 = MFMA32(VFR(6), PAF(2), o1); o0 = MFMA32(VFR(3), PAF(3), o0); o1 = MFMA32(VFR(7), PAF(3), o1); } while (0)
    int le = lane; asm volatile("" : "+v"(le));
    unsigned char* wse = kws();
    const bf16_t* zp = (const bf16_t*)(wse + WS_SZA) + (size_t)(R0 + (le >> 3)) * 512 + h * 64 + (le & 7) * 8;
    u32x4 zr[4];
    DRAIN(pA0, pA1);
#undef DRAIN
#undef STEP_DD
#undef STEP_DW
#undef STEP_WW
#undef PHASEA_PD
#undef PHASEA_PW
#undef QK0
#undef QK1
#undef STAGE
#undef EXG
#undef GAPB
#undef GAPM
#undef GAPA
#undef VRD
#undef VFR
#undef PAF
#undef PKW
#undef EX
#undef RESC
#undef DECIDE_W
#undef DECIDE_D
#undef DEC_TAIL
#undef CLDA
#undef CLDB
#undef CADDR
#undef KLD2
#undef MX3
#undef ROT
#undef VT
    { auto rr = __builtin_amdgcn_permlane32_swap(__float_as_uint(l_reg), __float_as_uint(l_reg), false, false); l_reg = __uint_as_float(rr[0]) + __uint_as_float(rr[1]); }
    const float inv = 1.0f / l_reg;
    { LAS char* stg = L + AT_TBL + wid * 4608; LAS char* srow = stg + (le >> 3) * 144 + (le & 7) * 16; LAS char* sfrag = stg + (le & 31) * 144 + (le >> 5) * 8;
#pragma unroll
      for (int i = 0; i < 4; ++i) *(LAS u32x4*)(srow + i * 8 * 144) = zr[i];
      asm volatile("s_waitcnt lgkmcnt(0)" ::: "memory");
      u32x2 zg0[4], zg1[4];
#pragma unroll
      for (int g = 0; g < 4; ++g) { zg0[g] = *(const LAS u32x2*)(sfrag + 16 * g); zg1[g] = *(const LAS u32x2*)(sfrag + 64 + 16 * g); }
      asm volatile("s_waitcnt lgkmcnt(0)" ::: "memory");
#pragma unroll
      for (int g = 0; g < 4; ++g) {
          const u32x2 z0 = zg0[g], z1 = zg1[g];
          u32x2 w0, w1;
          w0.x = cvtpk_s(o0[4 * g + 0] * inv * bflo(z0.x), o0[4 * g + 1] * inv * bfhi(z0.x)); w0.y = cvtpk_s(o0[4 * g + 2] * inv * bflo(z0.y), o0[4 * g + 3] * inv * bfhi(z0.y));
          w1.x = cvtpk_s(o1[4 * g + 0] * inv * bflo(z1.x), o1[4 * g + 1] * inv * bfhi(z1.x)); w1.y = cvtpk_s(o1[4 * g + 2] * inv * bflo(z1.y), o1[4 * g + 3] * inv * bfhi(z1.y));
          *(LAS u32x2*)(sfrag + 16 * g) = w0; *(LAS u32x2*)(sfrag + 64 + 16 * g) = w1; }
      asm volatile("s_waitcnt lgkmcnt(0)" ::: "memory");
      bf16_t* yp = (bf16_t*)(wse + WS_YAB) + (size_t)(R0 + (le >> 3)) * 1024 + h * 64 + (le & 7) * 8;
#pragma unroll
      for (int i = 0; i < 4; ++i) { const u32x4 v = *(const LAS u32x4*)(srow + i * 8 * 144); *(u32x4*)(yp + (size_t)i * 8 * 1024) = v; } }
    WBAR();
#undef WBAR
#undef PIN
#undef SBAR
}
#undef ATT_SRC
#undef ATT_DECODE

__device__ __forceinline__ void mix_phase(Frame& F, int layer) {
    AttnPre P;
    const int t_ctx = 255 - F.bx;
    for (int t = F.bx; t < M / 32; t += 256) conv_task(F, layer, t, P, t + 256 >= M / 32 ? F.bx : -1);
    attn_wg(F, layer, F.bx, false, P, t_ctx < 128 ? t_ctx : -1);
    if (t_ctx < 128) attn_wg(F, layer, t_ctx, true, P, -1);
}

__device__ __forceinline__ void cvec_phase(Frame& F) {
    const int gw = F.bx * 8 + F.wave, NGW = F.G * 8;
    const float* md = WSP(float, WS_MOD) + 5 * 3072;
    f32x4 sh[5][4];
#pragma unroll
    for (int g = 0; g < 5; ++g)
#pragma unroll
        for (int i = 0; i < 4; ++i) sh[g][i] = *(const f32x4*)(md + g * 3072 + 16 * F.lane + 4 * i);
    const bf16_t* W = WSP(bf16_t, WS_WTIN) + (size_t)DIN * D; const float* bp = WSP(float, WS_BIASP) + DIN; float* cv = WSP(float, WS_CVEC);
    for (int n = gw; n < DIN; n += NGW) {
        const u32x4 wa = *(const u32x4*)(W + (size_t)n * D + 16 * F.lane), wb = *(const u32x4*)(W + (size_t)n * D + 16 * F.lane + 8);
        const f32x4 w0 = {bflo(wa.x), bfhi(wa.x), bflo(wa.y), bfhi(wa.y)}, w1 = {bflo(wa.z), bfhi(wa.z), bflo(wa.w), bfhi(wa.w)};
        const f32x4 w2 = {bflo(wb.x), bfhi(wb.x), bflo(wb.y), bfhi(wb.y)}, w3 = {bflo(wb.z), bfhi(wb.z), bflo(wb.w), bfhi(wb.w)};
        const float bias = bp[n];
#pragma unroll
        for (int g = 0; g < 5; ++g) { const f32x4 p = sh[g][0] * w0 + sh[g][1] * w1 + sh[g][2] * w2 + sh[g][3] * w3;
            const float sm = wave_sum((p[0] + p[1]) + (p[2] + p[3])); if (F.lane == 0) cv[g * DIN + n] = sm + bias; }
    }
}

struct Args { const float* in[20]; float* out; unsigned char* ws; int ph_lo, ph_hi; };

__global__ void __launch_bounds__(512, 2) mk_fwd(Args args) {
    extern __shared__ __attribute__((aligned(16))) unsigned char lds_raw[];
    Frame F;
    F.lds = (LAS unsigned char*)lds_raw;
    F.tid = threadIdx.x; F.lane = F.tid & 63; F.wave = __builtin_amdgcn_readfirstlane(F.tid >> 6); F.G = gridDim.x; F.bx = blockIdx.x;
    for (int u = F.tid; u < (LDS_BYTES - LDSCTL_OFF) / 4; u += 512) ((LAS unsigned*)(F.lds + LDSCTL_OFF))[u] = 0u;
    __syncthreads();
    XcdBarrier bar; bar.bar = WSP(unsigned, WS_CTL) + CW_BAR; bar.x = 0; bar.st = nullptr;
#define lo (kint(176))
#define hi (kint(180))
    if (hi - lo > 1) bar = xcd_barrier_post(WSP(unsigned, WS_CTL) + CW_BAR, (volatile LAS unsigned*)(F.lds + MISC_OFF) + 8);
#ifndef PH_MASK
#define PH_MASK 0x7f
#endif
#define PHK(kind) ((PH_MASK >> (kind)) & 1)
#define IN(k) (lo <= (k) && (k) < hi)
#define SEAM(k) do { if (IN(k) && IN((k) + 1)) { XcdBarrier bb_; bb_.bar = WSP(unsigned, WS_CTL) + CW_BAR; bb_.x = xb_xcc_id(); bb_.st = (volatile LAS unsigned*)((LAS unsigned char*)lds_raw + MISC_OFF) + 8; xcd_barrier(bb_); } } while (0)
#define FRESH() do { F.tid = fresh_tid(); F.lane = F.tid & 63; F.wave = __builtin_amdgcn_readfirstlane(F.tid >> 6); } while (0)

    if (PHK(0) && IN(0)) { FRESH(); p0_prologue(F); SEAM(0); }
    for (int layer = 0; layer < DEPTH; ++layer) {
        const int pb = 1 + 5 * layer;
        if (PHK(1) && IN(pb) && layer == 0) { FRESH();
            if (layer == 0 && F.bx == F.G - 1) { const float* rg = kin(I_RMS_G) + D; const float* md = WSP(float, WS_MOD) + 5 * 3072; float* gm = WSP(float, WS_GM);
                for (int i = F.tid; i < 5 * 1024; i += 512) { const int g = i >> 10, c = i & 1023; gm[i] = rg[c] * (1.0f + md[g * 3072 + 1024 + c]); } }
            norm_phase(F, layer); SEAM(pb); }
        if (PHK(2) && IN(pb + 1)) {
            constexpr int M1 = 46 * 256;
            const bf16_t* Ain = layer == 0 ? WSP(bf16_t, WS_H) : WSP(bf16_t, WS_YAB);
            { pg8::Gemm g{Ain + (size_t)M1 * D, WSP(bf16_t, WS_WTIN) + (size_t)layer * DIN * D, M - M1, DIN, D, D}; pg8::StaticOrder S; S.init(M - M1, DIN, F.G, F.G - 1 - F.bx, 0, 128);
              if (layer == 0) { EpiInT<2> E{layer, M1}; pg8::gemm_phase<EpiInT<2>>(F.lds, g, S, E); } else { EpiInT<2, true> E{layer, M1}; pg8::gemm_phase<EpiInT<2, true>>(F.lds, g, S, E); } }
            const int nidle = F.G - (M - M1) / 128 * (DIN / 256);
            const bool slack = (int)blockIdx.x < nidle, early = slack && ((blockIdx.x >> 3) & 1) == 0;
            if (early) { if (layer == 0) { FRESH(); __syncthreads(); wt_items(F, 1, F.bx * 8 + F.wave, nidle * 8); __syncthreads(); } else { __builtin_amdgcn_s_sleep(100); __builtin_amdgcn_s_sleep(100); } }
            { pg8::Gemm g{Ain, WSP(bf16_t, WS_WTIN) + (size_t)layer * DIN * D, M1, DIN, D, D}; pg8::StaticOrder S; S.init(M1, DIN, F.G, F.bx);
              if (layer == 0) { EpiInT<4> E{layer, 0}; pg8::gemm_phase<EpiInT<4>>(F.lds, g, S, E); } else { EpiInT<4, true> E{layer, 0}; pg8::gemm_phase<EpiInT<4, true>>(F.lds, g, S, E); } }
            if (layer == 0 && slack && !early) { FRESH(); __syncthreads(); wt_items(F, 1, F.bx * 8 + F.wave, nidle * 8); }
            SEAM(pb + 1);
        }
        if (PHK(3) && IN(pb + 2)) { FRESH(); mix_phase(F, layer); SEAM(pb + 2); }
        if (PHK(4) && IN(pb + 3)) {
            if (layer == 0) { FRESH(); cvec_phase(F); }
            pg8::Gemm g{WSP(bf16_t, WS_YAB), WSP(bf16_t, WS_WTPROJ) + (size_t)layer * D * D, M, D, D, D}; pg8::StaticOrder S; S.init(M, D, F.G, F.bx, 0, 192);
            EpiProj E{};
            pg8::gemm_phase<EpiProj>(F.lds, g, S, E);
            SEAM(pb + 3);
        }
        if (PHK(5) && IN(pb + 4)) {
            pg8::Gemm g{WSP(bf16_t, WS_H), WSP(bf16_t, WS_WTOUT) + (size_t)layer * D * D, M, D, D, D}; pg8::StaticOrder S; S.init(M, D, F.G, F.bx, 0, 192);
            if (layer + 1 < DEPTH) { EpiOutT<false> E{layer}; pg8::gemm_phase<EpiOutT<false>>(F.lds, g, S, E); }
            else { EpiOutT<true> E{layer}; pg8::gemm_phase<EpiOutT<true>>(F.lds, g, S, E); }
            if (layer + 1 < DEPTH) SEAM(pb + 4);
        }
    }
#undef IN
#undef SEAM
#undef lo
#undef hi
}

extern "C" void kernel_launch(void* const* d_in, const int* in_sizes, int n_in, void* d_out, int out_size, void* d_ws, size_t ws_size, hipStream_t stream) {
    static int grid = 0;
    if (grid == 0) {
        if (n_in != 20 || ws_size < WS_END) { fprintf(stderr, "kernel_launch: unexpected inputs (n_in %d, ws %zu)\n", n_in, ws_size); grid = -1; return; }
        int dev = 0, cus = 0, per_cu = 0;
        if (hipGetDevice(&dev) != hipSuccess || hipDeviceGetAttribute(&cus, hipDeviceAttributeMultiprocessorCount, dev) != hipSuccess) { grid = -1; return; }
        if (hipFuncSetAttribute((const void*)mk_fwd, hipFuncAttributeMaxDynamicSharedMemorySize, LDS_BYTES) != hipSuccess) { fprintf(stderr, "kernel_launch: hipFuncSetAttribute failed\n"); grid = -1; return; }
        if (hipOccupancyMaxActiveBlocksPerMultiprocessor(&per_cu, (const void*)mk_fwd, 512, LDS_BYTES) != hipSuccess || per_cu < 1) { fprintf(stderr, "kernel_launch: occupancy query says %d\n", per_cu); per_cu = 1; }
        (void)hipGetLastError();
        if (cus < 256) { fprintf(stderr, "kernel_launch: %d CUs; the mixer's work split is written for a grid of 256 workgroups\n", cus); grid = -1; return; }
        grid = 256;
    }
    if (grid < 0) return;
    (void)hipMemsetAsync((char*)d_ws + WS_CTL, 0, CTL_ZERO_BYTES, stream);
    Args a{};
    for (int i = 0; i < 20; ++i) a.in[i] = (const float*)d_in[i];
    a.out = (float*)d_out; a.ws = (unsigned char*)d_ws;
    if (MK_N_LAUNCHES == 1) { a.ph_lo = 0; a.ph_hi = NPHASE; hipLaunchKernelGGL(mk_fwd, dim3(grid), dim3(512), LDS_BYTES, stream, a); }
    else for (int p = 0; p < NPHASE; ++p) { a.ph_lo = p; a.ph_hi = p + 1; hipLaunchKernelGGL(mk_fwd, dim3(grid), dim3(512), LDS_BYTES, stream, a); }
}
```

```cpp
#include <hip/hip_runtime.h>
#include <cstdio>
#include <cstdint>

#ifndef MK_N_LAUNCHES
#define MK_N_LAUNCHES 1
#endif

#define GAS __attribute__((address_space(1)))
#define LAS __attribute__((address_space(3)))
typedef unsigned short bf16_t;
typedef short bf16x8 __attribute__((ext_vector_type(8)));
typedef float f32x4 __attribute__((ext_vector_type(4)));
typedef float f32x2 __attribute__((ext_vector_type(2)));
typedef unsigned u32x4 __attribute__((ext_vector_type(4)));
typedef unsigned u32x2 __attribute__((ext_vector_type(2)));
typedef GAS unsigned gu32;
#define RLX_AGENT __ATOMIC_RELAXED, __HIP_MEMORY_SCOPE_AGENT
#define LDS_WAIT() asm volatile("s_waitcnt lgkmcnt(0)" ::: "memory")
#define VM_WAIT() asm volatile("s_waitcnt vmcnt(0)" ::: "memory")

constexpr int D = 1024, NCTX = 4096, NLAT = 8192, M = NCTX + NLAT, DIN = 5632, DEPTH = 2, NH = 8, HD = 64;
constexpr int NPHASE = 12;
constexpr float EPS = 1e-6f;

constexpr size_t MiB = 1u << 20;
constexpr size_t WS_CTL = 0, CTL_ZERO_BYTES = 192 * 1024;
constexpr size_t WS_RSS2 = 128 * 1024;
constexpr size_t WS_RSS = 64 * 1024;
constexpr size_t WS_GM = 1 * MiB + 192 * 1024;
constexpr size_t WS_CVEC = 1 * MiB + 256 * 1024;
constexpr size_t WS_MOD = 1 * MiB;
constexpr size_t WS_BIASP = 1 * MiB + 128 * 1024;
constexpr size_t WS_WTIN = 2 * MiB;
constexpr size_t WS_WTPROJ = 24 * MiB;
constexpr size_t WS_WTOUT = 28 * MiB;
constexpr size_t WS_CK = 32 * MiB, WS_CV = 34 * MiB;
constexpr size_t WS_H = 36 * MiB;
constexpr size_t WS_Q = 60 * MiB, WS_K = 72 * MiB, WS_V = 84 * MiB, WS_SZA = 96 * MiB, WS_U = 108 * MiB, WS_SZB = 120 * MiB;
constexpr size_t WS_GR = 132 * MiB, WS_GB = 156 * MiB;
constexpr size_t WS_YAB = 180 * MiB;
constexpr size_t WS_X1 = 204 * MiB;
constexpr size_t WS_END = 228 * MiB;
constexpr int CW_BAR = 4096;
constexpr int CW_ROWBLK = 8192;

constexpr int RING_BYTES = 131072;
constexpr int LDSCTL_OFF = RING_BYTES, MISC_OFF = LDSCTL_OFF + 320;
constexpr int LDS_BYTES = 147456;

__device__ __forceinline__ unsigned f2bf(float f) { unsigned u = __builtin_bit_cast(unsigned, f); return (u + 0x7fffu + ((u >> 16) & 1u)) >> 16; }
__device__ __forceinline__ unsigned pk2(float lo, float hi) { return f2bf(lo) | (f2bf(hi) << 16); }
typedef __bf16 bf16x2_cv __attribute__((ext_vector_type(2)));
__device__ __forceinline__ unsigned cvt_pk_bf16(float lo, float hi) { f32x2 v = {lo, hi}; bf16x2_cv b = __builtin_convertvector(v, bf16x2_cv); return __builtin_bit_cast(unsigned, b); }
__device__ __forceinline__ float bflo(unsigned w) { return __builtin_bit_cast(float, w << 16); }
__device__ __forceinline__ float bfhi(unsigned w) { return __builtin_bit_cast(float, w & 0xffff0000u); }
__device__ __forceinline__ float sigmoid_f(float x) { return __builtin_amdgcn_rcpf(1.0f + __expf(-x)); }
__device__ __forceinline__ float silu_f(float x) { return x * sigmoid_f(x); }
__device__ __forceinline__ float dpp_f(float v, float o) { return v + o; }
__device__ __forceinline__ float wave_sum(float v) {
#define DPP_ADD(ctrl, rm, bc) v += __builtin_bit_cast(float, __builtin_amdgcn_update_dpp(0, __builtin_bit_cast(int, v), ctrl, rm, 0xf, bc))
    DPP_ADD(0x111, 0xf, true); DPP_ADD(0x112, 0xf, true); DPP_ADD(0x114, 0xf, true); DPP_ADD(0x118, 0xf, true);
    DPP_ADD(0x142, 0xa, false); DPP_ADD(0x143, 0xc, false);
#undef DPP_ADD
    return __builtin_bit_cast(float, __builtin_amdgcn_readlane(__builtin_bit_cast(int, v), 63));
}

__device__ __forceinline__ int fresh_tid() { int t = threadIdx.x; asm volatile("" : "+v"(t)); return t; }

namespace pg8 {
constexpr int BM = 256, BK = 64, HALF = 128, HTB = HALF * BK * 2, STAGE_BYTES = 8 * HTB, NXCD = 8, WGM = 8;
__host__ __device__ __forceinline__ int lds_byte(int r, int c) { const int st = (r >> 4) * 2 + (c >> 5), rr = r & 15, cc = c & 31, ob = rr * 64 + cc * 2; return st * 1024 + (ob ^ (((ob >> 9) & 1) << 5)); }
__host__ __device__ __forceinline__ void stage_rc(int b, int& R, int& C) { const int st = b / 1024, sb = b % 1024, swz = sb ^ (((sb >> 9) & 1) << 5); R = (st >> 1) * 16 + swz / 64; C = (st & 1) * 32 + (swz % 64) / 2; }
__host__ __device__ __forceinline__ int perm32(int rho) { const int n = rho >> 4, i = rho & 15; return 8 * (i >> 2) + 4 * n + (i & 3); }

struct Unit { int pm, pn, kh; };
struct Gemm { const bf16_t* A; const bf16_t* Bt; int M, N, K, ld; };

struct StaticOrder {
    int nM, nN, nwg, G, c;
    __host__ __device__ void init(int M_, int N_, int G_, int c_, int split_ = 0, int bm_ = BM) { nM = M_ / bm_; nN = N_ / BM; nwg = nM * nN; G = G_; c = c_; split = split_; }
    int split;
    __host__ __device__ bool next(int i0, Unit& u) const {
        const int i = split ? (i0 >> 1) : i0; u.kh = split ? (i0 & 1) : 0;
        const long L = (long)i * G + c; if (L >= nwg) return false;
        int wgid = (int)L; { const int q = nwg / NXCD, r = nwg % NXCD, xcd = wgid % NXCD, off = wgid / NXCD; wgid = (xcd < r ? xcd * (q + 1) : r * (q + 1) + (xcd - r) * q) + off; }
        const int nig = WGM * nN, gid = wgid / nig, fm = gid * WGM, gsz = (nM - fm) < WGM ? (nM - fm) : WGM;
        u.pm = fm + ((wgid % nig) % gsz); u.pn = (wgid % nig) / gsz; return true;
    }
};

template <class Epi, bool ALIGN_EPI = true, bool SP2 = true>
__device__ __forceinline__ void gemm_phase(LAS unsigned char* lds, const Gemm g, const StaticOrder& S, const Epi& E) {
    const int tid = fresh_tid(), wid = __builtin_amdgcn_readfirstlane(tid >> 6), lane = tid & 63, wr = wid >> 2, wc = wid & 3, fr = lane & 15, fq = lane >> 4;
    static_assert(SP2 || Epi::MB == 4, "tiles lower than 256 rows use the SP2 loop");
    constexpr int MB = Epi::MB, HROWS = 32 * MB;
    const int K = g.ld, nt = g.K / BK;
    const size_t khstep = (size_t)g.K * 2;
    unsigned voffA[2], voffB[2];
#pragma unroll
    for (int i = 0; i < 2; ++i) { int R, C; stage_rc(tid * 16 + i * 8192, R, C); const int Rb = Epi::PERM ? ((R & ~31) + perm32(R & 31)) : R;
        voffA[i] = (unsigned)(R * K + C) * 2u; voffB[i] = (unsigned)(Rb * K + C) * 2u; }
    const size_t kstep = (size_t)(BK * 2);
    const size_t hstep = (size_t)HROWS * K * 2;
    const size_t hstepB = (size_t)HALF * K * 2;
    const size_t tstep = 2 * hstep, tstepB = 2 * hstepB;
    const unsigned ldsw = (unsigned)wid * 1024u;
    const int aoff = lds_byte(wr * (16 * MB) + fr, fq * 8), boff = lds_byte(wc * 32 + fr, fq * 8);
#define PG8_SA(b, h) (((b) * 2 + (h)) * HTB)
#define PG8_SB(b, h) ((4 + (b) * 2 + (h)) * HTB)
#define PG8_STAGE(bufoff, gbase, voff) do { _Pragma("unroll") for (int _i = 0; _i < 2; ++_i) \
        __builtin_amdgcn_global_load_lds((const unsigned*)((const char*)(gbase) + (voff)[_i]), (LAS unsigned*)(lds + (bufoff) + ldsw + _i * 8192), 16, 0, 0); } while (0)
#define PG8_LDA(dst, b, h) do { _Pragma("unroll") for (int m = 0; m < MB; ++m) _Pragma("unroll") for (int k = 0; k < 2; ++k) dst[m][k] = *(const LAS bf16x8*)(lds + PG8_SA(b, h) + aoff + m * 2048 + k * 1024); } while (0)
#define PG8_LDB(dst, b, h) do { _Pragma("unroll") for (int n = 0; n < 2; ++n) _Pragma("unroll") for (int k = 0; k < 2; ++k) dst[n][k] = *(const LAS bf16x8*)(lds + PG8_SB(b, h) + boff + n * 2048 + k * 1024); } while (0)
#define PG8_MMA(ai, bj, At, Bt) do { __builtin_amdgcn_s_setprio(1); _Pragma("unroll") for (int m = 0; m < MB; ++m) _Pragma("unroll") for (int n = 0; n < 2; ++n) _Pragma("unroll") for (int k = 0; k < 2; ++k) \
        acc[ai][bj][m][n] = __builtin_amdgcn_mfma_f32_16x16x32_bf16(Bt[n][k], At[m][k], acc[ai][bj][m][n], 0, 0, 0); __builtin_amdgcn_s_setprio(0); } while (0)
#define PG8_WAIT_V(n) asm volatile("s_waitcnt vmcnt(" #n ")" ::: "memory")
    const int aIss = (MB == 4) ? 2 : (MB == 3) ? (wid < 4 ? 2 : 1) : (MB == 2) ? 1 : (wid < 4 ? 1 : 0);
#define PG8_STAGE_A(bufoff, gbase, voff) do { _Pragma("unroll") for (int _i = 0; _i < 2; ++_i) if (MB == 4 || _i < aIss) \
        __builtin_amdgcn_global_load_lds((const unsigned*)((const char*)(gbase) + (voff)[_i]), (LAS unsigned*)(lds + (bufoff) + ldsw + _i * 8192), 16, 0, 0); } while (0)
#define PG8_WAIT_VN(n) do { switch (n) { case 0: PG8_WAIT_V(0); break; case 1: PG8_WAIT_V(1); break; case 2: PG8_WAIT_V(2); break; case 4: PG8_WAIT_V(4); break; case 5: PG8_WAIT_V(5); break; \
        case 6: PG8_WAIT_V(6); break; default: PG8_WAIT_V(8); break; } } while (0)
#define PG8_WAIT_LOOP() do { if constexpr (MB == 4) PG8_WAIT_V(8); else PG8_WAIT_VN(4 + 2 * aIss); } while (0)
#define PG8_WAIT_P1() do { if constexpr (MB == 4) PG8_WAIT_V(2); else PG8_WAIT_VN(aIss); } while (0)
#define PG8_WAIT_P2() do { if constexpr (MB == 4) PG8_WAIT_V(6); else PG8_WAIT_VN(4 + aIss); } while (0)
#define PG8_WAIT_L(n) asm volatile("s_waitcnt lgkmcnt(" #n ")" ::: "memory")
#define PG8_BAR __builtin_amdgcn_s_barrier()
#define PG8_SCHED __builtin_amdgcn_sched_barrier(0)
    Unit cur, nxt; int ui = 0;
    if (!S.next(0, cur)) return;
    f32x4 acc[2][2][MB][2];
#pragma unroll
    for (int a = 0; a < 2; ++a)
#pragma unroll
        for (int b = 0; b < 2; ++b)
#pragma unroll
            for (int m = 0; m < MB; ++m)
#pragma unroll
                for (int n = 0; n < 2; ++n) acc[a][b][m][n] = (f32x4){0.f, 0.f, 0.f, 0.f};
    bf16x8 At[MB][2], B0[2][2], B1[2][2];
    const char* cA = (const char*)g.A + (size_t)cur.pm * tstep + cur.kh * khstep; const char* cB = (const char*)g.Bt + (size_t)cur.pn * tstepB + cur.kh * khstep;
    const int ntm = nt - 1; const int xrot = (int)(blockIdx.x & 3u) * (nt >> 2);
    auto krot = [&](const Unit& u_) -> int { return Epi::KROT == 1 ? (u_.pm & 3) * (nt >> 2) : Epi::KROT == 2 ? xrot : Epi::KROT == 3 ? (u_.pm & 3) * (nt >> 3) : 0; };
    auto kidx = [&](int t_, int r_) -> int { return Epi::KROT == 3 ? ((t_ & (nt >> 1)) | ((t_ + r_) & ((nt >> 1) - 1))) : ((t_ + r_) & ntm); };
    int rot = krot(cur);
    if constexpr (SP2) {
        const char* pA = cA + (size_t)kidx(0, rot) * kstep; const char* pB = cB + (size_t)kidx(0, rot) * kstep;
        PG8_STAGE(PG8_SB(0, 0), pB, voffB); PG8_STAGE(PG8_SB(0, 1), pB + hstepB, voffB); PG8_STAGE_A(PG8_SA(0, 0), pA, voffA); PG8_STAGE_A(PG8_SA(0, 1), pA + hstep, voffA);
        if (wr == 1) PG8_BAR;
        PG8_WAIT_P1(); PG8_BAR;
        PG8_STAGE(PG8_SB(1, 0), pB + kstep, voffB); PG8_STAGE_A(PG8_SA(1, 0), pA + kstep, voffA); PG8_STAGE(PG8_SB(1, 1), pB + hstepB + kstep, voffB);
        PG8_WAIT_P2(); PG8_BAR;
    } else {
        PG8_STAGE(PG8_SB(0, 0), cB, voffB); PG8_STAGE(PG8_SA(0, 0), cA, voffA); PG8_STAGE(PG8_SB(0, 1), cB + hstepB, voffB); PG8_STAGE(PG8_SA(0, 1), cA + hstep, voffA);
        if (wr == 1) PG8_BAR;
        PG8_WAIT_V(4); PG8_BAR;
        PG8_STAGE(PG8_SB(1, 0), cB + kstep, voffB); PG8_STAGE(PG8_SA(1, 0), cA + kstep, voffA); PG8_STAGE(PG8_SB(1, 1), cB + hstepB + kstep, voffB);
        PG8_WAIT_V(6); PG8_BAR;
    }
    for (;;) {
        const bool has_next = S.next(ui + 1, nxt);
        const char* nA = has_next ? (const char*)g.A + (size_t)nxt.pm * tstep + nxt.kh * khstep : cA; const char* nB = has_next ? (const char*)g.Bt + (size_t)nxt.pn * tstepB + nxt.kh * khstep : cB;
        const int nrot = has_next ? krot(nxt) : rot;
        for (int t = 0; t < nt; t += 2) {
            const bool last = (t == nt - 2);
            const char* a1 = cA + (size_t)(kidx(t, rot) + 1) * kstep;
            const char* a2 = last ? nA + (size_t)kidx(0, nrot) * kstep : cA + (size_t)kidx(t + 2, rot) * kstep; const char* b2 = last ? nB + (size_t)kidx(0, nrot) * kstep : cB + (size_t)kidx(t + 2, rot) * kstep;
            const char* a3 = a2 + kstep; const char* b3 = b2 + kstep;
            if constexpr (SP2) {
            PG8_LDB(B0, 0, 0); PG8_LDB(B1, 0, 1); PG8_SCHED; PG8_LDA(At, 0, 0); PG8_STAGE_A(PG8_SA(1, 1), a1 + hstep, voffA);
            PG8_WAIT_LOOP(); PG8_WAIT_L(0); PG8_BAR; PG8_MMA(0, 0, At, B0); PG8_MMA(0, 1, At, B1); PG8_BAR; PG8_SCHED;
            PG8_LDA(At, 0, 1); PG8_STAGE(PG8_SB(0, 0), b2, voffB); PG8_STAGE(PG8_SB(0, 1), b2 + hstepB, voffB); PG8_STAGE_A(PG8_SA(0, 0), a2, voffA);
            PG8_WAIT_LOOP(); PG8_WAIT_L(0); PG8_BAR; PG8_MMA(1, 0, At, B0); PG8_MMA(1, 1, At, B1); PG8_BAR; PG8_SCHED;
            PG8_LDB(B0, 1, 0); PG8_LDB(B1, 1, 1); PG8_SCHED; PG8_LDA(At, 1, 0); PG8_STAGE_A(PG8_SA(0, 1), a2 + hstep, voffA);
            PG8_WAIT_LOOP(); PG8_WAIT_L(0); PG8_BAR; PG8_MMA(0, 0, At, B0); PG8_MMA(0, 1, At, B1); PG8_BAR; PG8_SCHED;
            PG8_LDA(At, 1, 1); PG8_STAGE(PG8_SB(1, 0), b3, voffB); PG8_STAGE(PG8_SB(1, 1), b3 + hstepB, voffB); PG8_STAGE_A(PG8_SA(1, 0), a3, voffA);
            PG8_WAIT_LOOP(); PG8_WAIT_L(0); PG8_BAR; PG8_MMA(1, 0, At, B0); PG8_MMA(1, 1, At, B1); PG8_BAR; PG8_SCHED;
            } else {
            PG8_LDB(B0, 0, 0); PG8_SCHED; PG8_LDA(At, 0, 0); PG8_STAGE(PG8_SA(1, 1), a1 + hstep, voffA);
            PG8_WAIT_L(8); PG8_BAR; PG8_WAIT_L(0); PG8_MMA(0, 0, At, B0); PG8_BAR; PG8_SCHED;
            PG8_LDB(B1, 0, 1); PG8_STAGE(PG8_SB(0, 0), b2, voffB);
            PG8_BAR; PG8_WAIT_L(0); PG8_MMA(0, 1, At, B1); PG8_BAR;
            PG8_LDA(At, 0, 1); PG8_STAGE(PG8_SA(0, 0), a2, voffA);
            PG8_BAR; PG8_WAIT_L(0); PG8_MMA(1, 0, At, B0); PG8_BAR; PG8_SCHED;
            PG8_STAGE(PG8_SB(0, 1), b2 + hstepB, voffB);
            PG8_WAIT_V(6); PG8_BAR; PG8_MMA(1, 1, At, B1); PG8_BAR;
            PG8_LDB(B0, 1, 0); PG8_SCHED; PG8_LDA(At, 1, 0); PG8_STAGE(PG8_SA(0, 1), a2 + hstep, voffA);
            PG8_WAIT_L(8); PG8_BAR; PG8_WAIT_L(0); PG8_MMA(0, 0, At, B0); PG8_BAR; PG8_SCHED;
            PG8_LDB(B1, 1, 1); PG8_STAGE(PG8_SB(1, 0), b3, voffB);
            PG8_BAR; PG8_WAIT_L(0); PG8_MMA(0, 1, At, B1); PG8_BAR;
            PG8_LDA(At, 1, 1); PG8_STAGE(PG8_SA(1, 0), a3, voffA);
            PG8_BAR; PG8_WAIT_L(0); PG8_MMA(1, 0, At, B0); PG8_BAR; PG8_SCHED;
            PG8_STAGE(PG8_SB(1, 1), b3 + hstepB, voffB);
            PG8_WAIT_V(6); PG8_BAR; PG8_MMA(1, 1, At, B1); PG8_BAR;
            }
            if constexpr (Epi::MIDHOOK) { if (t + 2 == nt / 2) { E.mid(acc, cur, wr, wc, fr, fq); PG8_SCHED; } }
        }
        if constexpr (ALIGN_EPI) { if (wr == 0) PG8_BAR; }
        E(acc, cur, wr, wc, fr, fq);
        if (!has_next) break;
        {
#pragma unroll
        for (int a = 0; a < 2; ++a)
#pragma unroll
            for (int b = 0; b < 2; ++b)
#pragma unroll
                for (int m = 0; m < MB; ++m)
#pragma unroll
                    for (int n = 0; n < 2; ++n) acc[a][b][m][n] = (f32x4){0.f, 0.f, 0.f, 0.f};
        }
        cur = nxt; cA = nA; cB = nB; rot = nrot; ++ui;
        if constexpr (ALIGN_EPI) { if (wr == 1) PG8_BAR; }
    }
    PG8_WAIT_V(0);
    if constexpr (!ALIGN_EPI) { if (wr == 0) PG8_BAR; }
    PG8_BAR;
#undef PG8_SA
#undef PG8_SB
#undef PG8_STAGE
#undef PG8_STAGE_A
#undef PG8_WAIT_VN
#undef PG8_WAIT_LOOP
#undef PG8_WAIT_P1
#undef PG8_WAIT_P2
#undef PG8_LDA
#undef PG8_LDB
#undef PG8_MMA
#undef PG8_WAIT_V
#undef PG8_WAIT_L
#undef PG8_BAR
#undef PG8_SCHED
}
}

#define AS4 __attribute__((address_space(4)))
__device__ __forceinline__ const float* kin(int k) { const AS4 char* p = (const AS4 char*)__builtin_amdgcn_kernarg_segment_ptr(); asm volatile("" : "+s"(p)); return *(const float* const AS4*)(p + 8 * k); }
__device__ __forceinline__ float* kout() { const AS4 char* p = (const AS4 char*)__builtin_amdgcn_kernarg_segment_ptr(); asm volatile("" : "+s"(p)); return *(float* const AS4*)(p + 160); }
__device__ __forceinline__ int kint(int off) { const AS4 char* p = (const AS4 char*)__builtin_amdgcn_kernarg_segment_ptr(); asm volatile("" : "+s"(p)); return *(const int AS4*)(p + off); }
__device__ __forceinline__ unsigned char* kws() { const AS4 char* p = (const AS4 char*)__builtin_amdgcn_kernarg_segment_ptr(); asm volatile("" : "+s"(p)); return *(unsigned char* const AS4*)(p + 168); }
#define I_X_PROMPT 0
#define I_X_SAMPLE 1
#define I_CACHE_K 2
#define I_CACHE_V 3
#define I_C 4
#define I_C_CTX 5
#define I_RMS_G 6
#define I_W_ADA 7
#define I_B_ADA 8
#define I_W_IN 9
#define I_B_IN 10
#define I_REL_BIAS 11
#define I_DW_W 12
#define I_DW_B 13
#define I_LN_G 14
#define I_LN_B 15
#define I_W_PROJ_A 16
#define I_W_PROJ_B 17
#define I_W_OUT 18
#define I_FINAL_G 19
#define WSP(T, off) ((T*)(kws() + (off)))

constexpr float QSCALE = 0.125f * 1.4426950408889634f;
typedef f32x4 acc_t[2][2][4][2];
typedef f32x4 acc3_t[2][2][3][2];

template <int MB_, bool FU = false> struct EpiInT {
    static constexpr bool PERM = true, SPLIT2 = false, MIDHOOK = false; static constexpr int KROT = 0; static constexpr int MB = MB_;
    typedef f32x4 accm_t[2][2][MB_][2];
    int layer, rowbase;
    template <bool ACT, bool ST, bool QS = false> __device__ __forceinline__ void plain(accm_t& acc, const f32x4 (&bv)[2][2], bf16_t* dst, float* st, int row0, int colbase) const {
#pragma unroll
        for (int ai = 0; ai < 2; ++ai)
#pragma unroll
            for (int m = 0; m < MB_; ++m) { const int row = row0 + ai * (32 * MB_) + m * 16;
#pragma unroll
                for (int bj = 0; bj < 2; ++bj) { f32x4 v0 = acc[ai][bj][m][0] + bv[bj][0], v1 = acc[ai][bj][m][1] + bv[bj][1];
                    if (QS) { v0 = v0 * QSCALE; v1 = v1 * QSCALE; }
                    if (ST) { float* sp = st + ((size_t)((row >> 8) * 512 + layer * 256 + (row & 255))) * 512 + colbase + bj * 128; *(f32x4*)sp = v0; *(f32x4*)(sp + 4) = v1; }
                    if (ACT) {
#pragma unroll
                        for (int j = 0; j < 4; ++j) { v0[j] = silu_f(v0[j]); v1[j] = silu_f(v1[j]); } }
                    u32x4 w; w.x = cvt_pk_bf16(v0[0], v0[1]); w.y = cvt_pk_bf16(v0[2], v0[3]); w.z = cvt_pk_bf16(v1[0], v1[1]); w.w = cvt_pk_bf16(v1[2], v1[3]);
                    *(u32x4*)(dst + (size_t)row * 512 + colbase + bj * 128) = w; } }
    }
    __device__ __forceinline__ void operator()(accm_t& acc, const pg8::Unit& u, int wr, int wc, int fr, int fq) const {
        asm volatile("" : "+v"(fr), "+v"(fq));
        const int row0 = rowbase + u.pm * (64 * MB_) + wr * (16 * MB_) + fr, c8 = wc * 32 + 8 * fq, pn = u.pn;
        const bool ctxrows = rowbase + u.pm * (64 * MB_) < NCTX;
        unsigned char* wsb = kws();
        bf16_t* Q = (bf16_t*)(wsb + WS_Q); bf16_t* K = (bf16_t*)(wsb + WS_K); bf16_t* V = (bf16_t*)(wsb + WS_V); bf16_t* SZA = (bf16_t*)(wsb + WS_SZA); bf16_t* U = (bf16_t*)(wsb + WS_U);
        bf16_t* SZB = (bf16_t*)(wsb + WS_SZB); bf16_t* GR = (bf16_t*)(wsb + WS_GR); bf16_t* GB = (bf16_t*)(wsb + WS_GB);
        const int tr0 = rowbase + u.pm * (64 * MB_), tg = tr0 < NCTX ? 0 : 1 + ((tr0 - NCTX) >> 11);
        const float* bp = FU ? (const float*)(wsb + WS_CVEC) + tg * DIN + pn * 256 + c8 : (const float*)(wsb + WS_BIASP) + layer * DIN + pn * 256 + c8;
        if (FU) { const float* rss = (const float*)(wsb + WS_RSS); float rq[2][MB_];
#pragma unroll
            for (int ai = 0; ai < 2; ++ai)
#pragma unroll
                for (int m = 0; m < MB_; ++m) rq[ai][m] = rss[row0 + ai * (32 * MB_) + m * 16];
#pragma unroll
            for (int ai = 0; ai < 2; ++ai)
#pragma unroll
                for (int m = 0; m < MB_; ++m) { const float rs = rsqrtf(rq[ai][m] * (1.0f / D) + EPS);
#pragma unroll
                    for (int bj = 0; bj < 2; ++bj) { acc[ai][bj][m][0] = acc[ai][bj][m][0] * rs; acc[ai][bj][m][1] = acc[ai][bj][m][1] * rs; } } }
        float* stk = kout() + (size_t)M * D; float* stv = stk + (size_t)16 * 2 * 256 * 512;
        f32x4 bv[2][2];
#pragma unroll
        for (int bj = 0; bj < 2; ++bj)
#pragma unroll
            for (int n = 0; n < 2; ++n) bv[bj][n] = *(const f32x4*)(bp + bj * 128 + 4 * n);
        const int colbase = (pn & 1) * 256 + c8;
        if (pn < 2) plain<false, false, true>(acc, bv, Q, nullptr, row0, colbase);
        else if (pn < 4) { if (ctxrows) plain<false, true>(acc, bv, K, stk, row0, colbase); else plain<false, false>(acc, bv, K, nullptr, row0, colbase); }
        else if (pn < 6) { if (ctxrows) plain<false, true>(acc, bv, V, stv, row0, colbase); else plain<false, false>(acc, bv, V, nullptr, row0, colbase); }
        else if (pn < 8) plain<true, false>(acc, bv, SZA, nullptr, row0, colbase);
        else if (pn == 12 || pn == 13) plain<true, false>(acc, bv, SZB, nullptr, row0, colbase);
        else if (pn < 12) {
            const int cb = (pn - 8) * 128 + c8;
#pragma unroll
            for (int ai = 0; ai < 2; ++ai)
#pragma unroll
                for (int m = 0; m < MB_; ++m) { const int row = row0 + ai * (32 * MB_) + m * 16;
                    f32x4 a0 = acc[ai][0][m][0] + bv[0][0], a1 = acc[ai][0][m][1] + bv[0][1], b0 = acc[ai][1][m][0] + bv[1][0], b1 = acc[ai][1][m][1] + bv[1][1];
#pragma unroll
                    for (int j = 0; j < 4; ++j) { a0[j] *= sigmoid_f(b0[j]); a1[j] *= sigmoid_f(b1[j]); }
                    u32x4 w; w.x = cvt_pk_bf16(a0[0], a0[1]); w.y = cvt_pk_bf16(a0[2], a0[3]); w.z = cvt_pk_bf16(a1[0], a1[1]); w.w = cvt_pk_bf16(a1[2], a1[3]);
                    *(u32x4*)(U + (size_t)row * 512 + cb) = w; }
        } else {
            const int cb = (pn - 14) * 128 + c8;
#pragma unroll
            for (int ai = 0; ai < 2; ++ai)
#pragma unroll
                for (int m = 0; m < MB_; ++m) { const int row = row0 + ai * (32 * MB_) + m * 16;
                    f32x4 a0 = acc[ai][0][m][0] + bv[0][0], a1 = acc[ai][0][m][1] + bv[0][1], b0 = acc[ai][1][m][0] + bv[1][0], b1 = acc[ai][1][m][1] + bv[1][1];
                    f32x4 r0, r1, g0, g1;
#pragma unroll
                    for (int j = 0; j < 4; ++j) {
                        const float ea0 = __expf(-a0[j]), ea1 = __expf(-a1[j]), eb0 = fminf(__expf(-b0[j]), 1e30f), eb1 = fminf(__expf(-b1[j]), 1e30f);
                        g0[j] = __builtin_amdgcn_rcpf(1.0f + eb0); g1[j] = __builtin_amdgcn_rcpf(1.0f + eb1);
                        r0[j] = (1.0f + eb0) * __builtin_amdgcn_rcpf(1.0f + ea0); r1[j] = (1.0f + eb1) * __builtin_amdgcn_rcpf(1.0f + ea1); }
                    u32x4 w; w.x = cvt_pk_bf16(r0[0], r0[1]); w.y = cvt_pk_bf16(r0[2], r0[3]); w.z = cvt_pk_bf16(r1[0], r1[1]); w.w = cvt_pk_bf16(r1[2], r1[3]);
                    *(u32x4*)(GR + (size_t)row * 1024 + cb) = w;
                    w.x = cvt_pk_bf16(g0[0], g0[1]); w.y = cvt_pk_bf16(g0[2], g0[3]); w.z = cvt_pk_bf16(g1[0], g1[1]); w.w = cvt_pk_bf16(g1[2], g1[3]);
                    *(u32x4*)(GB + (size_t)row * 1024 + cb) = w; }
        }
    }
};

struct EpiProj {
    static constexpr bool PERM = true, SPLIT2 = false, MIDHOOK = true; static constexpr int KROT = 3; static constexpr int MB = 3;
    __device__ __forceinline__ void mid(acc3_t& acc, const pg8::Unit& u, int wr, int wc, int fr, int fq) const {
        asm volatile("" : "+v"(fr), "+v"(fq));
        const int row0 = u.pm * 192 + wr * 48 + fr, col0 = u.pn * 256 + wc * 32 + 8 * fq;
        const bf16_t* G = WSP(bf16_t, WS_GR);
#pragma unroll
        for (int ai = 0; ai < 2; ++ai)
#pragma unroll
            for (int m = 0; m < 3; ++m) { const size_t off = (size_t)(row0 + ai * 96 + m * 16) * 1024 + col0;
#pragma unroll
                for (int bj = 0; bj < 2; ++bj) { const u32x4 w = *(const u32x4*)(G + off + bj * 128);
                    acc[ai][bj][m][0] = acc[ai][bj][m][0] * (f32x4){bflo(w.x), bfhi(w.x), bflo(w.y), bfhi(w.y)}; acc[ai][bj][m][1] = acc[ai][bj][m][1] * (f32x4){bflo(w.z), bfhi(w.z), bflo(w.w), bfhi(w.w)}; } }
    }
    __device__ __forceinline__ void operator()(acc3_t& acc, const pg8::Unit& u, int wr, int wc, int fr, int fq) const {
        asm volatile("" : "+v"(fr), "+v"(fq));
        const int row0 = u.pm * 192 + wr * 48 + fr, col0 = u.pn * 256 + wc * 32 + 8 * fq;
        unsigned char* wsb = kws();
        const bf16_t* G = (const bf16_t*)(wsb + WS_GB); bf16_t* Mo = (bf16_t*)(wsb + WS_H);
#pragma unroll
        for (int ai = 0; ai < 2; ++ai)
#pragma unroll
            for (int m = 0; m < 3; ++m) { const size_t off = (size_t)(row0 + ai * 96 + m * 16) * 1024 + col0;
#pragma unroll
                for (int bj = 0; bj < 2; ++bj) { const u32x4 w = *(const u32x4*)(G + off + bj * 128);
                    const f32x4 v0 = acc[ai][bj][m][0] * (f32x4){bflo(w.x), bfhi(w.x), bflo(w.y), bfhi(w.y)}, v1 = acc[ai][bj][m][1] * (f32x4){bflo(w.z), bfhi(w.z), bflo(w.w), bfhi(w.w)};
                    u32x4 o; o.x = cvt_pk_bf16(v0[0], v0[1]); o.y = cvt_pk_bf16(v0[2], v0[3]); o.z = cvt_pk_bf16(v1[0], v1[1]); o.w = cvt_pk_bf16(v1[2], v1[3]);
                    *(u32x4*)(Mo + off + bj * 128) = o; }
                asm volatile("" ::: "memory"); }
    }
};

template <bool LAST> struct EpiOutT {
    static constexpr bool PERM = true, SPLIT2 = false, MIDHOOK = false; static constexpr int KROT = 1; static constexpr int MB = 3;
    int layer;
    __device__ __forceinline__ void operator()(acc3_t& acc, const pg8::Unit& u, int wr, int wc, int fr, int fq) const {
        asm volatile("" : "+v"(fr), "+v"(fq));
        const int row0 = u.pm * 192 + wr * 48 + fr, col0 = u.pn * 256 + wc * 32 + 8 * fq;
        const float* modl = WSP(float, WS_MOD) + layer * 5 * 3072 + 2048 + col0;
        const float* xp = kin(I_X_PROMPT); const float* xs = kin(I_X_SAMPLE) - (size_t)NCTX * D;
        bf16_t* X1 = WSP(bf16_t, WS_X1); bf16_t* XG = WSP(bf16_t, WS_YAB);
        float* rss = WSP(float, LAST ? WS_RSS2 : WS_RSS);
        const float* gfin = kin(I_FINAL_G) + col0;
        float olds[6];
#pragma unroll
        for (int ai = 0; ai < 2; ++ai)
#pragma unroll
            for (int m = 0; m < 3; ++m) { const int row = row0 + ai * 96 + m * 16; const size_t off = (size_t)row * D + col0;
                const int g = row < NCTX ? 0 : 1 + ((row - NCTX) >> 11);
                const float* gate = modl + g * 3072; const float* xin = row < NCTX ? xp : xs;
                float ssq = 0.f;
#pragma unroll
                for (int bj = 0; bj < 2; ++bj) { const size_t o_ = off + bj * 128;
                    const f32x4 gv0 = *(const f32x4*)(gate + bj * 128), gv1 = *(const f32x4*)(gate + bj * 128 + 4);
                    f32x4 xi0, xi1;
                    if (LAST) { const u32x4 xw = *(const u32x4*)(X1 + o_); xi0 = (f32x4){bflo(xw.x), bfhi(xw.x), bflo(xw.y), bfhi(xw.y)}; xi1 = (f32x4){bflo(xw.z), bfhi(xw.z), bflo(xw.w), bfhi(xw.w)}; }
                    else { xi0 = *(const f32x4*)(xin + o_); xi1 = *(const f32x4*)(xin + o_ + 4); }
                    const f32x4 xn0 = xi0 + gv0 * acc[ai][bj][m][0], xn1 = xi1 + gv1 * acc[ai][bj][m][1];
                    ssq += ((xn0[0] * xn0[0] + xn0[1] * xn0[1]) + (xn0[2] * xn0[2] + xn0[3] * xn0[3])) + ((xn1[0] * xn1[0] + xn1[1] * xn1[1]) + (xn1[2] * xn1[2] + xn1[3] * xn1[3]));
                    const float* gmp = LAST ? gfin + bj * 128 : WSP(float, WS_GM) + g * 1024 + col0 + bj * 128;
                    const f32x4 y0 = xn0 * *(const f32x4*)gmp, y1 = xn1 * *(const f32x4*)(gmp + 4);
                    if (LAST) { acc[ai][bj][m][0] = y0; acc[ai][bj][m][1] = y1; }
                    else { u32x4 w; w.x = cvt_pk_bf16(y0[0], y0[1]); w.y = cvt_pk_bf16(y0[2], y0[3]); w.z = cvt_pk_bf16(y1[0], y1[1]); w.w = cvt_pk_bf16(y1[2], y1[3]);
                        *(u32x4*)(XG + o_) = w;
                        u32x4 xw; xw.x = cvt_pk_bf16(xn0[0], xn0[1]); xw.y = cvt_pk_bf16(xn0[2], xn0[3]); xw.z = cvt_pk_bf16(xn1[0], xn1[1]); xw.w = cvt_pk_bf16(xn1[2], xn1[3]);
                        *(u32x4*)(X1 + o_) = xw; } }
                ssq += __shfl_xor(ssq, 16); ssq += __shfl_xor(ssq, 32);
                float o = 0.f;
                if (LAST) { if (fq == 0) o = __hip_atomic_fetch_add(rss + row, ssq, __ATOMIC_RELAXED, __HIP_MEMORY_SCOPE_AGENT); }
                else { if (fq == 0) (void)__hip_atomic_fetch_add(rss + row, ssq, __ATOMIC_RELAXED, __HIP_MEMORY_SCOPE_AGENT); }
                olds[ai * 3 + m] = o;
                asm volatile("" ::: "memory"); }
        if constexpr (LAST) {
            asm volatile("" :: "v"(olds[0]), "v"(olds[1]), "v"(olds[2]), "v"(olds[3]), "v"(olds[4]), "v"(olds[5]));
            asm volatile("s_waitcnt vmcnt(0)" ::: "memory");
            __syncthreads();
            if (fresh_tid() == 0) { unsigned* cnt = WSP(unsigned, WS_CTL) + CW_ROWBLK + u.pm * 16;
                (void)__hip_atomic_fetch_add(cnt, 1u, __ATOMIC_RELAXED, __HIP_MEMORY_SCOPE_AGENT);
                unsigned sp = 0; while (__hip_atomic_load(cnt, __ATOMIC_RELAXED, __HIP_MEMORY_SCOPE_AGENT) < 4u) { __builtin_amdgcn_s_sleep(1); if (++sp > (1u << 22)) break; } }
            __syncthreads();
            float* out = kout();
            float sq[6];
#pragma unroll
            for (int k = 0; k < 6; ++k) sq[k] = __hip_atomic_load(rss + row0 + (k / 3) * 96 + (k % 3) * 16, __ATOMIC_RELAXED, __HIP_MEMORY_SCOPE_AGENT);
#pragma unroll
            for (int ai = 0; ai < 2; ++ai)
#pragma unroll
                for (int m = 0; m < 3; ++m) { const int row = row0 + ai * 96 + m * 16; float* yr = out + (size_t)row * D + col0;
                    const float rstd = rsqrtf(sq[ai * 3 + m] * (1.f / D) + EPS);
#pragma unroll
                    for (int bj = 0; bj < 2; ++bj) { *(f32x4*)(yr + bj * 128) = acc[ai][bj][m][0] * rstd; *(f32x4*)(yr + bj * 128 + 4) = acc[ai][bj][m][1] * rstd; } }
        }
    }
};

#define XB_TMO      128
#define XB_XCNT(j)  (256  + 64 * (j))
#define XB_XSUB(j)  (1280 + 64 * (j))
#define XB_XGEN(j)  (2304 + 64 * (j))
#define XB_TOP      3328
#define XB_TOPGEN   3392
#define XCD_BAR_WORDS 3456
#define XB_SPIN_CAP (1u << 18)
__device__ __forceinline__ unsigned xb_ld(unsigned* p)              { return __hip_atomic_load(p, __ATOMIC_RELAXED, __HIP_MEMORY_SCOPE_AGENT); }
__device__ __forceinline__ unsigned xb_add(unsigned* p, unsigned v) { return __hip_atomic_fetch_add(p, v, __ATOMIC_RELAXED, __HIP_MEMORY_SCOPE_AGENT); }
__device__ __forceinline__ unsigned xb_xcc_id() { return (unsigned)__builtin_amdgcn_s_getreg((3 << 11) | 20) & 0xFu; }
#define XB_SPIN(cond, bar) do { unsigned _sp = 0; while (cond) { __builtin_amdgcn_s_sleep(1); \
    if ((++_sp & 255u) == 0u) { if (xb_ld(&(bar)[XB_TMO])) break; if (_sp > XB_SPIN_CAP) { atomicAdd(&(bar)[XB_TMO], 1u); break; } } } } while (0)
struct XcdBarrier { unsigned* bar; unsigned x; volatile LAS unsigned* st; };
__device__ __forceinline__ XcdBarrier xcd_barrier_post(unsigned* bar, volatile LAS unsigned* st) {
    XcdBarrier b; b.bar = bar; b.x = xb_xcc_id(); b.st = st;
    if (threadIdx.x == 0) (void)xb_add(&bar[XB_XCNT(b.x)], 1u);
    return b;
}
__device__ __forceinline__ void xcd_barrier_complete(unsigned* bar, unsigned x, unsigned& nloc, unsigned& nx) {
    const unsigned G = gridDim.x * gridDim.y * gridDim.z;
    unsigned sum, cnt, mine, sp = 0u;
    for (;;) {
        sum = 0u; cnt = 0u; mine = 0u;
#pragma unroll
        for (unsigned j = 0; j < 16; ++j) { const unsigned c = xb_ld(&bar[XB_XCNT(j)]); sum += c; cnt += (c > 0u) ? 1u : 0u; mine = (j == x) ? c : mine; }
        if (sum == G) break;
        __builtin_amdgcn_s_sleep(1);
        if ((++sp & 255u) == 0u) { if (xb_ld(&bar[XB_TMO])) break; if (sp > XB_SPIN_CAP) { atomicAdd(&bar[XB_TMO], 1u); break; } }
    }
    nloc = mine > 0u ? mine : 1u; nx = cnt > 0u ? cnt : 1u;
}
__device__ __forceinline__ void xcd_barrier(const XcdBarrier& b) {
    asm volatile("s_waitcnt vmcnt(0)" ::: "memory");
    __syncthreads();
    if (fresh_tid() == 0) {
        unsigned* bar = b.bar;
        __builtin_amdgcn_s_waitcnt(0);
        asm volatile("buffer_inv sc1" ::: "memory");
        unsigned nloc = b.st[0], nx = b.st[1];
        if (nloc == 0u) { xcd_barrier_complete(bar, b.x, nloc, nx); b.st[0] = nloc; b.st[1] = nx; }
        const unsigned old = xb_add(&bar[XB_XSUB(b.x)], 1u);
        const unsigned gen = old / nloc;
        if (old + 1u == (gen + 1u) * nloc) {
            __builtin_amdgcn_fence(__ATOMIC_RELEASE, "agent");
            asm volatile("s_waitcnt vmcnt(0)" ::: "memory");
            const unsigned og = xb_add(&bar[XB_TOP], 1u);
            const unsigned tg = og / nx;
            if (og + 1u == (tg + 1u) * nx) xb_add(&bar[XB_TOPGEN], 1u);
            else XB_SPIN(xb_ld(&bar[XB_TOPGEN]) == tg, bar);
            xb_add(&bar[XB_XGEN(b.x)], 1u);
        } else {
            XB_SPIN(xb_ld(&bar[XB_XGEN(b.x)]) == gen, bar);
        }
        asm volatile("s_waitcnt vmcnt(0)" ::: "memory");
    }
    __syncthreads();
}

struct Frame {
    LAS unsigned char* lds;
    int tid, lane, wave, G, bx;
};


__device__ __forceinline__ int in_srccol(int n) {
    const int tile = n >> 8, r = n & 255;
    if (tile < 8 || tile == 12 || tile == 13) return n;
    if (tile < 12) { const int i = tile - 8; return (r < 128 ? 2048 : 2560) + 128 * i + (r & 127); }
    const int i = tile - 14; return (r < 128 ? 3584 : 4608) + 128 * i + (r & 127);
}

__device__ __forceinline__ void transpose_item(const float* W, int ldw, int srccol0, int k0, bf16_t* WT, int dstrow0, int dstk0, LAS float* scr, int lane) {
    float tv[32];
#pragma unroll
    for (int i = 0; i < 32; ++i) { const int kk = 2 * i + (lane >> 5); tv[i] = W[(size_t)(k0 + kk) * ldw + srccol0 + (lane & 31)]; }
#pragma unroll
    for (int i = 0; i < 32; ++i) { const int kk = 2 * i + (lane >> 5); scr[kk * 33 + (lane & 31)] = tv[i]; }
    LDS_WAIT(); asm volatile("" ::: "memory");
    const int c = lane & 7;
#pragma unroll
    for (int j = 0; j < 4; ++j) { const int n = (lane >> 3) + 8 * j; const LAS float* s = scr + (8 * c) * 33 + n;
        u32x4 o; o.x = pk2(s[0 * 33], s[1 * 33]); o.y = pk2(s[2 * 33], s[3 * 33]); o.z = pk2(s[4 * 33], s[5 * 33]); o.w = pk2(s[6 * 33], s[7 * 33]);
        *(GAS u32x4*)(WT + (size_t)(dstrow0 + n) * 1024 + dstk0 + 8 * c) = o; }
    LDS_WAIT(); asm volatile("" ::: "memory");
}

__device__ __forceinline__ void mod_task(Frame& F, int t) {
    const int l = t / 48, j0 = (t % 48) * 64;
    const float* c_ctx = kin(I_C_CTX); const float* cvec = kin(I_C); const float* w_ada = kin(I_W_ADA); const float* b_ada = kin(I_B_ADA); float* MOD = WSP(float, WS_MOD);
    LAS float* sv = (LAS float*)F.lds;
    LAS float* part = (LAS float*)(F.lds + 20480);
    for (int i = F.tid; i < 5 * 1024; i += 512) { const int g = i >> 10, k = i & 1023; const float c = (g == 0) ? c_ctx[k] : cvec[(g - 1) * 1024 + k]; sv[i] = silu_f(c); }
    __syncthreads();
    const float* W = w_ada + (size_t)l * 1024 * 3072 + (size_t)(128 * F.wave) * 3072 + j0 + F.lane;
    float a0 = 0.f, a1 = 0.f, a2 = 0.f, a3 = 0.f, a4 = 0.f;
#pragma unroll 32
    for (int kk = 0; kk < 128; ++kk) { const float wv = W[(size_t)kk * 3072]; const int k = 128 * F.wave + kk;
        a0 += sv[k] * wv; a1 += sv[1024 + k] * wv; a2 += sv[2048 + k] * wv; a3 += sv[3072 + k] * wv; a4 += sv[4096 + k] * wv; }
    part[(F.wave * 5 + 0) * 64 + F.lane] = a0; part[(F.wave * 5 + 1) * 64 + F.lane] = a1; part[(F.wave * 5 + 2) * 64 + F.lane] = a2;
    part[(F.wave * 5 + 3) * 64 + F.lane] = a3; part[(F.wave * 5 + 4) * 64 + F.lane] = a4;
    __syncthreads();
    if (F.tid < 320) { const int g = F.tid >> 6, ln = F.tid & 63; float s = 0.f;
#pragma unroll
        for (int w = 0; w < 8; ++w) s += part[(w * 5 + g) * 64 + ln];
        MOD[(l * 5 + g) * 3072 + j0 + ln] = s + b_ada[l * 3072 + j0 + ln]; }
    __syncthreads();
}

__device__ __forceinline__ void wt_items(Frame& F, int l, int w0, int nw);
__device__ __forceinline__ void p0_prologue(Frame& F) {
    if (F.bx < 96) mod_task(F, F.bx);
    const int gw = F.bx * 8 + F.wave, NGW = F.G * 8;
    const int gt = F.bx * 512 + F.tid, NGT = F.G * 512;
    { float* BIASP = WSP(float, WS_BIASP); const float* b_in = kin(I_B_IN);
      for (int i = gt; i < DEPTH * DIN; i += NGT) { const int l = i / DIN, n = i % DIN; BIASP[i] = b_in[l * DIN + in_srccol(n)]; } }
    const float* cache_k = kin(I_CACHE_K); const float* cache_v = kin(I_CACHE_V); bf16_t* CK = WSP(bf16_t, WS_CK); bf16_t* CV = WSP(bf16_t, WS_CV);
    for (int i0 = gt; i0 < 2 * 131072; i0 += 2 * NGT) { f32x4 a[2], b[2];
#pragma unroll
        for (int k = 0; k < 2; ++k) { const int i = i0 + k * NGT; if (i < 2 * 131072) { const int which = i >> 17, e = (i & 131071) * 8; const float* src = (which ? cache_v : cache_k) + e; a[k] = *(const f32x4*)src; b[k] = *(const f32x4*)(src + 4); } }
#pragma unroll
        for (int k = 0; k < 2; ++k) { const int i = i0 + k * NGT; if (i < 2 * 131072) { const int which = i >> 17, e = (i & 131071) * 8; bf16_t* dst = (which ? CV : CK) + e;
            u32x4 w; w.x = pk2(a[k][0], a[k][1]); w.y = pk2(a[k][2], a[k][3]); w.z = pk2(b[k][0], b[k][1]); w.w = pk2(b[k][2], b[k][3]); *(u32x4*)dst = w; } } }
    wt_items(F, 0, gw, NGW);
    { const int nidle = F.G - (M - 46 * 256) / 128 * (DIN / 256); if (nidle <= 0) wt_items(F, 1, gw, NGW); }
}

__device__ __forceinline__ void wt_items(Frame& F, int l, int w0, int nw) {
    LAS float* scr = (LAS float*)(F.lds + F.wave * 16384);
    const float* w_in = kin(I_W_IN); const float* w_proj_a = kin(I_W_PROJ_A); const float* w_proj_b = kin(I_W_PROJ_B); const float* w_out = kin(I_W_OUT);
    bf16_t* WTIN = WSP(bf16_t, WS_WTIN); bf16_t* WTPROJ = WSP(bf16_t, WS_WTPROJ); bf16_t* WTOUT = WSP(bf16_t, WS_WTOUT);
    constexpr int I_IN = 16 * 176, I_P = 8 * 32, I_O = 16 * 32, I_L = I_IN + 2 * I_P + I_O;
    for (int it = w0; it < I_L; it += nw) {
        int r = it;
        if (r < I_IN) { const int kb = r / 176, nb = r % 176; transpose_item(w_in + (size_t)l * D * DIN, DIN, in_srccol(32 * nb), 64 * kb, WTIN + (size_t)l * DIN * D, 32 * nb, 64 * kb, scr, F.lane); continue; } r -= I_IN;
        if (r < I_P) { const int kb = r / 32, nb = r % 32; transpose_item(w_proj_a + (size_t)l * 512 * D, D, 32 * nb, 64 * kb, WTPROJ + (size_t)l * D * D, 32 * nb, 64 * kb, scr, F.lane); continue; } r -= I_P;
        if (r < I_P) { const int kb = r / 32, nb = r % 32; transpose_item(w_proj_b + (size_t)l * 512 * D, D, 32 * nb, 64 * kb, WTPROJ + (size_t)l * D * D, 32 * nb, 512 + 64 * kb, scr, F.lane); continue; } r -= I_P;
        { const int kb = r / 32, nb = r % 32; transpose_item(w_out + (size_t)l * D * D, D, 32 * nb, 64 * kb, WTOUT + (size_t)l * D * D, 32 * nb, 64 * kb, scr, F.lane); }
    }
}

__device__ __forceinline__ void norm_phase(Frame& F, int layer) {
    const int gw = F.bx * 8 + F.wave, NGW = F.G * 8;
    const float* xa = layer == 0 ? kin(I_X_PROMPT) : kout(); const float* xb = layer == 0 ? kin(I_X_SAMPLE) : kout() + (size_t)NCTX * D;
    const float* MOD = WSP(float, WS_MOD); const float* rms_g = kin(I_RMS_G) + layer * D; bf16_t* H = WSP(bf16_t, WS_H);
    for (int rb = gw; rb < M; rb += 3 * NGW) {
        f32x4 v[3][4];
#pragma unroll
        for (int k = 0; k < 3; ++k) { const int r = rb + k * NGW; if (r < M) {
            const float* xrow = r < NCTX ? xa + (size_t)r * D : xb + (size_t)(r - NCTX) * D; const f32x4* xr = (const f32x4*)xrow + F.lane;
#pragma unroll
            for (int j = 0; j < 4; ++j) v[k][j] = xr[64 * j]; } }
#pragma unroll
        for (int k = 0; k < 3; ++k) { const int r = rb + k * NGW; if (r < M) {
            const int g = r < NCTX ? 0 : 1 + ((r - NCTX) >> 11);
            const float* mod = MOD + (layer * 5 + g) * 3072;
            float s = 0.f;
#pragma unroll
            for (int j = 0; j < 4; ++j) s += (v[k][j][0] * v[k][j][0] + v[k][j][1] * v[k][j][1]) + (v[k][j][2] * v[k][j][2] + v[k][j][3] * v[k][j][3]);
            const float rstd = rsqrtf(wave_sum(s) * (1.f / D) + EPS);
            unsigned long long* o8 = (unsigned long long*)(H + (size_t)r * D) + F.lane;
#pragma unroll
            for (int j = 0; j < 4; ++j) { const int c = 4 * F.lane + 256 * j;
                const f32x4 gg = *(const f32x4*)(rms_g + c), sh = *(const f32x4*)(mod + c), sc = *(const f32x4*)(mod + 1024 + c);
                const f32x4 y = v[k][j] * rstd * gg * (sc + 1.0f) + sh;
                o8[64 * j] = (unsigned long long)cvt_pk_bf16(y[0], y[1]) | ((unsigned long long)cvt_pk_bf16(y[2], y[3]) << 32); } } }
    }
}

struct AttnPre { u32x4 qrow[4], pa0, pc0, pa1, kreg, vreg, kreg2, vreg2; float bvv[8]; };
__device__ __forceinline__ void attn_prefetch(Frame& F, int layer, int task, const bool ctx, AttnPre& P);
__device__ __forceinline__ void conv_task(Frame& F, int layer, int tile, AttnPre& pre, int pre_task) {
    const int t0 = tile * 32;
    int s0, s1; if (t0 < NCTX) { s0 = t0 & ~255; s1 = s0 + 256; } else { s0 = NCTX + ((t0 - NCTX) & ~2047); s1 = s0 + 2048; }
    const bf16_t* Ub = WSP(bf16_t, WS_U); const bf16_t* SZB = WSP(bf16_t, WS_SZB); bf16_t* YAB = WSP(bf16_t, WS_YAB);
    const float* dw_w = kin(I_DW_W); const float* dw_b = kin(I_DW_B); const float* ln_g = kin(I_LN_G) + layer * 512; const float* ln_b = kin(I_LN_B) + layer * 512;
    LAS unsigned* Ul = (LAS unsigned*)F.lds;
    LAS float* Cl = (LAS float*)(F.lds + 62 * 1024);
    u32x4 xs[8];
#pragma unroll
    for (int k = 0; k < 8; ++k) { const int i = F.tid + 512 * k; const int lr = i >> 6, ch = i & 63; const int t = t0 - 15 + lr; xs[k] = (u32x4){0u, 0u, 0u, 0u};
        if (i < 62 * 64 && t >= s0 && t < s1) xs[k] = *(const u32x4*)(Ub + (size_t)t * 512 + ch * 8); }
    const int cp = F.tid & 255, th = F.tid >> 8;
    float w0[31], w1[31];
#pragma unroll
    for (int j = 0; j < 31; ++j) { const f32x2 w = *(const f32x2*)(dw_w + (size_t)(layer * 31 + j) * 512 + 2 * cp); w0[j] = w[0]; w1[j] = w[1]; }
    const f32x2 bb = *(const f32x2*)(dw_b + layer * 512 + 2 * cp);
    u32x2 zq[4][2];
#pragma unroll
    for (int k = 0; k < 4; ++k) { const int t = t0 + F.wave * 4 + k; zq[k][0] = *(const u32x2*)(SZB + (size_t)t * 512 + 4 * F.lane); zq[k][1] = *(const u32x2*)(SZB + (size_t)t * 512 + 256 + 4 * F.lane); }
#pragma unroll
    for (int k = 0; k < 8; ++k) { const int i = F.tid + 512 * k; if (i < 62 * 64) *(LAS u32x4*)(Ul + (i >> 6) * 256 + (i & 63) * 4) = xs[k]; }
    __syncthreads();
    {
        for (int blk = 0; blk < 4; ++blk) { const int tt0 = th * 16 + blk * 4;
            float a0[4], a1[4];
#pragma unroll
            for (int o = 0; o < 4; ++o) { a0[o] = bb[0]; a1[o] = bb[1]; }
#pragma unroll
            for (int i = 0; i < 34; ++i) { const unsigned x = Ul[(tt0 + i) * 256 + cp]; const float x0 = bflo(x), x1 = bfhi(x);
#pragma unroll
                for (int o = 0; o < 4; ++o) { const int j = i - o; if (j >= 0 && j < 31) { a0[o] += w0[j] * x0; a1[o] += w1[j] * x1; } } }
#pragma unroll
            for (int o = 0; o < 4; ++o) *(LAS f32x2*)(Cl + (tt0 + o) * 512 + 2 * cp) = (f32x2){a0[o], a1[o]};
        }
    }
    __syncthreads();
    const f32x4 g0 = *(const f32x4*)(ln_g + 4 * F.lane), g1 = *(const f32x4*)(ln_g + 256 + 4 * F.lane);
    const f32x4 b0 = *(const f32x4*)(ln_b + 4 * F.lane), b1 = *(const f32x4*)(ln_b + 256 + 4 * F.lane);
    asm volatile("" ::: "memory");
    if (pre_task >= 0) attn_prefetch(F, layer, pre_task, false, pre);
    asm volatile("" ::: "memory");
#pragma unroll
    for (int k = 0; k < 4; ++k) { const int tt = F.wave * 4 + k, t = t0 + tt;
        f32x4 v0 = *(LAS f32x4*)(Cl + tt * 512 + 4 * F.lane), v1 = *(LAS f32x4*)(Cl + tt * 512 + 256 + 4 * F.lane);
        const float mean = wave_sum((v0[0] + v0[1]) + (v0[2] + v0[3]) + (v1[0] + v1[1]) + (v1[2] + v1[3])) * (1.f / 512.f);
        v0 = v0 - mean; v1 = v1 - mean;
        const float var = wave_sum((v0[0] * v0[0] + v0[1] * v0[1]) + (v0[2] * v0[2] + v0[3] * v0[3]) + (v1[0] * v1[0] + v1[1] * v1[1]) + (v1[2] * v1[2] + v1[3] * v1[3])) * (1.f / 512.f);
        const float rstd = rsqrtf(var + EPS);
        f32x4 y0 = v0 * rstd * g0 + b0, y1 = v1 * rstd * g1 + b1;
        const u32x2 z0 = zq[k][0], z1 = zq[k][1];
        const f32x4 zz0 = (f32x4){bflo(z0.x), bfhi(z0.x), bflo(z0.y), bfhi(z0.y)}, zz1 = (f32x4){bflo(z1.x), bfhi(z1.x), bflo(z1.y), bfhi(z1.y)};
#pragma unroll
        for (int j = 0; j < 4; ++j) { y0[j] = silu_f(y0[j]) * zz0[j]; y1[j] = silu_f(y1[j]) * zz1[j]; }
        u32x2 o0, o1; o0.x = cvt_pk_bf16(y0[0], y0[1]); o0.y = cvt_pk_bf16(y0[2], y0[3]); o1.x = cvt_pk_bf16(y1[0], y1[1]); o1.y = cvt_pk_bf16(y1[2], y1[3]);
        *(u32x2*)(YAB + (size_t)t * 1024 + 512 + 4 * F.lane) = o0; *(u32x2*)(YAB + (size_t)t * 1024 + 768 + 4 * F.lane) = o1;
    }
    __syncthreads();
}

typedef float f32x16 __attribute__((ext_vector_type(16)));
typedef short s16x4 __attribute__((ext_vector_type(4)));
typedef __bf16 bf16x2_t __attribute__((ext_vector_type(2)));
__device__ __forceinline__ unsigned cvtpk_s(float lo, float hi) { f32x2 v = {lo, hi}; bf16x2_t b = __builtin_convertvector(v, bf16x2_t); return __builtin_bit_cast(unsigned, b); }
__device__ __forceinline__ s16x4 vtr(const LAS char* p) { return __builtin_bit_cast(s16x4, __builtin_amdgcn_ds_read_tr16_b64_v4i16((LAS s16x4*)p)); }
#define MFMA32(a, b, c) __builtin_amdgcn_mfma_f32_32x32x16_bf16((a), (b), (c), 0, 0, 0)
constexpr float LOG2E = 1.4426950408889634f;
constexpr float ATT_QSCALE = 0.125f * LOG2E;
constexpr int AT_SLOTB = 8192, AT_K = 0, AT_V = 3 * AT_SLOTB, AT_TBL = 6 * AT_SLOTB;
constexpr int AT_VSTRIDE = 68, AT_ROWF = 16 * AT_VSTRIDE + 52, AT_INF = AT_TBL + 15 * AT_ROWF * 4, AT_ZERO = AT_INF + 512, AT_END = AT_ZERO + 512;
static_assert(AT_END <= RING_BYTES, "attention LDS");
constexpr float ATT_THR = 8.0f;

#define ATT_DECODE() \
    int b, h, R0, r = 0, n_win = 0, lo = 0, qc = 0, r0 = 0; \
    if (!ctx) { const int R = 4 * (task & 7); h = (task >> 3) & 7; b = task >> 6; r = R + (wid >> 1); const int HALF = wid & 1; \
        R0 = NCTX + b * 2048 + r * 64 + HALF * 32; qc = HALF * 32 + r32; r0 = min(max(r - 4, 0), 24); \
        lo = min(max(R - 4, 0), 24); n_win = min(max(R - 1, 0), 24) + 8 - lo; \
    } else { h = task & 7; b = task >> 3; R0 = b * 256 + wid * 32; } \
    const int NT = n_win + 4; (void)qc; (void)r0; (void)r; (void)NT; \
    const unsigned ksoff = (unsigned)(lane * 512 + wid * 8), vsoff = (unsigned)((16 * (wid & 3) + (lane >> 2)) * 512 + (wid >> 2) * 32 + (lane & 3) * 8);
#define ATT_SRC(t, KP, VP) do { if ((t) < n_win) { const size_t o_ = (size_t)(NCTX + b * 2048 + (lo + (t)) * 64) * 512 + h * 64; KP = (const bf16_t*)(wsb + WS_K) + o_; VP = (const bf16_t*)(wsb + WS_V) + o_; } \
        else if (ctx) { const size_t o_ = (size_t)(b * 256 + ((t) - n_win) * 64) * 512 + h * 64; KP = (const bf16_t*)(wsb + WS_K) + o_; VP = (const bf16_t*)(wsb + WS_V) + o_; } \
        else { const size_t o_ = ((size_t)((b * 2 + layer) * 256 + ((t) - n_win) * 64)) * 512 + h * 64; KP = (const bf16_t*)(wsb + WS_CK) + o_; VP = (const bf16_t*)(wsb + WS_CV) + o_; } } while (0)
__device__ __forceinline__ void attn_prefetch(Frame& F, int layer, int task, const bool ctx, AttnPre& P) {
    const int tid = fresh_tid(), lane = tid & 63, r32 = lane & 31, wid = __builtin_amdgcn_readfirstlane(tid >> 6);
    unsigned char* wsb = kws();
    ATT_DECODE()
    { const bf16_t* qp = (const bf16_t*)(wsb + WS_Q) + (size_t)(R0 + (lane >> 3)) * 512 + h * 64 + (lane & 7) * 8;
#pragma unroll
      for (int i = 0; i < 4; ++i) P.qrow[i] = *(const u32x4*)(qp + (size_t)i * 8 * 512); }
    { const bf16_t *k0, *v0, *k1, *v1, *k2, *v2, *k3, *v3; ATT_SRC(0, k0, v0); ATT_SRC(1, k1, v1); ATT_SRC(2, k2, v2); ATT_SRC(3, k3, v3); (void)v3;
      P.pa0 = *(const u32x4*)(k0 + ksoff); P.pc0 = *(const u32x4*)(v0 + vsoff); P.pa1 = *(const u32x4*)(k1 + ksoff);
      P.kreg = *(const u32x4*)(k2 + ksoff); P.vreg = *(const u32x4*)(v1 + vsoff); P.kreg2 = *(const u32x4*)(k3 + ksoff); P.vreg2 = *(const u32x4*)(v2 + vsoff); }
    if (!ctx) { const float* rb = kin(I_REL_BIAS) + (size_t)(layer * 8 + h) * 465;
#pragma unroll
        for (int k = 0; k < 8; ++k) { const int i = tid + 512 * k, dr = i >> 8, v = (i >> 4) & 15, j = i & 15; P.bvv[k] = (i < 3840) ? rb[dr * 31 + v + j] : 0.f; } }
}

__device__ __forceinline__ void attn_wg(Frame& F, int layer, int task, const bool ctx, AttnPre& P, int next_ctx) {
    const int tid = fresh_tid(), lane = tid & 63, r32 = lane & 31, hi = lane >> 5, wid = __builtin_amdgcn_readfirstlane(tid >> 6);
    LAS char* L = (LAS char*)F.lds;
    unsigned char* wsb = kws();
    ATT_DECODE()
    const int kdst = AT_K + wid * 1024 + lane * 16, vdst = AT_V + wid * 1024 + lane * 16;
    u32x4 kreg = P.kreg, vreg = P.vreg, kreg2 = P.kreg2, vreg2 = P.vreg2;
    bf16x8 qr[4];
    { LAS char* stg = L + AT_TBL + wid * 4608; LAS char* srow = stg + (lane >> 3) * 144 + (lane & 7) * 16;
#pragma unroll
      for (int i = 0; i < 4; ++i) *(LAS u32x4*)(srow + i * 8 * 144) = P.qrow[i];
      asm volatile("s_waitcnt lgkmcnt(0)" ::: "memory");
#pragma unroll
      for (int s_ = 0; s_ < 4; ++s_) qr[s_] = *(const LAS bf16x8*)(stg + r32 * 144 + hi * 16 + s_ * 32);
      asm volatile("s_waitcnt lgkmcnt(0)" ::: "memory"); }
    { unsigned zz = 0u; asm volatile("" : "+v"(zz));
      if (tid < 32) *(LAS u32x4*)(L + AT_ZERO + 16 * tid) = (u32x4){zz, zz, zz, zz}; }
    if (!ctx) { unsigned ninf = 0xff800000u; asm volatile("" : "+v"(ninf));
        for (int i = lane; i < 4608 / 16; i += 64) *(LAS u32x4*)(L + AT_TBL + wid * 4608 + 16 * i) = (u32x4){ninf, ninf, ninf, ninf};
        for (int i = 8 * 4608 / 16 + tid; i < (AT_ZERO - AT_TBL) / 16; i += 512) *(LAS u32x4*)(L + AT_TBL + 16 * i) = (u32x4){ninf, ninf, ninf, ninf}; }
    *(LAS u32x4*)(L + kdst) = P.pa0; *(LAS u32x4*)(L + vdst) = P.pc0; *(LAS u32x4*)(L + AT_SLOTB + kdst) = P.pa1;
    if (!ctx) {
        asm volatile("s_waitcnt lgkmcnt(0)\n\ts_barrier" ::: "memory");
#pragma unroll
        for (int k = 0; k < 8; ++k) { const int i = tid + 512 * k, dr = i >> 8, v = (i >> 4) & 15, j = i & 15; if (i < 3840) *(LAS float*)(L + AT_TBL + (dr * AT_ROWF + v * AT_VSTRIDE + 48 + j) * 4) = P.bvv[k] * LOG2E; }
    }
    const int HALFW = ctx ? 0 : (wid & 1);
    const LAS char* kpA = L + AT_K + hi * 1024 + (32 * HALFW + r32) * 16;
    const LAS char* kpB = L + AT_K + hi * 1024 + (32 * (1 - HALFW) + ((r32 + 24 * HALFW) & 31)) * 16;
    const LAS char* vp0 = L + AT_V + ((lane >> 4) & 1) * 32 + (lane & 3) * 8 + (4 * hi + ((lane & 15) >> 2)) * 64;
    const int H2 = HALFW * 2048, O2 = (1 - HALFW) * 2048, rot = 3 * HALFW;
    const int vol0 = H2, voh0 = H2 + 512, vol1 = H2 + 1024, voh1 = H2 + 1536;
    const int vol2 = O2 + ((0 + rot) & 3) * 512, voh2 = O2 + ((1 + rot) & 3) * 512, vol3 = O2 + ((2 + rot) & 3) * 512, voh3 = O2 + ((3 + rot) & 3) * 512;
    const int vsh = (qc < 8 ? 8 - qc : (qc > 56 ? 56 - qc : 0)) + 7;
    const int tlane = AT_TBL + (67 * vsh + 4 * hi - qc + 63) * 4;
    const int offA = 128 * HALFW, offB = HALFW ? 96 : 128;
    const int NWP = n_win + ((n_win > 0 && ((n_win - 1) & 1)) ? 1 : 0), NTV = NWP + 4;
#define VT(t) ((t) < n_win ? (t) : ((t) < NWP ? n_win - 1 : (t) - (NWP - n_win)))
    float mhat = -INFINITY, l_reg = 0.f, fres = 1.f; bool resc = false;
    f32x16 o0, o1;
#pragma unroll
    for (int i = 0; i < 16; ++i) { o0[i] = 0.f; o1[i] = 0.f; }
    f32x16 pA0, pA1, pB0, pB1; bf16x8 kf[8]; s16x4 vlo[8], vhi[8]; u32x4 pw0, pw1, pw2, pw3;
#pragma unroll
    for (int i = 0; i < 16; ++i) { pA1[i] = 0.f; pB1[i] = 0.f; }
    int sl_prev = 0, sl_cur = 0, sl_next = AT_SLOTB;
#define SBAR() __builtin_amdgcn_sched_barrier(0)
#define PIN(x) asm volatile("" : "+v"(x))
#define WBAR() asm volatile("s_waitcnt lgkmcnt(0)\n\ts_barrier" ::: "memory")
#define ROT() do { sl_prev = sl_cur; sl_cur = sl_next; sl_next = (sl_next == 2 * AT_SLOTB) ? 0 : sl_next + AT_SLOTB; } while (0)
#define MX3(a, b, c) __builtin_fmaxf(__builtin_fmaxf((a), (b)), (c))
#define KLD2(so, j) do { kf[2 * (j)] = *(const LAS bf16x8*)(kpA + (so) + (j) * 2048); kf[2 * (j) + 1] = *(const LAS bf16x8*)(kpB + (so) + (j) * 2048); } while (0)
#define CADDR(tt) (((tt) < n_win && (unsigned)(lo + (tt) - r0) < 8u) ? tlane + (lo + (tt) - r + 7) * (AT_ROWF * 4) : AT_INF)
#define CLDA(X0, q) do { const int ro_ = (((2 * (q)) & 3) + 8 * ((2 * (q)) >> 2)) * 4; X0[2 * (q)] = *(const LAS float*)(L + cad + offA + ro_); X0[2 * (q) + 1] = *(const LAS float*)(L + cad + offA + ro_ + 4); } while (0)
#define CLDB(X1, q) do { X1[2 * (q)] = *(const LAS float*)(L + cad + offB + 8 * (q)); X1[2 * (q) + 1] = *(const LAS float*)(L + cad + offB + 8 * (q) + 4); } while (0)
#define DEC_TAIL() do { { auto rr_ = __builtin_amdgcn_permlane32_swap(__float_as_uint(rm_), __float_as_uint(rm_), false, false); rm_ = __builtin_fmaxf(__uint_as_float(rr_[0]), __uint_as_float(rr_[1])); } \
        resc = false; \
        if (__builtin_amdgcn_ballot_w64(rm_ > mhat + ATT_THR) != 0ull) { const float mn_ = __builtin_fmaxf(mhat, rm_); fres = __builtin_amdgcn_exp2f(mhat - mn_); l_reg *= fres; mhat = mn_; resc = true; } \
        nmh = (mhat == -INFINITY) ? 0.f : -mhat; } while (0)
#define DECIDE_D(C0, C1) do { float a_ = MX3(C0[0], C0[1], C1[0]), b_ = MX3(C0[2], C0[3], C1[1]); a_ = MX3(a_, C1[2], C1[3]); \
        _Pragma("unroll") for (int r_ = 4; r_ < 16; r_ += 4) { a_ = MX3(a_, C0[r_], C0[r_ + 1]); b_ = MX3(b_, C0[r_ + 2], C0[r_ + 3]); a_ = MX3(a_, C1[r_], C1[r_ + 1]); b_ = MX3(b_, C1[r_ + 2], C1[r_ + 3]); } \
        float rm_ = __builtin_fmaxf(a_, b_); DEC_TAIL(); } while (0)
#define DECIDE_W(C0, C1) do { float a_ = MX3(C0[0], C0[1], C1[0]), b_ = MX3(C0[2], C0[3], C1[1]); a_ = MX3(a_, C1[2], C1[3]); \
        _Pragma("unroll") for (int r_ = 4; r_ < 16; r_ += 4) { a_ = MX3(a_, C0[r_], C0[r_ + 1]); b_ = MX3(b_, C0[r_ + 2], C0[r_ + 3]); } \
        float rm_ = __builtin_fmaxf(a_, b_); DEC_TAIL(); } while (0)
#define RESC() do { if (resc) { _Pragma("unroll") for (int r_ = 0; r_ < 16; ++r_) { o0[r_] *= fres; o1[r_] *= fres; } } } while (0)
#define EX(v) __builtin_amdgcn_exp2f((v) + nmh)
#define PKW(P, i) cvtpk_s(P[i], P[(i) + 1])
#define PAF(k) __builtin_bit_cast(bf16x8, pw##k)
#define VFR(i) (bf16x8){vlo[i][0], vlo[i][1], vlo[i][2], vlo[i][3], vhi[i][0], vhi[i][1], vhi[i][2], vhi[i][3]}
#define VRD(i, s) do { vlo[i] = vtr(vp_ + (((i) >> 2) * 4096 + vol##s)); vhi[i] = vtr(vp_ + (((i) >> 2) * 4096 + voh##s)); } while (0)
#define GAPA(MF, a0, a1, a2, a3, W0, W1, PW) do { MF; sacc += a0; sacc += a1; sacc += a2; sacc += a3; PIN(sacc); W0; W1; PIN(PW); SBAR(); } while (0)
#define GAPM(MF) do { MF; SBAR(); } while (0)
#define GAPB(MF, X, i) do { MF; X[i] = EX(X[i]); X[(i) + 1] = EX(X[(i) + 1]); X[(i) + 2] = EX(X[(i) + 2]); X[(i) + 3] = EX(X[(i) + 3]); PIN(X); SBAR(); } while (0)
#define EXG(X, i) do { X[i] = EX(X[i]); X[(i) + 1] = EX(X[(i) + 1]); X[(i) + 2] = EX(X[(i) + 2]); X[(i) + 3] = EX(X[(i) + 3]); PIN(X); SBAR(); } while (0)
#define STAGE(t, KR, VR) do { *(LAS u32x4*)(L + sl_prev + kdst) = KR; *(LAS u32x4*)(L + sl_next + vdst) = VR; \
        { const int tk_ = VT(min((t) + 4, NTV - 1)), tv_ = VT(min((t) + 3, NTV - 1)); const bf16_t *kp_, *vq_, *kq_, *vv_; ATT_SRC(tk_, kp_, vq_); ATT_SRC(tv_, kq_, vv_); (void)vq_; (void)kq_; \
          KR = *(const u32x4*)(kp_ + ksoff); VR = *(const u32x4*)(vv_ + vsoff); } SBAR(); } while (0)
#define QK0(C0, CZ) C0 = (CZ) ? MFMA32(kf[0], qr[0], zero16) : MFMA32(kf[0], qr[0], C0)
#define QK1(C1, CZ) C1 = (CZ) ? MFMA32(kf[1], qr[0], zero16) : MFMA32(kf[1], qr[0], C1)
#define PHASEA_PW(C0, C1, P0, P1, CZ) do { \
    VRD(0, 0); SBAR(); float sacc = P0[0] + P0[1]; \
                       GAPA(QK0(C0, CZ), P0[2], P0[3], P0[4], P0[5],     pw0[0] = PKW(P0, 0),  pw0[1] = PKW(P0, 2),  pw0); \
    VRD(4, 0); SBAR(); GAPA(QK1(C1, CZ), P0[6], P0[7], P0[8], P0[9],     pw0[2] = PKW(P0, 4),  pw0[3] = PKW(P0, 6),  pw0); \
    VRD(1, 1); SBAR(); GAPA(C0 = MFMA32(kf[2], qr[1], C0), P0[10], P0[11], P0[12], P0[13], pw1[0] = PKW(P0, 8),  pw1[1] = PKW(P0, 10), pw1); \
    VRD(5, 1); SBAR(); GAPA(C1 = MFMA32(kf[3], qr[1], C1), P0[14], P0[15], P1[0], P1[1],   pw1[2] = PKW(P0, 12), pw1[3] = PKW(P0, 14), pw1); \
    VRD(2, 2); SBAR(); GAPA(C0 = MFMA32(kf[4], qr[2], C0), P1[2], P1[3], 0.f, 0.f,         pw2[0] = PKW(P1, 0),  pw2[1] = PKW(P1, 2),  pw2); \
    VRD(6, 2); SBAR(); GAPM(C1 = MFMA32(kf[5], qr[2], C1)); pw2[2] = 0u; pw2[3] = 0u; \
                       GAPM(C0 = MFMA32(kf[6], qr[3], C0)); GAPM(C1 = MFMA32(kf[7], qr[3], C1)); \
    l_reg += sacc; } while (0)
#define PHASEA_PD(C0, C1, P0, P1, CZ) do { \
    VRD(0, 0); SBAR(); float sacc = P0[0] + P0[1]; \
                       GAPA(QK0(C0, CZ), P0[2], P0[3], P0[4], P0[5],     pw0[0] = PKW(P0, 0),  pw0[1] = PKW(P0, 2),  pw0); \
    VRD(4, 0); SBAR(); GAPA(QK1(C1, CZ), P0[6], P0[7], P0[8], P0[9],     pw0[2] = PKW(P0, 4),  pw0[3] = PKW(P0, 6),  pw0); \
    VRD(1, 1); SBAR(); GAPA(C0 = MFMA32(kf[2], qr[1], C0), P0[10], P0[11], P0[12], P0[13], pw1[0] = PKW(P0, 8),  pw1[1] = PKW(P0, 10), pw1); \
    VRD(5, 1); SBAR(); GAPA(C1 = MFMA32(kf[3], qr[1], C1), P0[14], P0[15], P1[0], P1[1],   pw1[2] = PKW(P0, 12), pw1[3] = PKW(P0, 14), pw1); \
    VRD(2, 2); SBAR(); GAPA(C0 = MFMA32(kf[4], qr[2], C0), P1[2], P1[3], P1[4], P1[5],     pw2[0] = PKW(P1, 0),  pw2[1] = PKW(P1, 2),  pw2); \
    VRD(6, 2); SBAR(); GAPA(C1 = MFMA32(kf[5], qr[2], C1), P1[6], P1[7], P1[8], P1[9],     pw2[2] = PKW(P1, 4),  pw2[3] = PKW(P1, 6),  pw2); \
    VRD(3, 3); SBAR(); GAPA(C0 = MFMA32(kf[6], qr[3], C0), P1[10], P1[11], P1[12], P1[13], pw3[0] = PKW(P1, 8),  pw3[1] = PKW(P1, 10), pw3); \
    VRD(7, 3); SBAR(); GAPA(C1 = MFMA32(kf[7], qr[3], C1), P1[14], P1[15], 0.f, 0.f,       pw3[2] = PKW(P1, 12), pw3[3] = PKW(P1, 14), pw3); \
    l_reg += sacc; } while (0)
#define STEP_WW(C0, C1, P0, P1, t, KR, VR) do { SBAR(); const LAS char* vp_ = vp0 + sl_prev; const int cad = CADDR((t) + 1); \
    PHASEA_PW(C0, C1, P0, P1, false); STAGE(t, KR, VR); float nmh; DECIDE_W(C0, C1); SBAR(); \
                               GAPB(o0 = MFMA32(VFR(0), PAF(0), o0), C0, 0);  CLDA(P0, 0); CLDA(P0, 1); SBAR(); \
                               GAPB(o1 = MFMA32(VFR(4), PAF(0), o1), C0, 4);  CLDA(P0, 2); CLDA(P0, 3); SBAR(); \
    KLD2(sl_next, 0); SBAR();  GAPB(o0 = MFMA32(VFR(1), PAF(1), o0), C0, 8);  CLDA(P0, 4); CLDA(P0, 5); SBAR(); \
    KLD2(sl_next, 1); SBAR();  GAPB(o1 = MFMA32(VFR(5), PAF(1), o1), C0, 12); CLDA(P0, 6); CLDA(P0, 7); SBAR(); \
    KLD2(sl_next, 2); SBAR();  GAPB(o0 = MFMA32(VFR(2), PAF(2), o0), C1, 0);  CLDB(P1, 0); CLDB(P1, 1); SBAR(); \
    KLD2(sl_next, 3); SBAR();  GAPM(o1 = MFMA32(VFR(6), PAF(2), o1)); } while (0)
#define STEP_DW(C0, C1, P0, P1, t, KR, VR) do { SBAR(); const LAS char* vp_ = vp0 + sl_prev; \
    PHASEA_PW(C0, C1, P0, P1, true); STAGE(t, KR, VR); float nmh; DECIDE_D(C0, C1); SBAR(); \
                               GAPB(o0 = MFMA32(VFR(0), PAF(0), o0), C0, 0); \
                               GAPB(o1 = MFMA32(VFR(4), PAF(0), o1), C0, 4); \
    KLD2(sl_next, 0); SBAR();  GAPB(o0 = MFMA32(VFR(1), PAF(1), o0), C0, 8); \
    KLD2(sl_next, 1); SBAR();  GAPB(o1 = MFMA32(VFR(5), PAF(1), o1), C0, 12); \
    KLD2(sl_next, 2); SBAR();  GAPB(o0 = MFMA32(VFR(2), PAF(2), o0), C1, 0); \
    KLD2(sl_next, 3); SBAR();  GAPB(o1 = MFMA32(VFR(6), PAF(2), o1), C1, 4); \
                               EXG(C1, 8); EXG(C1, 12); } while (0)
#define STEP_DD(C0, C1, P0, P1, t, KR, VR) do { SBAR(); const LAS char* vp_ = vp0 + sl_prev; \
    PHASEA_PD(C0, C1, P0, P1, true); STAGE(t, KR, VR); float nmh; DECIDE_D(C0, C1); SBAR(); \
                               GAPB(o0 = MFMA32(VFR(0), PAF(0), o0), C0, 0); \
                               GAPB(o1 = MFMA32(VFR(4), PAF(0), o1), C0, 4); \
    KLD2(sl_next, 0); SBAR();  GAPB(o0 = MFMA32(VFR(1), PAF(1), o0), C0, 8); \
    KLD2(sl_next, 1); SBAR();  GAPB(o1 = MFMA32(VFR(5), PAF(1), o1), C0, 12); \
    KLD2(sl_next, 2); SBAR();  GAPB(o0 = MFMA32(VFR(2), PAF(2), o0), C1, 0); \
    KLD2(sl_next, 3); SBAR();  GAPB(o1 = MFMA32(VFR(6), PAF(2), o1), C1, 4); \
                               GAPB(o0 = MFMA32(VFR(3), PAF(3), o0), C1, 8); \
                               GAPB(o1 = MFMA32(VFR(7), PAF(3), o1), C1, 12); } while (0)
    f32x16 zero16;
#pragma unroll
    for (int i = 0; i < 16; ++i) zero16[i] = 0.f;
    WBAR();
    sl_prev = 2 * AT_SLOTB; sl_cur = 0; sl_next = AT_SLOTB;
    if (!ctx) {
        { const int cad = CADDR(0);
#pragma unroll
          for (int q = 0; q < 8; ++q) CLDA(pA0, q);
          CLDB(pA1, 0); CLDB(pA1, 1); }
#pragma unroll
        for (int j = 0; j < 4; ++j) KLD2(0, j);
#pragma unroll
        for (int j = 0; j < 4; ++j) { pA0 = MFMA32(kf[2 * j], qr[j], pA0); pA1 = MFMA32(kf[2 * j + 1], qr[j], pA1); }
        STAGE(0, kreg, vreg);
        { float nmh; DECIDE_W(pA0, pA1);
#pragma unroll
          for (int r_ = 0; r_ < 16; ++r_) pA0[r_] = EX(pA0[r_]);
#pragma unroll
          for (int r_ = 0; r_ < 4; ++r_) pA1[r_] = EX(pA1[r_]); }
        { const int cad = CADDR(1);
#pragma unroll
          for (int q = 0; q < 8; ++q) CLDA(pB0, q);
          CLDB(pB1, 0); CLDB(pB1, 1); }
#pragma unroll
        for (int j = 0; j < 4; ++j) KLD2(AT_SLOTB, j);
        WBAR(); ROT();
#pragma unroll 1
        for (int t = 1; t < NWP; t += 2) {
            STEP_WW(pB0, pB1, pA0, pA1, t, kreg2, vreg2);     WBAR(); RESC(); ROT();
            STEP_WW(pA0, pA1, pB0, pB1, t + 1, kreg, vreg); WBAR(); RESC(); ROT();
        }
        STEP_DW(pB0, pB1, pA0, pA1, NWP, kreg2, vreg2); WBAR(); RESC(); ROT();
    } else {
#pragma unroll
        for (int j = 0; j < 4; ++j) KLD2(0, j);
        pB0 = MFMA32(kf[0], qr[0], zero16); pB1 = MFMA32(kf[1], qr[0], zero16);
#pragma unroll
        for (int j = 1; j < 4; ++j) { pB0 = MFMA32(kf[2 * j], qr[j], pB0); pB1 = MFMA32(kf[2 * j + 1], qr[j], pB1); }
        STAGE(0, kreg, vreg);
        { float nmh; DECIDE_D(pB0, pB1);
#pragma unroll
          for (int r_ = 0; r_ < 16; ++r_) { pB0[r_] = EX(pB0[r_]); pB1[r_] = EX(pB1[r_]); } }
#pragma unroll
        for (int j = 0; j < 4; ++j) KLD2(AT_SLOTB, j);
        WBAR(); ROT();
    }
    if (ctx) {
      STEP_DD(pA0, pA1, pB0, pB1, 1, kreg2, vreg2); WBAR(); RESC(); ROT();
      STEP_DD(pB0, pB1, pA0, pA1, 2, kreg, vreg);   WBAR(); RESC(); ROT();
      STEP_DD(pA0, pA1, pB0, pB1, 3, kreg2, vreg2); WBAR(); RESC(); ROT();
    } else {
      STEP_DD(pA0, pA1, pB0, pB1, NWP + 1, kreg, vreg);   WBAR(); RESC(); ROT();
      STEP_DD(pB0, pB1, pA0, pA1, NWP + 2, kreg2, vreg2); WBAR(); RESC(); ROT();
      STEP_DD(pA0, pA1, pB0, pB1, NWP + 3, kreg, vreg);   WBAR(); RESC(); ROT(); }
#define DRAIN(P0, P1) do { float sacc = P0[0] + P0[1]; \
      _Pragma("unroll") for (int r_ = 2; r_ < 16; ++r_) sacc += P0[r_]; \
      _Pragma("unroll") for (int r_ = 0; r_ < 16; ++r_) sacc += P1[r_]; \
      l_reg += sacc; \
      pw0 = (u32x4){PKW(P0, 0), PKW(P0, 2), PKW(P0, 4), PKW(P0, 6)}; pw1 = (u32x4){PKW(P0, 8), PKW(P0, 10), PKW(P0, 12), PKW(P0, 14)}; \
      pw2 = (u32x4){PKW(P1, 0), PKW(P1, 2), PKW(P1, 4), PKW(P1, 6)}; pw3 = (u32x4){PKW(P1, 8), PKW(P1, 10), PKW(P1, 12), PKW(P1, 14)}; \
      PIN(pw0); PIN(pw1); PIN(pw2); PIN(pw3); SBAR(); \
      _Pragma("unroll") for (int i_ = 0; i_ < 4; ++i_) zr[i_] = *(const u32x4*)(zp + (size_t)i_ * 8 * 512); \
      asm volatile("" ::: "memory"); if (next_ctx >= 0) attn_prefetch(F, layer, next_ctx, true, P); asm volatile("" ::: "memory");     \
      const LAS char* vp_ = vp0 + sl_prev; VRD(0, 0); VRD(4, 0); VRD(1, 1); VRD(5, 1); VRD(2, 2); VRD(6, 2); VRD(3, 3); VRD(7, 3); \
      o0 = MFMA32(VFR(0), PAF(0), o0); o1 = MFMA32(VFR(4), PAF(0), o1); o0 = MFMA32(VFR(1), PAF(1), o0); o1 = MFMA32(VFR(5), PAF(1), o1); \
      o0 = MFMA32(VFR(2), PAF(2), o0); o1 = MFMA32(VFR(6), PAF(2), o1); o0 = MFMA32(VFR(3), PAF(3), o0); o1 = MFMA32(VFR(7), PAF(3), o1); } while (0)
    int le = lane; asm volatile("" : "+v"(le));
    unsigned char* wse = kws();
    const bf16_t* zp = (const bf16_t*)(wse + WS_SZA) + (size_t)(R0 + (le >> 3)) * 512 + h * 64 + (le & 7) * 8;
    u32x4 zr[4];
    DRAIN(pA0, pA1);
#undef DRAIN
#undef STEP_DD
#undef STEP_DW
#undef STEP_WW
#undef PHASEA_PD
#undef PHASEA_PW
#undef QK0
#undef QK1
#undef STAGE
#undef EXG
#undef GAPB
#undef GAPM
#undef GAPA
#undef VRD
#undef VFR
#undef PAF
#undef PKW
#undef EX
#undef RESC
#undef DECIDE_W
#undef DECIDE_D
#undef DEC_TAIL
#undef CLDA
#undef CLDB
#undef CADDR
#undef KLD2
#undef MX3
#undef ROT
#undef VT
    { auto rr = __builtin_amdgcn_permlane32_swap(__float_as_uint(l_reg), __float_as_uint(l_reg), false, false); l_reg = __uint_as_float(rr[0]) + __uint_as_float(rr[1]); }
    const float inv = 1.0f / l_reg;
    { LAS char* stg = L + AT_TBL + wid * 4608; LAS char* srow = stg + (le >> 3) * 144 + (le & 7) * 16; LAS char* sfrag = stg + (le & 31) * 144 + (le >> 5) * 8;
#pragma unroll
      for (int i = 0; i < 4; ++i) *(LAS u32x4*)(srow + i * 8 * 144) = zr[i];
      asm volatile("s_waitcnt lgkmcnt(0)" ::: "memory");
      u32x2 zg0[4], zg1[4];
#pragma unroll
      for (int g = 0; g < 4; ++g) { zg0[g] = *(const LAS u32x2*)(sfrag + 16 * g); zg1[g] = *(const LAS u32x2*)(sfrag + 64 + 16 * g); }
      asm volatile("s_waitcnt lgkmcnt(0)" ::: "memory");
#pragma unroll
      for (int g = 0; g < 4; ++g) {
          const u32x2 z0 = zg0[g], z1 = zg1[g];
          u32x2 w0, w1;
          w0.x = cvtpk_s(o0[4 * g + 0] * inv * bflo(z0.x), o0[4 * g + 1] * inv * bfhi(z0.x)); w0.y = cvtpk_s(o0[4 * g + 2] * inv * bflo(z0.y), o0[4 * g + 3] * inv * bfhi(z0.y));
          w1.x = cvtpk_s(o1[4 * g + 0] * inv * bflo(z1.x), o1[4 * g + 1] * inv * bfhi(z1.x)); w1.y = cvtpk_s(o1[4 * g + 2] * inv * bflo(z1.y), o1[4 * g + 3] * inv * bfhi(z1.y));
          *(LAS u32x2*)(sfrag + 16 * g) = w0; *(LAS u32x2*)(sfrag + 64 + 16 * g) = w1; }
      asm volatile("s_waitcnt lgkmcnt(0)" ::: "memory");
      bf16_t* yp = (bf16_t*)(wse + WS_YAB) + (size_t)(R0 + (le >> 3)) * 1024 + h * 64 + (le & 7) * 8;
#pragma unroll
      for (int i = 0; i < 4; ++i) { const u32x4 v = *(const LAS u32x4*)(srow + i * 8 * 144); *(u32x4*)(yp + (size_t)i * 8 * 1024) = v; } }
    WBAR();
#undef WBAR
#undef PIN
#undef SBAR
}
#undef ATT_SRC
#undef ATT_DECODE

__device__ __forceinline__ void mix_phase(Frame& F, int layer) {
    AttnPre P;
    const int t_ctx = 255 - F.bx;
    for (int t = F.bx; t < M / 32; t += 256) conv_task(F, layer, t, P, t + 256 >= M / 32 ? F.bx : -1);
    attn_wg(F, layer, F.bx, false, P, t_ctx < 128 ? t_ctx : -1);
    if (t_ctx < 128) attn_wg(F, layer, t_ctx, true, P, -1);
}

__device__ __forceinline__ void cvec_phase(Frame& F) {
    const int gw = F.bx * 8 + F.wave, NGW = F.G * 8;
    const float* md = WSP(float, WS_MOD) + 5 * 3072;
    f32x4 sh[5][4];
#pragma unroll
    for (int g = 0; g < 5; ++g)
#pragma unroll
        for (int i = 0; i < 4; ++i) sh[g][i] = *(const f32x4*)(md + g * 3072 + 16 * F.lane + 4 * i);
    const bf16_t* W = WSP(bf16_t, WS_WTIN) + (size_t)DIN * D; const float* bp = WSP(float, WS_BIASP) + DIN; float* cv = WSP(float, WS_CVEC);
    for (int n = gw; n < DIN; n += NGW) {
        const u32x4 wa = *(const u32x4*)(W + (size_t)n * D + 16 * F.lane), wb = *(const u32x4*)(W + (size_t)n * D + 16 * F.lane + 8);
        const f32x4 w0 = {bflo(wa.x), bfhi(wa.x), bflo(wa.y), bfhi(wa.y)}, w1 = {bflo(wa.z), bfhi(wa.z), bflo(wa.w), bfhi(wa.w)};
        const f32x4 w2 = {bflo(wb.x), bfhi(wb.x), bflo(wb.y), bfhi(wb.y)}, w3 = {bflo(wb.z), bfhi(wb.z), bflo(wb.w), bfhi(wb.w)};
        const float bias = bp[n];
#pragma unroll
        for (int g = 0; g < 5; ++g) { const f32x4 p = sh[g][0] * w0 + sh[g][1] * w1 + sh[g][2] * w2 + sh[g][3] * w3;
            const float sm = wave_sum((p[0] + p[1]) + (p[2] + p[3])); if (F.lane == 0) cv[g * DIN + n] = sm + bias; }
    }
}

struct Args { const float* in[20]; float* out; unsigned char* ws; int ph_lo, ph_hi; };

__global__ void __launch_bounds__(512, 2) mk_fwd(Args args) {
    extern __shared__ __attribute__((aligned(16))) unsigned char lds_raw[];
    Frame F;
    F.lds = (LAS unsigned char*)lds_raw;
    F.tid = threadIdx.x; F.lane = F.tid & 63; F.wave = __builtin_amdgcn_readfirstlane(F.tid >> 6); F.G = gridDim.x; F.bx = blockIdx.x;
    for (int u = F.tid; u < (LDS_BYTES - LDSCTL_OFF) / 4; u += 512) ((LAS unsigned*)(F.lds + LDSCTL_OFF))[u] = 0u;
    __syncthreads();
    XcdBarrier bar; bar.bar = WSP(unsigned, WS_CTL) + CW_BAR; bar.x = 0; bar.st = nullptr;
#define lo (kint(176))
#define hi (kint(180))
    if (hi - lo > 1) bar = xcd_barrier_post(WSP(unsigned, WS_CTL) + CW_BAR, (volatile LAS unsigned*)(F.lds + MISC_OFF) + 8);
#ifndef PH_MASK
#define PH_MASK 0x7f
#endif
#define PHK(kind) ((PH_MASK >> (kind)) & 1)
#define IN(k) (lo <= (k) && (k) < hi)
#define SEAM(k) do { if (IN(k) && IN((k) + 1)) { XcdBarrier bb_; bb_.bar = WSP(unsigned, WS_CTL) + CW_BAR; bb_.x = xb_xcc_id(); bb_.st = (volatile LAS unsigned*)((LAS unsigned char*)lds_raw + MISC_OFF) + 8; xcd_barrier(bb_); } } while (0)
#define FRESH() do { F.tid = fresh_tid(); F.lane = F.tid & 63; F.wave = __builtin_amdgcn_readfirstlane(F.tid >> 6); } while (0)

    if (PHK(0) && IN(0)) { FRESH(); p0_prologue(F); SEAM(0); }
    for (int layer = 0; layer < DEPTH; ++layer) {
        const int pb = 1 + 5 * layer;
        if (PHK(1) && IN(pb) && layer == 0) { FRESH();
            if (layer == 0 && F.bx == F.G - 1) { const float* rg = kin(I_RMS_G) + D; const float* md = WSP(float, WS_MOD) + 5 * 3072; float* gm = WSP(float, WS_GM);
                for (int i = F.tid; i < 5 * 1024; i += 512) { const int g = i >> 10, c = i & 1023; gm[i] = rg[c] * (1.0f + md[g * 3072 + 1024 + c]); } }
            norm_phase(F, layer); SEAM(pb); }
        if (PHK(2) && IN(pb + 1)) {
            constexpr int M1 = 46 * 256;
            const bf16_t* Ain = layer == 0 ? WSP(bf16_t, WS_H) : WSP(bf16_t, WS_YAB);
            { pg8::Gemm g{Ain + (size_t)M1 * D, WSP(bf16_t, WS_WTIN) + (size_t)layer * DIN * D, M - M1, DIN, D, D}; pg8::StaticOrder S; S.init(M - M1, DIN, F.G, F.G - 1 - F.bx, 0, 128);
              if (layer == 0) { EpiInT<2> E{layer, M1}; pg8::gemm_phase<EpiInT<2>>(F.lds, g, S, E); } else { EpiInT<2, true> E{layer, M1}; pg8::gemm_phase<EpiInT<2, true>>(F.lds, g, S, E); } }
            const int nidle = F.G - (M - M1) / 128 * (DIN / 256);
            const bool slack = (int)blockIdx.x < nidle, early = slack && ((blockIdx.x >> 3) & 1) == 0;
            if (early) { if (layer == 0) { FRESH(); __syncthreads(); wt_items(F, 1, F.bx * 8 + F.wave, nidle * 8); __syncthreads(); } else { __builtin_amdgcn_s_sleep(100); __builtin_amdgcn_s_sleep(100); } }
            { pg8::Gemm g{Ain, WSP(bf16_t, WS_WTIN) + (size_t)layer * DIN * D, M1, DIN, D, D}; pg8::StaticOrder S; S.init(M1, DIN, F.G, F.bx);
              if (layer == 0) { EpiInT<4> E{layer, 0}; pg8::gemm_phase<EpiInT<4>>(F.lds, g, S, E); } else { EpiInT<4, true> E{layer, 0}; pg8::gemm_phase<EpiInT<4, true>>(F.lds, g, S, E); } }
            if (layer == 0 && slack && !early) { FRESH(); __syncthreads(); wt_items(F, 1, F.bx * 8 + F.wave, nidle * 8); }
            SEAM(pb + 1);
        }
        if (PHK(3) && IN(pb + 2)) { FRESH(); mix_phase(F, layer); SEAM(pb + 2); }
        if (PHK(4) && IN(pb + 3)) {
            if (layer == 0) { FRESH(); cvec_phase(F); }
            pg8::Gemm g{WSP(bf16_t, WS_YAB), WSP(bf16_t, WS_WTPROJ) + (size_t)layer * D * D, M, D, D, D}; pg8::StaticOrder S; S.init(M, D, F.G, F.bx, 0, 192);
            EpiProj E{};
            pg8::gemm_phase<EpiProj>(F.lds, g, S, E);
            SEAM(pb + 3);
        }
        if (PHK(5) && IN(pb + 4)) {
            pg8::Gemm g{WSP(bf16_t, WS_H), WSP(bf16_t, WS_WTOUT) + (size_t)layer * D * D, M, D, D, D}; pg8::StaticOrder S; S.init(M, D, F.G, F.bx, 0, 192);
            if (layer + 1 < DEPTH) { EpiOutT<false> E{layer}; pg8::gemm_phase<EpiOutT<false>>(F.lds, g, S, E); }
            else { EpiOutT<true> E{layer}; pg8::gemm_phase<EpiOutT<true>>(F.lds, g, S, E); }
            if (layer + 1 < DEPTH) SEAM(pb + 4);
        }
    }
#undef IN
#undef SEAM
#undef lo
#undef hi
}

extern "C" void kernel_launch(void* const* d_in, const int* in_sizes, int n_in, void* d_out, int out_size, void* d_ws, size_t ws_size, hipStream_t stream) {
    static int grid = 0;
    if (grid == 0) {
        if (n_in != 20 || ws_size < WS_END) { fprintf(stderr, "kernel_launch: unexpected inputs (n_in %d, ws %zu)\n", n_in, ws_size); grid = -1; return; }
        int dev = 0, cus = 0, per_cu = 0;
        if (hipGetDevice(&dev) != hipSuccess || hipDeviceGetAttribute(&cus, hipDeviceAttributeMultiprocessorCount, dev) != hipSuccess) { grid = -1; return; }
        if (hipFuncSetAttribute((const void*)mk_fwd, hipFuncAttributeMaxDynamicSharedMemorySize, LDS_BYTES) != hipSuccess) { fprintf(stderr, "kernel_launch: hipFuncSetAttribute failed\n"); grid = -1; return; }
        if (hipOccupancyMaxActiveBlocksPerMultiprocessor(&per_cu, (const void*)mk_fwd, 512, LDS_BYTES) != hipSuccess || per_cu < 1) { fprintf(stderr, "kernel_launch: occupancy query says %d\n", per_cu); per_cu = 1; }
        (void)hipGetLastError();
        if (cus < 256) { fprintf(stderr, "kernel_launch: %d CUs; the mixer's work split is written for a grid of 256 workgroups\n", cus); grid = -1; return; }
        grid = 256;
    }
    if (grid < 0) return;
    (void)hipMemsetAsync((char*)d_ws + WS_CTL, 0, CTL_ZERO_BYTES, stream);
    Args a{};
    for (int i = 0; i < 20; ++i) a.in[i] = (const float*)d_in[i];
    a.out = (float*)d_out; a.ws = (unsigned char*)d_ws;
    if (MK_N_LAUNCHES == 1) { a.ph_lo = 0; a.ph_hi = NPHASE; hipLaunchKernelGGL(mk_fwd, dim3(grid), dim3(512), LDS_BYTES, stream, a); }
    else for (int p = 0; p < NPHASE; ++p) { a.ph_lo = p; a.ph_hi = p + 1; hipLaunchKernelGGL(mk_fwd, dim3(grid), dim3(512), LDS_BYTES, stream, a); }
}
```
